# Optimizing an MI355X kernel written in HIP

```python
import math
import jax, jax.numpy as jnp
from jax import lax
import numpy as np

D_MODEL = 1024
BATCH = 8
SEQ = 2048
DEPTH = 1
DEC_BATCH = 128
DEC_SEQ = 8
PAST_LEN = 16384
PAGE_SIZE = 128

M_HEADS = 4
M_HEAD_DIM = D_MODEL // M_HEADS
M_WIDTH = M_HEADS * M_HEAD_DIM
CONV_W = 4
G_HEADS = 4
G_DK = D_MODEL // (2 * G_HEADS)
G_DV = D_MODEL // G_HEADS
G_KW = G_HEADS * G_DK
G_VW = G_HEADS * G_DV
G_RANK = 16
G_TAU = 16.0
D_FF = 2816
CHUNK = 64
EPS = 1e-6

kernel_name = "hybrid_mlstm_gla_macaron_step"

IN_SPLITS = (M_WIDTH, M_WIDTH, M_WIDTH, 2 * M_HEADS, G_KW, G_KW, G_VW, G_VW, G_RANK, D_MODEL, D_MODEL)
IN_WIDTH = 3 * M_WIDTH + 2 * M_HEADS + 2 * G_KW + 2 * G_VW + G_RANK + 2 * D_MODEL


def _rmsnorm(x, g):
    xf = x.astype(jnp.float32)
    y = xf * lax.rsqrt(jnp.mean(xf * xf, axis=-1, keepdims=True) + EPS)
    return (y * g.astype(jnp.float32)).astype(x.dtype)


def _head_norm(h, g, dtype):
    y = h * lax.rsqrt(jnp.mean(h * h, axis=-1, keepdims=True) + EPS)
    B, H, T, d = h.shape
    y = y.transpose(0, 2, 1, 3).reshape(B, T, H * d)
    return (y * g.astype(jnp.float32)).astype(dtype)


def _swiglu(h, w_up, w_down):
    a, g = jnp.split(h @ w_up, 2, axis=-1)
    return (jax.nn.silu(g) * a) @ w_down


def _causal_conv(u, buf, w, b):
    full = jnp.concatenate([buf.astype(u.dtype), u], axis=1)
    T = u.shape[1]
    y = b
    for j in range(CONV_W):
        y = y + full[:, j:j + T] * w[j]
    return y, full[:, full.shape[1] - (CONV_W - 1):]


def _chunk_len(T):
    return CHUNK if T % CHUNK == 0 else T


def _to_chunks(a, L):
    B, H, T = a.shape[:3]
    a = a.reshape(B, H, T // L, L, *a.shape[3:])
    return jnp.moveaxis(a, 2, 0)


def _mlstm_scan(q, k, v, ig, lf, C0, n0, m0):
    B, H, T, d = q.shape
    L = _chunk_len(T)
    xs = tuple(_to_chunks(a, L) for a in (q, k, v, ig, lf))
    causal = jnp.tril(jnp.ones((L, L), dtype=bool))

    def step(carry, inp):
        C, n, m = carry
        qb, kb, vb, ib, fb = inp
        b = jnp.cumsum(fb, axis=-1)
        m_t = b + jnp.maximum(m[..., None], lax.cummax(ib - b, axis=2))
        inter = jnp.exp(b + m[..., None] - m_t)
        logD = b[..., :, None] - b[..., None, :] + ib[..., None, :] - m_t[..., :, None]
        Dm = jnp.exp(jnp.where(causal, logD, -jnp.inf))
        s = jnp.einsum('bhtd,bhsd->bhts', qb, kb) * Dm
        num = inter[..., None] * jnp.einsum('bhtd,bhed->bhte', qb, C) + jnp.einsum('bhts,bhse->bhte', s, vb)
        den = inter * jnp.einsum('bhtd,bhd->bht', qb, n) + jnp.sum(s, axis=-1)
        h = num / jnp.maximum(jnp.abs(den), jnp.exp(-m_t))[..., None]
        m_L = m_t[..., -1]
        w = jnp.exp(b[..., -1:] - b + ib - m_L[..., None])
        decay = jnp.exp(b[..., -1] + m - m_L)
        C_new = decay[..., None, None] * C + jnp.einsum('bhs,bhse,bhsd->bhed', w, vb, kb)
        n_new = decay[..., None] * n + jnp.einsum('bhs,bhsd->bhd', w, kb)
        return (C_new, n_new, m_L), h

    (C, n, m), hc = lax.scan(step, (C0, n0, m0), xs)
    h = jnp.moveaxis(hc, 0, 2).reshape(B, H, T, d)
    return h, C, n, m


def _gla_scan(q, k, v, la, S0):
    B, H, T, _ = q.shape
    dv = v.shape[-1]
    L = _chunk_len(T)
    xs = tuple(_to_chunks(a, L) for a in (q, k, v, la))
    causal = jnp.tril(jnp.ones((L, L), dtype=bool))[:, :, None]

    def step(S, inp):
        qb, kb, vb, ab = inp
        A = jnp.cumsum(ab, axis=2)
        inter = jnp.einsum('bhtd,bhde->bhte', qb * jnp.exp(A), S)
        diff = jnp.where(causal, A[:, :, :, None, :] - A[:, :, None, :, :], -jnp.inf)
        att = jnp.einsum('bhtd,bhtsd,bhsd->bhts', qb, jnp.exp(diff), kb)
        o = inter + jnp.einsum('bhts,bhse->bhte', att, vb)
        A_L = A[:, :, -1]
        S_new = jnp.exp(A_L)[..., None] * S + jnp.einsum('bhsd,bhse->bhde', kb * jnp.exp(A_L[:, :, None] - A), vb)
        return S_new, o

    S, oc = lax.scan(step, S0, xs)
    o = jnp.moveaxis(oc, 0, 2).reshape(B, H, T, dv)
    return o, S


def _mixer(h, conv_buf, C0, n0, m0, S0, W, l):
    B, T, _ = h.shape
    dt = h.dtype
    f32 = jnp.float32
    proj = h @ W['w_in'][l]
    idx, acc = [], 0
    for wdt in IN_SPLITS[:-1]:
        acc += wdt
        idx.append(acc)
    u_m, v_m, o_m, if_m, q_g, k_g, v_g, r_g, a_g, g_a, g_b = jnp.split(proj, idx, axis=-1)

    c, conv_new = _causal_conv(u_m, conv_buf, W['conv_w'][l], W['conv_b'][l])
    ch = jax.nn.silu(c).reshape(B, T, M_HEADS, M_HEAD_DIM)
    q = jnp.einsum('bthd,hde->bhte', ch, W['w_mq'][l]).astype(f32)
    k = (jnp.einsum('bthd,hde->bhte', ch, W['w_mk'][l]) * (M_HEAD_DIM ** -0.5)).astype(f32)
    v = v_m.reshape(B, T, M_HEADS, M_HEAD_DIM).transpose(0, 2, 1, 3).astype(f32)
    gates = (if_m.reshape(B, T, 2, M_HEADS) + W['b_if'][l]).astype(f32)
    ig = gates[:, :, 0].transpose(0, 2, 1)
    lf = jax.nn.log_sigmoid(gates[:, :, 1]).transpose(0, 2, 1)
    hm, C, n, m = _mlstm_scan(q, k, v, ig, lf, C0.astype(f32), n0.astype(f32), m0.astype(f32))
    hm = jax.nn.sigmoid(o_m) * _head_norm(hm, W['g_mhead'][l], dt)

    qg = (q_g.reshape(B, T, G_HEADS, G_DK).transpose(0, 2, 1, 3) * (G_DK ** -0.5)).astype(f32)
    kg = k_g.reshape(B, T, G_HEADS, G_DK).transpose(0, 2, 1, 3).astype(f32)
    vg = v_g.reshape(B, T, G_HEADS, G_DV).transpose(0, 2, 1, 3).astype(f32)
    la = jax.nn.log_sigmoid((a_g @ W['w_a2'][l] + W['b_a'][l]).astype(f32)) / G_TAU
    la = la.reshape(B, T, G_HEADS, G_DK).transpose(0, 2, 1, 3)
    og, S = _gla_scan(qg, kg, vg, la, S0.astype(f32))
    og = jax.nn.silu(r_g) * _head_norm(og, W['g_ghead'][l], dt)

    y = jax.nn.sigmoid(g_a) * (hm @ W['w_pa'][l]) + jax.nn.sigmoid(g_b) * (og @ W['w_pb'][l])
    out = y @ W['w_o'][l]
    return out, conv_new.astype(dt), C.astype(dt), n.astype(dt), m.astype(dt), S.astype(dt)


def _trunk(x, st_conv, st_C, st_n, st_m, st_S, W):
    convs, Cs, ns, ms, Ss = [], [], [], [], []
    for l in range(DEPTH):
        x = x + 0.5 * _swiglu(_rmsnorm(x, W['g_ffn1'][l]), W['w_ffn1_up'][l], W['w_ffn1_down'][l])
        mix, cv, C, n, m, S = _mixer(_rmsnorm(x, W['g_mix'][l]), st_conv[l], st_C[l], st_n[l], st_m[l], st_S[l], W, l)
        x = x + mix
        x = x + 0.5 * _swiglu(_rmsnorm(x, W['g_ffn2'][l]), W['w_ffn2_up'][l], W['w_ffn2_down'][l])
        convs.append(cv); Cs.append(C); ns.append(n); ms.append(m); Ss.append(S)
    y = _rmsnorm(x, W['g_final'])
    return y, jnp.stack(convs), jnp.stack(Cs), jnp.stack(ns), jnp.stack(ms), jnp.stack(Ss)


def setup_inputs(seed: int = 0) -> dict:
    key = jax.random.key(seed)
    ks = iter(jax.random.split(key, 40))
    nrm = lambda shape, s: jax.random.normal(next(ks), shape, jnp.float32) * s
    gain = lambda shape: 1.0 + nrm(shape, 0.05)
    f_bias = jnp.linspace(3.0, 6.0, M_HEADS, dtype=jnp.float32)
    b_if = jnp.stack([nrm((DEPTH, M_HEADS), 0.1), f_bias + nrm((DEPTH, M_HEADS), 0.1)], axis=1)
    return {
        "x_prompt": nrm((BATCH, SEQ, D_MODEL), 1.0),
        "x_sample": nrm((DEC_BATCH, DEC_SEQ, D_MODEL), 1.0),
        "state_conv": nrm((DEPTH, DEC_BATCH, CONV_W - 1, M_WIDTH), 1.0),
        "state_mlstm_C": nrm((DEPTH, DEC_BATCH, M_HEADS, M_HEAD_DIM, M_HEAD_DIM), 0.1),
        "state_mlstm_n": nrm((DEPTH, DEC_BATCH, M_HEADS, M_HEAD_DIM), 0.1),
        "state_mlstm_m": nrm((DEPTH, DEC_BATCH, M_HEADS), 1.0),
        "state_gla_S": nrm((DEPTH, DEC_BATCH, G_HEADS, G_DK, G_DV), 0.1),
        "g_ffn1": gain((DEPTH, D_MODEL)),
        "w_ffn1_up": nrm((DEPTH, D_MODEL, 2 * D_FF), D_MODEL ** -0.5),
        "w_ffn1_down": nrm((DEPTH, D_FF, D_MODEL), D_FF ** -0.5),
        "g_mix": gain((DEPTH, D_MODEL)),
        "w_in": nrm((DEPTH, D_MODEL, IN_WIDTH), D_MODEL ** -0.5),
        "conv_w": nrm((DEPTH, CONV_W, M_WIDTH), CONV_W ** -0.5),
        "conv_b": nrm((DEPTH, M_WIDTH), 0.02),
        "w_mq": nrm((DEPTH, M_HEADS, M_HEAD_DIM, M_HEAD_DIM), M_HEAD_DIM ** -0.5),
        "w_mk": nrm((DEPTH, M_HEADS, M_HEAD_DIM, M_HEAD_DIM), M_HEAD_DIM ** -0.5),
        "b_if": b_if,
        "g_mhead": gain((DEPTH, M_WIDTH)),
        "w_a2": nrm((DEPTH, G_RANK, G_KW), G_RANK ** -0.5),
        "b_a": nrm((DEPTH, G_KW), 0.1),
        "g_ghead": gain((DEPTH, G_VW)),
        "w_pa": nrm((DEPTH, M_WIDTH, D_MODEL), M_WIDTH ** -0.5),
        "w_pb": nrm((DEPTH, G_VW, D_MODEL), G_VW ** -0.5),
        "w_o": nrm((DEPTH, D_MODEL, D_MODEL), D_MODEL ** -0.5),
        "g_ffn2": gain((DEPTH, D_MODEL)),
        "w_ffn2_up": nrm((DEPTH, D_MODEL, 2 * D_FF), D_MODEL ** -0.5),
        "w_ffn2_down": nrm((DEPTH, D_FF, D_MODEL), D_FF ** -0.5),
        "g_final": gain((D_MODEL,)),
    }


def reference(x_prompt, x_sample, state_conv, state_mlstm_C, state_mlstm_n, state_mlstm_m, state_gla_S,
              g_ffn1, w_ffn1_up, w_ffn1_down, g_mix, w_in, conv_w, conv_b, w_mq, w_mk, b_if, g_mhead,
              w_a2, b_a, g_ghead, w_pa, w_pb, w_o, g_ffn2, w_ffn2_up, w_ffn2_down, g_final):
    W = {
        'g_ffn1': g_ffn1, 'w_ffn1_up': w_ffn1_up, 'w_ffn1_down': w_ffn1_down, 'g_mix': g_mix,
        'w_in': w_in, 'conv_w': conv_w, 'conv_b': conv_b, 'w_mq': w_mq, 'w_mk': w_mk, 'b_if': b_if,
        'g_mhead': g_mhead, 'w_a2': w_a2, 'b_a': b_a, 'g_ghead': g_ghead, 'w_pa': w_pa, 'w_pb': w_pb,
        'w_o': w_o, 'g_ffn2': g_ffn2, 'w_ffn2_up': w_ffn2_up, 'w_ffn2_down': w_ffn2_down, 'g_final': g_final,
    }
    B = x_prompt.shape[0]
    dt = x_prompt.dtype
    z_conv = jnp.zeros((DEPTH, B, CONV_W - 1, M_WIDTH), dt)
    z_C = jnp.zeros((DEPTH, B, M_HEADS, M_HEAD_DIM, M_HEAD_DIM), dt)
    z_n = jnp.zeros((DEPTH, B, M_HEADS, M_HEAD_DIM), dt)
    z_m = jnp.zeros((DEPTH, B, M_HEADS), dt)
    z_S = jnp.zeros((DEPTH, B, G_HEADS, G_DK, G_DV), dt)
    y_prompt, conv_p, C_p, n_p, m_p, S_p = _trunk(x_prompt, z_conv, z_C, z_n, z_m, z_S, W)
    y_sample, conv_s, C_s, n_s, m_s, S_s = _trunk(x_sample, state_conv, state_mlstm_C, state_mlstm_n,
                                                  state_mlstm_m, state_gla_S, W)
    return (y_prompt, y_sample, conv_p, C_p, n_p, m_p, S_p, conv_s, C_s, n_s, m_s, S_s)
```

```cpp
#include <hip/hip_runtime.h>
#include <cstdio>
#include <cstdint>
namespace nv {
constexpr int D = 1024, FF = 2816, INW = 8216, NH = 4, HD = 256, GDK = 128, GDV = 256, GKW = 512;
constexpr int C_UM = 0, C_VM = 1024, C_OM = 2048, C_IF = 3072, C_QG = 3080, C_KG = 3592, C_VG = 4104, C_RG = 5128, C_AG = 6152, C_GA = 6168, C_GB = 7192;
constexpr float EPS = 1e-6f;

__device__ __forceinline__ float sigmoidf_(float x) { return 1.f / (1.f + expf(-x)); }
__device__ __forceinline__ float siluf_(float x) { return x / (1.f + expf(-x)); }
__device__ __forceinline__ float logsigmoidf_(float x) { return fminf(x, 0.f) - log1pf(expf(-fabsf(x))); }

__global__ void k_rmsnorm(const float* x, const float* g, float* out, int ncol) {
    const float* xr = x + (size_t)blockIdx.x * ncol; float* o = out + (size_t)blockIdx.x * ncol;
    __shared__ float red[8];
    float s = 0.f;
    for (int c = threadIdx.x; c < ncol; c += blockDim.x) s += xr[c] * xr[c];
    for (int o2 = 32; o2 > 0; o2 >>= 1) s += __shfl_xor(s, o2);
    if ((threadIdx.x & 63) == 0) red[threadIdx.x >> 6] = s;
    __syncthreads();
    float tot = 0.f; for (int i = 0; i < (int)(blockDim.x >> 6); ++i) tot += red[i];
    const float r = 1.f / sqrtf(tot / ncol + EPS);
    for (int c = threadIdx.x; c < ncol; c += blockDim.x) o[c] = xr[c] * r * g[c];
}
__global__ void __launch_bounds__(256) k_gemm(const float* A, int lda, const float* B, int ldb, float* C, int ldc, int M, int N, int K, size_t sA, size_t sB, size_t sC) {
    A += blockIdx.z * sA; B += blockIdx.z * sB; C += blockIdx.z * sC;
    __shared__ float As[16][68], Bs[16][68];
    const int tx = threadIdx.x & 15, ty = threadIdx.x >> 4, m0 = blockIdx.y * 64, n0 = blockIdx.x * 64;
    float acc[4][4] = {};
    for (int k0 = 0; k0 < K; k0 += 16) {
        for (int i = threadIdx.x; i < 1024; i += 256) { const int r = i >> 4, c = i & 15; As[c][r] = (m0 + r < M) ? A[(size_t)(m0 + r) * lda + k0 + c] : 0.f; }
        for (int i = threadIdx.x; i < 1024; i += 256) { const int r = i >> 6, c = i & 63; Bs[r][c] = (n0 + c < N) ? B[(size_t)(k0 + r) * ldb + n0 + c] : 0.f; }
        __syncthreads();
#pragma unroll
        for (int kk = 0; kk < 16; ++kk) {
            float a[4], b[4];
#pragma unroll
            for (int i = 0; i < 4; ++i) { a[i] = As[kk][ty * 4 + i]; b[i] = Bs[kk][tx * 4 + i]; }
#pragma unroll
            for (int i = 0; i < 4; ++i)
#pragma unroll
                for (int j = 0; j < 4; ++j) acc[i][j] += a[i] * b[j];
        }
        __syncthreads();
    }
    for (int i = 0; i < 4; ++i) for (int j = 0; j < 4; ++j) { const int r = m0 + ty * 4 + i, c = n0 + tx * 4 + j; if (r < M && c < N) C[(size_t)r * ldc + c] = acc[i][j]; }
}
__global__ void k_swiglu(const float* up, float* act, size_t n) { const size_t i = (size_t)blockIdx.x * blockDim.x + threadIdx.x; if (i >= n) return; const size_t r = i / FF, j = i % FF; const float a = up[r * 2 * FF + j], g = up[r * 2 * FF + FF + j]; act[i] = siluf_(g) * a; }
__global__ void k_axpy(const float* x, const float* d, float alpha, float* out, size_t n) { const size_t i = (size_t)blockIdx.x * blockDim.x + threadIdx.x; if (i < n) out[i] = x[i] + alpha * d[i]; }
__global__ void k_conv(const float* proj, const float* buf, const float* cw, const float* cb, float* ch, float* conv_out, int nseq, int Tl) {
    const size_t i = (size_t)blockIdx.x * blockDim.x + threadIdx.x; if (i >= (size_t)nseq * Tl * D) return;
    const int c = i % D; const int t = (i / D) % Tl; const int s = i / ((size_t)D * Tl);
    float y = cb[c];
    for (int j = 0; j < 4; ++j) { const int tt = t - 3 + j; float u; if (tt >= 0) u = proj[((size_t)s * Tl + tt) * INW + C_UM + c]; else u = buf ? buf[((size_t)s * 3 + (3 + tt)) * D + c] : 0.f; y += u * cw[j * D + c]; }
    ch[i] = siluf_(y);
    if (t >= Tl - 3) conv_out[((size_t)s * 3 + (t - (Tl - 3))) * D + c] = proj[((size_t)s * Tl + t) * INW + C_UM + c];
}
__global__ void k_la(const float* proj, const float* wa2, const float* ba, float* la, size_t rows) {
    const size_t i = (size_t)blockIdx.x * blockDim.x + threadIdx.x; if (i >= rows * GKW) return; const size_t r = i / GKW; const int c = i % GKW;
    float s = ba[c]; for (int j = 0; j < 16; ++j) s += proj[r * INW + C_AG + j] * wa2[j * GKW + c];
    la[i] = logsigmoidf_(s) / 16.f;
}
__global__ void __launch_bounds__(256) k_mlstm(const float* q, const float* k, const float* proj, const float* bif, const float* C0, const float* n0, const float* m0,
                                             float* hout, float* Cout, float* nout, float* mout, int Tl) {
    const int eg = blockIdx.x, h = blockIdx.y, s = blockIdx.z, tid = threadIdx.x, e = tid >> 3, dp = tid & 7;
    __shared__ float Cs[32][257]; __shared__ float ns[256], qs[256], ks[256], red[4], vs[32];
    const size_t sh = (size_t)s * NH + h;
    for (int i = tid; i < 32 * 256; i += 256) { const int ee = i >> 8, d = i & 255; Cs[ee][d] = C0 ? C0[(sh * HD + eg * 32 + ee) * HD + d] : 0.f; }
    ns[tid] = n0 ? n0[sh * HD + tid] : 0.f;
    float m = m0 ? m0[sh] : 0.f;
    __syncthreads();
    for (int t = 0; t < Tl; ++t) {
        const size_t r = (size_t)s * Tl + t;
        const float ig = proj[r * INW + C_IF + h] + bif[h], fg = proj[r * INW + C_IF + NH + h] + bif[NH + h], lf = logsigmoidf_(fg);
        const float mn = fmaxf(lf + m, ig), fdec = expf(lf + m - mn), iexp = expf(ig - mn);
        qs[tid] = q[r * D + h * HD + tid]; ks[tid] = k[r * D + h * HD + tid] * 0.0625f;
        if (tid < 32) vs[tid] = proj[r * INW + C_VM + h * HD + eg * 32 + tid];
        __syncthreads();
        const float nn = fdec * ns[tid] + iexp * ks[tid]; ns[tid] = nn;
        float dpart = nn * qs[tid];
        for (int o = 32; o > 0; o >>= 1) dpart += __shfl_xor(dpart, o);
        if ((tid & 63) == 0) red[tid >> 6] = dpart;
        float acc = 0.f; const float ve = vs[e] * iexp;
        for (int d = dp * 32; d < dp * 32 + 32; ++d) { const float c = fdec * Cs[e][d] + ve * ks[d]; Cs[e][d] = c; acc += c * qs[d]; }
        acc += __shfl_xor(acc, 1); acc += __shfl_xor(acc, 2); acc += __shfl_xor(acc, 4);
        __syncthreads();
        const float den = red[0] + red[1] + red[2] + red[3];
        if (dp == 0) hout[r * D + h * HD + eg * 32 + e] = acc / fmaxf(fabsf(den), expf(-mn));
        m = mn;
        __syncthreads();
    }
    for (int i = tid; i < 32 * 256; i += 256) { const int ee = i >> 8, d = i & 255; Cout[(sh * HD + eg * 32 + ee) * HD + d] = Cs[ee][d]; }
    if (eg == 0) { nout[sh * HD + tid] = ns[tid]; if (tid == 0) mout[sh] = m; }
}
__global__ void __launch_bounds__(256) k_gla(const float* proj, const float* la, const float* S0, float* oout, float* Sout, int Tl) {
    const int eg = blockIdx.x, h = blockIdx.y, s = blockIdx.z, tid = threadIdx.x, e = tid >> 2, dp = tid & 3;
    __shared__ float Ss[128][65]; __shared__ float qs[128], ks[128], as[128], vs[64];
    const size_t sh = (size_t)s * NH + h;
    for (int i = tid; i < 128 * 64; i += 256) { const int d = i >> 6, ee = i & 63; Ss[d][ee] = S0 ? S0[(sh * GDK + d) * GDV + eg * 64 + ee] : 0.f; }
    __syncthreads();
    for (int t = 0; t < Tl; ++t) {
        const size_t r = (size_t)s * Tl + t;
        if (tid < 128) { qs[tid] = proj[r * INW + C_QG + h * GDK + tid] * 0.08838834764831845f; ks[tid] = proj[r * INW + C_KG + h * GDK + tid]; as[tid] = expf(la[r * GKW + h * GDK + tid]); }
        if (tid < 64) vs[tid] = proj[r * INW + C_VG + h * GDV + eg * 64 + tid];
        __syncthreads();
        float acc = 0.f; const float ve = vs[e];
        for (int d = dp * 32; d < dp * 32 + 32; ++d) { const float c = as[d] * Ss[d][e] + ks[d] * ve; Ss[d][e] = c; acc += qs[d] * c; }
        acc += __shfl_xor(acc, 1); acc += __shfl_xor(acc, 2);
        if (dp == 0) oout[r * D + h * GDV + eg * 64 + e] = acc;
        __syncthreads();
    }
    for (int i = tid; i < 128 * 64; i += 256) { const int d = i >> 6, ee = i & 63; Sout[(sh * GDK + d) * GDV + eg * 64 + ee] = Ss[d][ee]; }
}
__global__ void __launch_bounds__(256) k_headnorm(const float* hin, const float* g, const float* proj, int gcol, int mode, float* out) {
    const size_t r = blockIdx.x; const int h = blockIdx.y, tid = threadIdx.x; __shared__ float red[4];
    const float v = hin[r * D + h * HD + tid]; float s = v * v;
    for (int o = 32; o > 0; o >>= 1) s += __shfl_xor(s, o);
    if ((tid & 63) == 0) red[tid >> 6] = s;
    __syncthreads();
    const float rs = 1.f / sqrtf((red[0] + red[1] + red[2] + red[3]) / HD + EPS);
    const float gv = proj[r * INW + gcol + h * HD + tid];
    out[r * D + h * HD + tid] = (mode == 0 ? sigmoidf_(gv) : siluf_(gv)) * (v * rs * g[h * HD + tid]);
}
__global__ void k_merge(const float* pa, const float* pb, const float* proj, float* y, size_t rows) {
    const size_t i = (size_t)blockIdx.x * blockDim.x + threadIdx.x; if (i >= rows * D) return; const size_t r = i / D; const int c = i % D;
    y[i] = sigmoidf_(proj[r * INW + C_GA + c]) * pa[i] + sigmoidf_(proj[r * INW + C_GB + c]) * pb[i];
}

struct In { const float *xp, *xs, *st_conv, *st_C, *st_n, *st_m, *st_S, *g_ffn1, *w_up1, *w_dn1, *g_mix, *w_in, *conv_w, *conv_b, *w_mq, *w_mk, *b_if, *g_mhead, *w_a2, *b_a, *g_ghead, *w_pa, *w_pb, *w_o, *g_ffn2, *w_up2, *w_dn2, *g_final; };

inline void run_slab(const In& W, const float* x, int nseq, int Tl, const float* sconv, const float* sC, const float* sn, const float* sm, const float* sS,
                     float* y, float* oconv, float* oC, float* on, float* om, float* oS, float* ws, hipStream_t st) {
    const int R = nseq * Tl; const size_t RD = (size_t)R * D;
    float* xn = ws; float* up = xn + RD; float* act = up + (size_t)R * 2 * FF; float* tmp = act + (size_t)R * FF; float* x1 = tmp + RD; float* proj = x1 + RD;
    float* ch = proj + (size_t)R * INW; float* q = ch + RD; float* k = q + RD; float* la = k + RD; float* hh = la + (size_t)R * GKW; float* og = hh + RD; float* hm = og + RD; float* ogn = hm + RD;
    float* pa = ogn + RD; float* pb = pa + RD; float* yy = pb + RD;
    auto gemm = [&](const float* A, int lda, const float* B, int ldb, float* C, int ldc, int M, int N, int K, int nb = 1, size_t sA = 0, size_t sB = 0, size_t sC2 = 0) {
        k_gemm<<<dim3((N + 63) / 64, (M + 63) / 64, nb), 256, 0, st>>>(A, lda, B, ldb, C, ldc, M, N, K, sA, sB, sC2); };
    auto ew = [&](size_t n) { return dim3((unsigned)((n + 255) / 256)); };
    k_rmsnorm<<<R, 256, 0, st>>>(x, W.g_ffn1, xn, D);
    gemm(xn, D, W.w_up1, 2 * FF, up, 2 * FF, R, 2 * FF, D);
    k_swiglu<<<ew((size_t)R * FF), 256, 0, st>>>(up, act, (size_t)R * FF);
    gemm(act, FF, W.w_dn1, D, tmp, D, R, D, FF);
    k_axpy<<<ew(RD), 256, 0, st>>>(x, tmp, 0.5f, x1, RD);
    k_rmsnorm<<<R, 256, 0, st>>>(x1, W.g_mix, xn, D);
    gemm(xn, D, W.w_in, INW, proj, INW, R, INW, D);
    k_conv<<<ew(RD), 256, 0, st>>>(proj, sconv, W.conv_w, W.conv_b, ch, oconv, nseq, Tl);
    gemm(ch, D, W.w_mq, HD, q, D, R, HD, HD, NH, HD, (size_t)HD * HD, HD);
    gemm(ch, D, W.w_mk, HD, k, D, R, HD, HD, NH, HD, (size_t)HD * HD, HD);
    k_mlstm<<<dim3(8, NH, nseq), 256, 0, st>>>(q, k, proj, W.b_if, sC, sn, sm, hh, oC, on, om, Tl);
    k_la<<<ew((size_t)R * GKW), 256, 0, st>>>(proj, W.w_a2, W.b_a, la, R);
    k_gla<<<dim3(4, NH, nseq), 256, 0, st>>>(proj, la, sS, og, oS, Tl);
    k_headnorm<<<dim3(R, NH), 256, 0, st>>>(hh, W.g_mhead, proj, C_OM, 0, hm);
    k_headnorm<<<dim3(R, NH), 256, 0, st>>>(og, W.g_ghead, proj, C_RG, 1, ogn);
    gemm(hm, D, W.w_pa, D, pa, D, R, D, D);
    gemm(ogn, D, W.w_pb, D, pb, D, R, D, D);
    k_merge<<<ew(RD), 256, 0, st>>>(pa, pb, proj, yy, R);
    gemm(yy, D, W.w_o, D, tmp, D, R, D, D);
    k_axpy<<<ew(RD), 256, 0, st>>>(x1, tmp, 1.0f, x1, RD);
    k_rmsnorm<<<R, 256, 0, st>>>(x1, W.g_ffn2, xn, D);
    gemm(xn, D, W.w_up2, 2 * FF, up, 2 * FF, R, 2 * FF, D);
    k_swiglu<<<ew((size_t)R * FF), 256, 0, st>>>(up, act, (size_t)R * FF);
    gemm(act, FF, W.w_dn2, D, tmp, D, R, D, FF);
    k_axpy<<<ew(RD), 256, 0, st>>>(x1, tmp, 0.5f, x1, RD);
    k_rmsnorm<<<R, 256, 0, st>>>(x1, W.g_final, y, D);
}
inline In make_in(void* const* d) { In W; const float** p = (const float**)&W; for (int i = 0; i < 28; ++i) p[i] = (const float*)d[i]; return W; }
constexpr size_t O_YP = 0, O_YS = 16777216, O_CONVP = 17825792, O_CP = 17850368, O_NP = 19947520, O_MP = 19955712, O_SP = 19955744, O_CONVS = 21004320, O_CS = 21397536, O_NS = 54951968, O_MS = 55083040, O_SS = 55083552, O_END = 71860768;
inline void run_all(void* const* d_in, float* out, float* ws, hipStream_t st) {
    const In W = make_in(d_in);
    for (int b = 0; b < 8; ++b)
        run_slab(W, W.xp + (size_t)b * 2048 * D, 1, 2048, nullptr, nullptr, nullptr, nullptr, nullptr,
                 out + O_YP + (size_t)b * 2048 * D, out + O_CONVP + (size_t)b * 3 * D, out + O_CP + (size_t)b * NH * HD * HD, out + O_NP + (size_t)b * NH * HD, out + O_MP + (size_t)b * NH,
                 out + O_SP + (size_t)b * NH * GDK * GDV, ws, st);
    run_slab(W, W.xs, 128, 8, W.st_conv, W.st_C, W.st_n, W.st_m, W.st_S, out + O_YS, out + O_CONVS, out + O_CS, out + O_NS, out + O_MS, out + O_SS, ws, st);
}
}
extern "C" void kernel_launch(void* const* d_in, const int* in_sizes, int n_in, void* d_out, int out_size, void* d_ws, size_t ws_size, hipStream_t stream) {
    if (n_in != 28 || (size_t)out_size != nv::O_END || ws_size < (size_t)300 * 1024 * 1024) { fprintf(stderr, "kernel_launch: unexpected sizes n_in %d out %d ws %zu\n", n_in, out_size, ws_size); return; }
    nv::run_all(d_in, (float*)d_out, (float*)d_ws, stream);
}
```

```cpp
#include <hip/hip_runtime.h>
#include <cstdio>
#include <cstdint>
#include <hip/hip_cooperative_groups.h>
namespace cg = cooperative_groups;
namespace mk {
#define LAS __attribute__((address_space(3)))
#define GAS __attribute__((address_space(1)))
typedef unsigned short bf16_t;
typedef short bf16x8 __attribute__((ext_vector_type(8)));
typedef float f32x4 __attribute__((ext_vector_type(4)));
typedef float f32x2 __attribute__((ext_vector_type(2)));
typedef unsigned u32x4 __attribute__((ext_vector_type(4)));
typedef unsigned u32x2 __attribute__((ext_vector_type(2)));

constexpr int D = 1024, FF = 2816, T_P = 16384, T_S = 1024, T = T_P + T_S, SEQ = 2048, NB = 8, DEC_B = 128, DEC_T = 8;
constexpr int NH = 4, HD = 256, GDK = 128, GDV = 256, GKW = 512, INW = 8216;
constexpr int NWAVES = 8, NTHR = 512;
constexpr float EPS = 1e-6f;
constexpr int NCH_P = T_P / 64;
constexpr int NGRP = T / 64;

__device__ __forceinline__ unsigned f2bf(float f) { unsigned u = __builtin_bit_cast(unsigned, f); return (u + 0x7fffu + ((u >> 16) & 1u)) >> 16; }
__device__ __forceinline__ unsigned pk2(float lo, float hi) { return f2bf(lo) | (f2bf(hi) << 16); }
__device__ __forceinline__ float bf2f(unsigned short b) { return __builtin_bit_cast(float, (unsigned)b << 16); }
__device__ __forceinline__ float bflo(unsigned w) { return __builtin_bit_cast(float, w << 16); }
__device__ __forceinline__ float bfhi(unsigned w) { return __builtin_bit_cast(float, w & 0xffff0000u); }
__device__ __forceinline__ float sigmoid_(float x) { return 1.f / (1.f + __expf(-x)); }
__device__ __forceinline__ float silu_(float x) { return x / (1.f + __expf(-x)); }
__device__ __forceinline__ float logsigmoid_(float x) { return fminf(x, 0.f) - log1pf(expf(-fabsf(x))); }
__device__ __forceinline__ float wave_sum(float v) {
#pragma unroll
    for (int o = 1; o < 64; o <<= 1) v += __shfl_xor(v, o);
    return v;
}

namespace pg8 {
constexpr int BM = 256, BK = 64, HALF = 128, HTB = HALF * BK * 2, STAGE_BYTES = 8 * HTB, NXCD = 8, WGM = 8;
__host__ __device__ __forceinline__ int lds_byte(int r, int c) { const int st = (r >> 4) * 2 + (c >> 5), rr = r & 15, cc = c & 31, ob = rr * 64 + cc * 2; return st * 1024 + (ob ^ (((ob >> 9) & 1) << 5)); }
__host__ __device__ __forceinline__ void stage_rc(int b, int& R, int& C) { const int st = b / 1024, sb = b % 1024, swz = sb ^ (((sb >> 9) & 1) << 5); R = (st >> 1) * 16 + swz / 64; C = (st & 1) * 32 + (swz % 64) / 2; }
__host__ __device__ __forceinline__ int perm32(int rho) { const int n = rho >> 4, i = rho & 15; return 8 * (i >> 2) + 4 * n + (i & 3); }

struct Unit { int pm, pn, seg, z; };
struct Gemm { const bf16_t* A0; const bf16_t* B0; const bf16_t* A1; const bf16_t* B1; int lda, ldb, K, zA, zB; };
struct Sched {
    int nM0, nN0, nM1, nN1, n0, ntot, G, c;
    __device__ void init(int nM0_, int nN0_, int nz0, int nM1_, int nN1_, int nz1, int G_, int c_) { nM0 = nM0_; nN0 = nN0_; nM1 = nM1_; nN1 = nN1_; n0 = nM0 * nN0 * nz0; ntot = n0 + nM1 * nN1 * nz1; G = G_; c = c_; }
    __device__ bool next(int i, Unit& u) const {
        int L = i * G + c; if (L >= ntot) return false;
        int nM = nM0, nN = nN0; u.seg = 0; if (L >= n0) { L -= n0; nM = nM1; nN = nN1; u.seg = 1; }
        const int nwg = nM * nN; u.z = L / nwg; int wgid = L - u.z * nwg;
        { const int q = nwg / NXCD, r = nwg % NXCD, xcd = wgid % NXCD, off = wgid / NXCD; wgid = (xcd < r ? xcd * (q + 1) : r * (q + 1) + (xcd - r) * q) + off; }
        const int nig = WGM * nN, gid = wgid / nig, fm = gid * WGM, gsz = (nM - fm) < WGM ? (nM - fm) : WGM;
        u.pm = fm + ((wgid % nig) % gsz); u.pn = (wgid % nig) / gsz; return true;
    }
};
template <class Epi>
__device__ __forceinline__ void gemm_phase(LAS unsigned char* lds, const Gemm g, const Sched& S, const Epi& E) {
    int tid_ = threadIdx.x; asm volatile("" : "+v"(tid_));
    const int tid = tid_, wid = __builtin_amdgcn_readfirstlane(tid >> 6), lane = tid & 63, wr = wid >> 2, wc = wid & 3, fr = lane & 15, fq = lane >> 4;
    const int K = g.K, nt = K / BK;
    unsigned voffA[2], voffB[2];
#pragma unroll
    for (int i = 0; i < 2; ++i) { int R, C; stage_rc(tid * 16 + i * 8192, R, C); const int Rb = (R & ~31) + perm32(R & 31);
        voffA[i] = (unsigned)(R * g.lda + C) * 2u; voffB[i] = (unsigned)(Rb * g.ldb + C) * 2u; }
    const size_t kstep = (size_t)(BK * 2);
    const size_t hstepA = (size_t)HALF * g.lda * 2, hstepB = (size_t)HALF * g.ldb * 2;
    const unsigned ldsw = (unsigned)wid * 1024u;
    const int aoff = lds_byte(wr * 64 + fr, fq * 8), boff = lds_byte(wc * 32 + fr, fq * 8);
#define PG8_SA(b, h) (((b) * 2 + (h)) * HTB)
#define PG8_SB(b, h) ((4 + (b) * 2 + (h)) * HTB)
#define PG8_STAGE(bufoff, gbase, voff) do { _Pragma("unroll") for (int _i = 0; _i < 2; ++_i) \
        __builtin_amdgcn_global_load_lds((const unsigned*)((const char*)(gbase) + (voff)[_i]), (LAS unsigned*)(lds + (bufoff) + ldsw + _i * 8192), 16, 0, 0); } while (0)
#define PG8_LDA(dst, b, h) do { _Pragma("unroll") for (int m = 0; m < 4; ++m) _Pragma("unroll") for (int k = 0; k < 2; ++k) dst[m][k] = *(const LAS bf16x8*)(lds + PG8_SA(b, h) + aoff + m * 2048 + k * 1024); } while (0)
#define PG8_LDB(dst, b, h) do { _Pragma("unroll") for (int n = 0; n < 2; ++n) _Pragma("unroll") for (int k = 0; k < 2; ++k) dst[n][k] = *(const LAS bf16x8*)(lds + PG8_SB(b, h) + boff + n * 2048 + k * 1024); } while (0)
#define PG8_MMA(ai, bj, At, Bt) do { __builtin_amdgcn_s_setprio(1); _Pragma("unroll") for (int m = 0; m < 4; ++m) _Pragma("unroll") for (int n = 0; n < 2; ++n) _Pragma("unroll") for (int k = 0; k < 2; ++k) \
        acc[ai][bj][m][n] = __builtin_amdgcn_mfma_f32_16x16x32_bf16(Bt[n][k], At[m][k], acc[ai][bj][m][n], 0, 0, 0); __builtin_amdgcn_s_setprio(0); } while (0)
#define PG8_WAIT_V(n) asm volatile("s_waitcnt vmcnt(" #n ")" ::: "memory")
#define PG8_WAIT_L(n) asm volatile("s_waitcnt lgkmcnt(" #n ")" ::: "memory")
#define PG8_BAR __builtin_amdgcn_s_barrier()
#define PG8_SCHED __builtin_amdgcn_sched_barrier(0)
#define PG8_ABASE(u) ((const char*)((u).seg ? g.A1 : g.A0) + ((size_t)(u).z * g.zA) * 2 + (size_t)(u).pm * 2 * hstepA)
#define PG8_BBASE(u) ((const char*)((u).seg ? g.B1 : g.B0) + ((size_t)(u).z * g.zB) * 2 + (size_t)(u).pn * 2 * hstepB)
    Unit cur, nxt; int ui = 0;
    if (!S.next(0, cur)) return;
    f32x4 acc[2][2][4][2];
#pragma unroll
    for (int a = 0; a < 2; ++a)
#pragma unroll
        for (int b = 0; b < 2; ++b)
#pragma unroll
            for (int m = 0; m < 4; ++m)
#pragma unroll
                for (int n = 0; n < 2; ++n) acc[a][b][m][n] = (f32x4){0.f, 0.f, 0.f, 0.f};
    bf16x8 At[4][2], B0[2][2], B1[2][2];
    const char* cA = PG8_ABASE(cur); const char* cB = PG8_BBASE(cur);
    PG8_STAGE(PG8_SB(0, 0), cB, voffB); PG8_STAGE(PG8_SB(0, 1), cB + hstepB, voffB); PG8_STAGE(PG8_SA(0, 0), cA, voffA); PG8_STAGE(PG8_SA(0, 1), cA + hstepA, voffA);
    if (wr == 1) PG8_BAR;
    PG8_WAIT_V(2); PG8_BAR;
    PG8_STAGE(PG8_SB(1, 0), cB + kstep, voffB); PG8_STAGE(PG8_SA(1, 0), cA + kstep, voffA); PG8_STAGE(PG8_SB(1, 1), cB + hstepB + kstep, voffB);
    PG8_WAIT_V(6); PG8_BAR;
    for (;;) {
        const bool has_next = S.next(ui + 1, nxt);
        const char* nA = has_next ? PG8_ABASE(nxt) : cA; const char* nB = has_next ? PG8_BBASE(nxt) : cB;
        for (int t = 0; t < nt; t += 2) {
            const bool last = (t == nt - 2);
            const char* a1 = cA + (size_t)(t + 1) * kstep;
            const char* a2 = last ? nA : cA + (size_t)(t + 2) * kstep; const char* b2 = last ? nB : cB + (size_t)(t + 2) * kstep;
            const char* a3 = a2 + kstep; const char* b3 = b2 + kstep;
            PG8_LDB(B0, 0, 0); PG8_LDB(B1, 0, 1); PG8_SCHED; PG8_LDA(At, 0, 0); PG8_STAGE(PG8_SA(1, 1), a1 + hstepA, voffA);
            PG8_WAIT_V(8); PG8_WAIT_L(0); PG8_BAR; PG8_MMA(0, 0, At, B0); PG8_MMA(0, 1, At, B1); PG8_BAR; PG8_SCHED;
            PG8_LDA(At, 0, 1); PG8_STAGE(PG8_SB(0, 0), b2, voffB); PG8_STAGE(PG8_SB(0, 1), b2 + hstepB, voffB); PG8_STAGE(PG8_SA(0, 0), a2, voffA);
            PG8_WAIT_V(8); PG8_WAIT_L(0); PG8_BAR; PG8_MMA(1, 0, At, B0); PG8_MMA(1, 1, At, B1); PG8_BAR; PG8_SCHED;
            PG8_LDB(B0, 1, 0); PG8_LDB(B1, 1, 1); PG8_SCHED; PG8_LDA(At, 1, 0); PG8_STAGE(PG8_SA(0, 1), a2 + hstepA, voffA);
            PG8_WAIT_V(8); PG8_WAIT_L(0); PG8_BAR; PG8_MMA(0, 0, At, B0); PG8_MMA(0, 1, At, B1); PG8_BAR; PG8_SCHED;
            PG8_LDA(At, 1, 1); PG8_STAGE(PG8_SB(1, 0), b3, voffB); PG8_STAGE(PG8_SB(1, 1), b3 + hstepB, voffB); PG8_STAGE(PG8_SA(1, 0), a3, voffA);
            PG8_WAIT_V(8); PG8_WAIT_L(0); PG8_BAR; PG8_MMA(1, 0, At, B0); PG8_MMA(1, 1, At, B1); PG8_BAR; PG8_SCHED;
        }
        if (wr == 0) PG8_BAR;
        E(acc, cur, wr, wc, fr, fq);
        if (!has_next) break;
#pragma unroll
        for (int a = 0; a < 2; ++a)
#pragma unroll
            for (int b = 0; b < 2; ++b)
#pragma unroll
                for (int m = 0; m < 4; ++m)
#pragma unroll
                    for (int n = 0; n < 2; ++n) acc[a][b][m][n] = (f32x4){0.f, 0.f, 0.f, 0.f};
        cur = nxt; cA = nA; cB = nB; ++ui;
        if (wr == 1) PG8_BAR;
    }
    PG8_WAIT_V(0);
    PG8_BAR;
#undef PG8_SA
#undef PG8_SB
#undef PG8_STAGE
#undef PG8_LDA
#undef PG8_LDB
#undef PG8_MMA
#undef PG8_WAIT_V
#undef PG8_WAIT_L
#undef PG8_BAR
#undef PG8_SCHED
#undef PG8_ABASE
#undef PG8_BBASE
}
}
constexpr size_t MiB = 1u << 20;
constexpr size_t SZ_TD2 = (size_t)T * D * 2;
constexpr size_t WS_CTL = 0;
constexpr size_t WS_W = 1 * MiB;
constexpr size_t W_UP1 = WS_W, W_DN1 = W_UP1 + (size_t)2 * FF * D * 2, W_IN = W_DN1 + (size_t)D * FF * 2;
constexpr int NIN = 8448;
constexpr size_t W_QK = W_IN + (size_t)NIN * D * 2, W_PA = W_QK + (size_t)512 * D * 2, W_PB = W_PA + (size_t)D * D * 2, W_O = W_PB + (size_t)D * D * 2;
constexpr size_t W_UP2 = W_O + (size_t)D * D * 2, W_DN2 = W_UP2 + (size_t)2 * FF * D * 2, W_END = W_DN2 + (size_t)D * FF * 2;
static_assert(W_END <= 61 * MiB, "weights");
constexpr size_t WS_XBF = 61 * MiB;
constexpr size_t WS_MISC = WS_XBF + SZ_TD2;
constexpr size_t M_SSQ = WS_MISC;
constexpr size_t M_GATES = M_SSQ + (size_t)T * 16 * 4;
constexpr size_t M_SC = M_GATES + (size_t)T * 32 * 4;
constexpr size_t M_EAL = M_SC + (size_t)5 * NH * T * 4;
constexpr size_t M_DEN = M_EAL + (size_t)384 * GKW * 4;
constexpr size_t M_END = M_DEN + (size_t)T * 4 * 4;
static_assert(M_END <= WS_MISC + 6 * MiB, "misc");
constexpr size_t WS_ACT = WS_MISC + 6 * MiB;
constexpr size_t A_Q = WS_ACT, A_K = A_Q + SZ_TD2, A_QT = A_K + SZ_TD2;
constexpr size_t WS_SIG = WS_ACT + 94 * MiB;
constexpr size_t S_SIGO = WS_SIG, S_SILUR = S_SIGO + SZ_TD2, S_SIGA = S_SILUR + SZ_TD2, S_SIGB = S_SIGA + SZ_TD2;
constexpr size_t WS_VT = WS_SIG + 4 * SZ_TD2;
constexpr size_t WS_KT = WS_VT + 2 * SZ_TD2;
constexpr size_t WS_G = WS_KT + SZ_TD2;
constexpr size_t G_KT = WS_G, G_KTT = WS_G + SZ_TD2 / 2;
constexpr size_t WS_HN = WS_G + SZ_TD2;
constexpr size_t WS_END = WS_HN + SZ_TD2;
static_assert(A_QT + SZ_TD2 / 2 <= WS_SIG && WS_END <= 502 * MiB, "ws map");
constexpr size_t O_YP = 0, O_YS = 16777216, O_CONVP = 17825792, O_CP = 17850368, O_NP = 19947520, O_MP = 19955712, O_SP = 19955744, O_CONVS = 21004320, O_CS = 21397536, O_NS = 54951968, O_MS = 55083040, O_SS = 55083552, O_END = 71860768;
constexpr size_t DO_U = O_CS * 4, DO_QG = DO_U + SZ_TD2, DO_KG = DO_QG + SZ_TD2 / 2, DO_CH = DO_KG + SZ_TD2 / 2;
static_assert(DO_CH + SZ_TD2 <= O_NS * 4, "d_out temporaries");

struct P {
    const float* in[28]; float* out; unsigned char* ws;
};
#define WSP(T_, off) ((T_*)(p.ws + (off)))
#define DOP(T_, off) ((T_*)((unsigned char*)p.out + (off)))

__device__ __forceinline__ int win_src(int n) {
    if (n < 1024) return n;
    if (n < 2048) return 2048 + (n - 1024);
    if (n < 2560) return 3080 + (n - 2048);
    if (n < 3072) return 3592 + (n - 2560);
    if (n < 4096) return 5128 + (n - 3072);
    if (n < 5120) return 6168 + (n - 4096);
    if (n < 6144) return 7192 + (n - 5120);
    if (n < 6400) { const int j = n - 6144; return j < 8 ? 3072 + j : (j < 24 ? 6152 + (j - 8) : -1); }
    if (n < 7424) return 1024 + (n - 6400);
    return 4104 + (n - 7424);
}
__device__ __forceinline__ int up_src(int n) { const int t = n >> 8, r = n & 255; return (r >> 7) * FF + t * 128 + (r & 127); }
template <int MAP>
__device__ __forceinline__ void p0_item(const float* W, int K, int N, const float* gk, float scale, bf16_t* WT, int dst_row0, int ndst, LAS float* scr, int item, int lane) {
    const int nblk = ndst / 32, kb = item / nblk, nb = item % nblk, k0 = 64 * kb, n0 = 32 * nb;
    const int nn = n0 + (lane & 31); const int src = MAP == 0 ? nn : (MAP == 1 ? up_src(nn) : win_src(nn));
#pragma unroll 8
    for (int i = 0; i < 32; ++i) { const int kk = 2 * i + (lane >> 5); float v = 0.f; if (src >= 0) v = W[(size_t)(k0 + kk) * N + src] * (gk ? gk[k0 + kk] : 1.f) * scale; scr[kk * 33 + (lane & 31)] = v; }
    asm volatile("s_waitcnt lgkmcnt(0)" ::: "memory");
    const int c = lane & 7;
#pragma unroll
    for (int j = 0; j < 4; ++j) { const int n = (lane >> 3) + 8 * j; const LAS float* s = scr + (8 * c) * 33 + n;
        u32x4 o; o.x = pk2(s[0 * 33], s[1 * 33]); o.y = pk2(s[2 * 33], s[3 * 33]); o.z = pk2(s[4 * 33], s[5 * 33]); o.w = pk2(s[6 * 33], s[7 * 33]);
        *(u32x4*)(WT + (size_t)(dst_row0 + n0 + n) * K + k0 + 8 * c) = o; }
    asm volatile("s_waitcnt lgkmcnt(0)" ::: "memory");
}
__device__ __forceinline__ void p0_prologue(const P& p, LAS unsigned char* lds, int gw, int NGW, int wave, int lane) {
    LAS float* scr = (LAS float*)(lds + wave * 16384);
    constexpr int I_UP = (D / 64) * (2 * FF / 32), I_DN = (FF / 64) * (D / 32), I_IN = (D / 64) * (NIN / 32), I_QK = (D / 64) * (256 / 32), I_SQ = (D / 64) * (D / 32);
    constexpr int NITEMS = 2 * I_UP + 2 * I_DN + I_IN + 2 * I_QK + 3 * I_SQ;
    for (int it = gw; it < NITEMS; it += NGW) {
        int r = it;
        if (r < I_IN) { p0_item<2>(p.in[11], D, INW, p.in[10], 1.f, WSP(bf16_t, W_IN), 0, NIN, scr, r, lane); continue; } r -= I_IN;
        if (r < I_UP) { p0_item<1>(p.in[8], D, 2 * FF, p.in[7], 1.f, WSP(bf16_t, W_UP1), 0, 2 * FF, scr, r, lane); continue; } r -= I_UP;
        if (r < I_UP) { p0_item<1>(p.in[25], D, 2 * FF, p.in[24], 1.f, WSP(bf16_t, W_UP2), 0, 2 * FF, scr, r, lane); continue; } r -= I_UP;
        if (r < I_DN) { p0_item<0>(p.in[9], FF, D, nullptr, 1.f, WSP(bf16_t, W_DN1), 0, D, scr, r, lane); continue; } r -= I_DN;
        if (r < I_DN) { p0_item<0>(p.in[26], FF, D, nullptr, 1.f, WSP(bf16_t, W_DN2), 0, D, scr, r, lane); continue; } r -= I_DN;
        if (r < I_QK) { p0_item<0>(p.in[14], D, 256, nullptr, 1.f, WSP(bf16_t, W_QK), 0, 256, scr, r, lane); continue; } r -= I_QK;
        if (r < I_QK) { p0_item<0>(p.in[15], D, 256, nullptr, 0.0625f, WSP(bf16_t, W_QK), 256, 256, scr, r, lane); continue; } r -= I_QK;
        if (r < I_SQ) { p0_item<0>(p.in[21], D, D, nullptr, 1.f, WSP(bf16_t, W_PA), 0, D, scr, r, lane); continue; } r -= I_SQ;
        if (r < I_SQ) { p0_item<0>(p.in[22], D, D, nullptr, 1.f, WSP(bf16_t, W_PB), 0, D, scr, r, lane); continue; } r -= I_SQ;
        p0_item<0>(p.in[23], D, D, nullptr, 1.f, WSP(bf16_t, W_O), 0, D, scr, r, lane);
    }
    bf16_t* XB = WSP(bf16_t, WS_XBF); float* SSQ = WSP(float, M_SSQ);
    for (int m = gw; m < T; m += NGW) {
        const float* xrow = m < T_P ? p.in[0] + (size_t)m * D : p.in[1] + (size_t)(m - T_P) * D;
        const f32x4* xr = (const f32x4*)xrow + lane; f32x4 v[4]; float s = 0.f;
#pragma unroll
        for (int j = 0; j < 4; ++j) { v[j] = xr[64 * j]; s += (v[j].x * v[j].x + v[j].y * v[j].y) + (v[j].z * v[j].z + v[j].w * v[j].w); }
        s = wave_sum(s);
        u32x2* o8 = (u32x2*)(XB + (size_t)m * D) + lane;
#pragma unroll
        for (int j = 0; j < 4; ++j) { u32x2 w; w.x = pk2(v[j].x, v[j].y); w.y = pk2(v[j].z, v[j].w); o8[64 * j] = w; }
        if (lane < 16) SSQ[(size_t)m * 16 + lane] = lane == 0 ? s : 0.f;
    }
}
__device__ __forceinline__ float row_rs(const float* SSQ, int row) {
    const f32x4* q = (const f32x4*)(SSQ + (size_t)row * 16); const f32x4 a = q[0], b = q[1], c = q[2], d = q[3];
    const float s = ((a.x + a.y) + (a.z + a.w)) + ((b.x + b.y) + (b.z + b.w)) + ((c.x + c.y) + (c.z + c.w)) + ((d.x + d.y) + (d.z + d.w));
    return 1.f / sqrtf(s * (1.f / D) + EPS);
}

typedef pg8::Unit Unit;
#define EPI_ARGS const f32x4 (&acc)[2][2][4][2], const Unit& u, int wr, int wc, int fr, int fq
struct EpiUp { const float* SSQ; bf16_t* ACT;
    __device__ __forceinline__ void operator()(EPI_ARGS) const {
        const int row0 = u.pm * 256 + wr * 64 + fr, col0 = u.pn * 128 + wc * 32 + 8 * fq;
#pragma unroll
        for (int ai = 0; ai < 2; ++ai)
#pragma unroll
            for (int m = 0; m < 4; ++m) { const int row = row0 + ai * 128 + m * 16; const float rs = row_rs(SSQ, row); u32x4 w; unsigned* wp = (unsigned*)&w;
#pragma unroll
                for (int n = 0; n < 2; ++n) { const f32x4 a = acc[ai][0][m][n] * rs, g = acc[ai][1][m][n] * rs;
                    wp[2 * n] = pk2(silu_(g[0]) * a[0], silu_(g[1]) * a[1]); wp[2 * n + 1] = pk2(silu_(g[2]) * a[2], silu_(g[3]) * a[3]); }
                *(u32x4*)(ACT + (size_t)row * FF + col0) = w; }
    }
};
template <bool WB> struct EpiRes { const float* xi_p; const float* xi_s; float* xo; bf16_t* XBo; float* SSQ; float alpha;
    __device__ __forceinline__ void operator()(EPI_ARGS) const {
        const int row0 = u.pm * 256 + wr * 64 + fr; const float* xi = u.pm < T_P / 256 ? xi_p : xi_s;
#pragma unroll
        for (int ai = 0; ai < 2; ++ai)
#pragma unroll
            for (int m = 0; m < 4; ++m) { const int row = row0 + ai * 128 + m * 16; float ss = 0.f;
#pragma unroll
                for (int bj = 0; bj < 2; ++bj) { const int col = u.pn * 256 + bj * 128 + wc * 32 + 8 * fq; const size_t off = (size_t)row * D + col;
                    const f32x4 x0 = *(const f32x4*)(xi + off), x1 = *(const f32x4*)(xi + off + 4);
                    const f32x4 y0 = x0 + acc[ai][bj][m][0] * alpha, y1 = x1 + acc[ai][bj][m][1] * alpha;
                    *(f32x4*)(xo + off) = y0; *(f32x4*)(xo + off + 4) = y1;
                    ss += (y0[0] * y0[0] + y0[1] * y0[1]) + (y0[2] * y0[2] + y0[3] * y0[3]) + (y1[0] * y1[0] + y1[1] * y1[1]) + (y1[2] * y1[2] + y1[3] * y1[3]);
                    if (WB) { u32x4 w; w.x = pk2(y0[0], y0[1]); w.y = pk2(y0[2], y0[3]); w.z = pk2(y1[0], y1[1]); w.w = pk2(y1[2], y1[3]); *(u32x4*)(XBo + off) = w; } }
                ss += __shfl_xor(ss, 16); ss += __shfl_xor(ss, 32);
                if (fq == 0) SSQ[(size_t)row * 16 + u.pn * 4 + wc] = ss; }
    }
};
struct EpiIn { const float* SSQ; bf16_t *U, *SIGO, *QG, *KG, *SILUR, *SIGA, *SIGB, *VT; float* GATES;
    __device__ __forceinline__ void operator()(EPI_ARGS) const {
        if (u.seg == 0) {
            const int row0 = u.pm * 256 + wr * 64 + fr; const int pn = u.pn;
            bf16_t* dst; int ld, cb, act;
            if (pn < 4) { dst = U; ld = D; cb = pn * 256; act = 0; } else if (pn < 8) { dst = SIGO; ld = D; cb = (pn - 4) * 256; act = 1; }
            else if (pn < 10) { dst = QG; ld = GKW; cb = (pn - 8) * 256; act = 0; } else if (pn < 12) { dst = KG; ld = GKW; cb = (pn - 10) * 256; act = 0; }
            else if (pn < 16) { dst = SILUR; ld = D; cb = (pn - 12) * 256; act = 2; } else if (pn < 20) { dst = SIGA; ld = D; cb = (pn - 16) * 256; act = 1; }
            else { dst = SIGB; ld = D; cb = (pn - 20) * 256; act = 1; }
#pragma unroll
            for (int ai = 0; ai < 2; ++ai)
#pragma unroll
                for (int m = 0; m < 4; ++m) { const int row = row0 + ai * 128 + m * 16; const float rs = row_rs(SSQ, row);
                    if (pn == 24) { if (wc == 0) { *(f32x4*)(GATES + (size_t)row * 32 + 8 * fq) = acc[ai][0][m][0] * rs; *(f32x4*)(GATES + (size_t)row * 32 + 8 * fq + 4) = acc[ai][0][m][1] * rs; } continue; }
#pragma unroll
                    for (int bj = 0; bj < 2; ++bj) { f32x4 v0 = acc[ai][bj][m][0] * rs, v1 = acc[ai][bj][m][1] * rs;
                        if (act == 1) { for (int i = 0; i < 4; ++i) { v0[i] = sigmoid_(v0[i]); v1[i] = sigmoid_(v1[i]); } }
                        else if (act == 2) { for (int i = 0; i < 4; ++i) { v0[i] = silu_(v0[i]); v1[i] = silu_(v1[i]); } }
                        u32x4 w; w.x = pk2(v0[0], v0[1]); w.y = pk2(v0[2], v0[3]); w.z = pk2(v1[0], v1[1]); w.w = pk2(v1[2], v1[3]);
                        *(u32x4*)(dst + (size_t)row * ld + cb + bj * 128 + wc * 32 + 8 * fq) = w; } }
        } else {
            const int vrow0 = u.pm * 256 + wr * 64 + fr;
            float rs[2][8];
#pragma unroll
            for (int bj = 0; bj < 2; ++bj)
#pragma unroll
                for (int j = 0; j < 8; ++j) rs[bj][j] = row_rs(SSQ, u.pn * 256 + bj * 128 + wc * 32 + 8 * fq + j);
#pragma unroll
            for (int ai = 0; ai < 2; ++ai)
#pragma unroll
                for (int m = 0; m < 4; ++m) { const int vr = vrow0 + ai * 128 + m * 16;
#pragma unroll
                    for (int bj = 0; bj < 2; ++bj) { const f32x4 a0 = acc[ai][bj][m][0], a1 = acc[ai][bj][m][1]; u32x4 w;
                        w.x = pk2(a0[0] * rs[bj][0], a0[1] * rs[bj][1]); w.y = pk2(a0[2] * rs[bj][2], a0[3] * rs[bj][3]); w.z = pk2(a1[0] * rs[bj][4], a1[1] * rs[bj][5]); w.w = pk2(a1[2] * rs[bj][6], a1[3] * rs[bj][7]);
                        *(u32x4*)(VT + (size_t)vr * T + u.pn * 256 + bj * 128 + wc * 32 + 8 * fq) = w; } }
        }
    }
};
struct EpiQK { bf16_t *Q, *K, *KT;
    __device__ __forceinline__ void operator()(EPI_ARGS) const {
        const int row0 = u.pm * 256 + wr * 64 + fr;
#pragma unroll
        for (int ai = 0; ai < 2; ++ai)
#pragma unroll
            for (int m = 0; m < 4; ++m) { const int row = row0 + ai * 128 + m * 16;
#pragma unroll
                for (int bj = 0; bj < 2; ++bj) { const f32x4 v0 = acc[ai][bj][m][0], v1 = acc[ai][bj][m][1]; const int cc = bj * 128 + wc * 32 + 8 * fq;
                    u32x4 w; w.x = pk2(v0[0], v0[1]); w.y = pk2(v0[2], v0[3]); w.z = pk2(v1[0], v1[1]); w.w = pk2(v1[2], v1[3]);
                    if (u.seg == 0) *(u32x4*)((u.pn == 0 ? Q : K) + (size_t)row * D + u.z * 256 + cc) = w;
                    else *(u32x4*)(KT + (size_t)(u.z * 256 + row) * T + u.pn * 256 + cc) = w; } }
    }
};
template <int MODE> struct EpiMerge { const bf16_t* G; float* YT; bf16_t* Y;
    __device__ __forceinline__ void operator()(EPI_ARGS) const {
        const int row0 = u.pm * 256 + wr * 64 + fr;
#pragma unroll
        for (int ai = 0; ai < 2; ++ai)
#pragma unroll
            for (int m = 0; m < 4; ++m) { const int row = row0 + ai * 128 + m * 16;
#pragma unroll
                for (int bj = 0; bj < 2; ++bj) { const size_t off = (size_t)row * D + u.pn * 256 + bj * 128 + wc * 32 + 8 * fq;
                    const u32x4 gw = *(const u32x4*)(G + off);
                    f32x4 g0 = {bflo(gw.x), bfhi(gw.x), bflo(gw.y), bfhi(gw.y)}, g1 = {bflo(gw.z), bfhi(gw.z), bflo(gw.w), bfhi(gw.w)};
                    f32x4 y0 = g0 * acc[ai][bj][m][0], y1 = g1 * acc[ai][bj][m][1];
                    if (MODE == 0) { *(f32x4*)(YT + off) = y0; *(f32x4*)(YT + off + 4) = y1; }
                    else { y0 += *(const f32x4*)(YT + off); y1 += *(const f32x4*)(YT + off + 4);
                        u32x4 w; w.x = pk2(y0[0], y0[1]); w.y = pk2(y0[2], y0[3]); w.z = pk2(y1[0], y1[1]); w.w = pk2(y1[2], y1[3]); *(u32x4*)(Y + off) = w; } } }
    }
};
constexpr size_t SC_STRIDE = (size_t)NH * T;
__device__ __forceinline__ void p4_conv(const P& p, size_t gtid, size_t gsz) {
    const bf16_t* U = DOP(const bf16_t, DO_U); bf16_t* CH = DOP(bf16_t, DO_CH);
    const float* cw = p.in[12]; const float* cb = p.in[13]; const float* stc = p.in[2];
    for (size_t idx = gtid; idx < (size_t)T * 128; idx += gsz) {
        const int row = (int)(idx >> 7), c8 = (int)(idx & 127) * 8;
        int t, Tl, seq; if (row < T_P) { t = row & (SEQ - 1); Tl = SEQ; seq = row >> 11; } else { t = (row - T_P) & 7; Tl = DEC_T; seq = (row - T_P) >> 3; }
        float a[8]; { const f32x4 b0 = *(const f32x4*)(cb + c8), b1 = *(const f32x4*)(cb + c8 + 4); a[0] = b0[0]; a[1] = b0[1]; a[2] = b0[2]; a[3] = b0[3]; a[4] = b1[0]; a[5] = b1[1]; a[6] = b1[2]; a[7] = b1[3]; }
        u32x4 ucur = {0u, 0u, 0u, 0u};
#pragma unroll
        for (int j = 0; j < 4; ++j) { const int tt = t - 3 + j; float uv[8];
            if (tt >= 0) { const u32x4 w = *(const u32x4*)(U + (size_t)(row - 3 + j) * D + c8); if (j == 3) ucur = w;
                uv[0] = bflo(w.x); uv[1] = bfhi(w.x); uv[2] = bflo(w.y); uv[3] = bfhi(w.y); uv[4] = bflo(w.z); uv[5] = bfhi(w.z); uv[6] = bflo(w.w); uv[7] = bfhi(w.w); }
            else if (row >= T_P) { const float* s = stc + ((size_t)seq * 3 + (3 + tt)) * D + c8; const f32x4 s0 = *(const f32x4*)s, s1 = *(const f32x4*)(s + 4);
                uv[0] = s0[0]; uv[1] = s0[1]; uv[2] = s0[2]; uv[3] = s0[3]; uv[4] = s1[0]; uv[5] = s1[1]; uv[6] = s1[2]; uv[7] = s1[3]; }
            else { for (int i = 0; i < 8; ++i) uv[i] = 0.f; }
            const f32x4 w0 = *(const f32x4*)(cw + j * D + c8), w1 = *(const f32x4*)(cw + j * D + c8 + 4);
            a[0] += uv[0] * w0[0]; a[1] += uv[1] * w0[1]; a[2] += uv[2] * w0[2]; a[3] += uv[3] * w0[3]; a[4] += uv[4] * w1[0]; a[5] += uv[5] * w1[1]; a[6] += uv[6] * w1[2]; a[7] += uv[7] * w1[3]; }
        u32x4 o; o.x = pk2(silu_(a[0]), silu_(a[1])); o.y = pk2(silu_(a[2]), silu_(a[3])); o.z = pk2(silu_(a[4]), silu_(a[5])); o.w = pk2(silu_(a[6]), silu_(a[7]));
        *(u32x4*)(CH + (size_t)row * D + c8) = o;
        if (t >= Tl - 3) { float* co = (row < T_P ? p.out + O_CONVP : p.out + O_CONVS) + ((size_t)seq * 3 + (t - (Tl - 3))) * D + c8;
            *(f32x4*)co = (f32x4){bflo(ucur.x), bfhi(ucur.x), bflo(ucur.y), bfhi(ucur.y)}; *(f32x4*)(co + 4) = (f32x4){bflo(ucur.z), bfhi(ucur.z), bflo(ucur.w), bfhi(ucur.w)}; }
    }
}
__device__ __forceinline__ void p4_gates(const P& p, int gw, int NGW, int lane) {
    const float* GATES = WSP(const float, M_GATES); float* SC = WSP(float, M_SC); const float* bif = p.in[16];
    for (int job = gw; job < 96; job += NGW) {
        const bool smp = job >= 32; const int h = smp ? (job - 32) & 3 : job & 3;
        const int W = smp ? 8 : 64, nch = smp ? 1 : 32; const int li = lane & (W - 1);
        const int seq = smp ? ((job - 32) >> 2) * 8 + (lane >> 3) : (job >> 2);
        float mprev = smp ? p.in[5][seq * NH + h] : 0.f;
        const float bi = bif[h], bfg = bif[NH + h];
        for (int c = 0; c < nch; ++c) {
            const int row = smp ? T_P + seq * 8 + li : seq * SEQ + c * 64 + lane;
            const float gi = GATES[(size_t)row * 32 + h] + bi, gf = GATES[(size_t)row * 32 + NH + h] + bfg;
            float b = logsigmoid_(gf);
            for (int o = 1; o < W; o <<= 1) { const float x = __shfl_up(b, o, W); if (li >= o) b += x; }
            const float a = gi - b; float cm = a;
            for (int o = 1; o < W; o <<= 1) { const float x = __shfl_up(cm, o, W); if (li >= o) cm = fmaxf(cm, x); }
            const float Mt = fmaxf(mprev, cm), mt = b + Mt;
            const float ML = __shfl(Mt, W - 1, W), bL = __shfl(b, W - 1, W);
            const size_t o = (size_t)h * T + row;
            SC[o] = a; SC[SC_STRIDE + o] = Mt; SC[2 * SC_STRIDE + o] = expf(mprev - Mt); SC[3 * SC_STRIDE + o] = expf(a - ML); SC[4 * SC_STRIDE + o] = expf(-mt);
            mprev = bL + ML;
        }
        if (li == W - 1) { if (smp) p.out[O_MS + (size_t)seq * NH + h] = mprev; else if (lane == 63) p.out[O_MP + (size_t)seq * NH + h] = mprev; }
    }
}
__device__ __forceinline__ void p4_gla(const P& p, int bid, int G, int tid) {
    const float* GATES = WSP(const float, M_GATES); const bf16_t* QG = DOP(const bf16_t, DO_QG); const bf16_t* KG = DOP(const bf16_t, DO_KG);
    bf16_t* QT = WSP(bf16_t, A_QT); bf16_t* KTn = WSP(bf16_t, G_KT); bf16_t* KTT = WSP(bf16_t, G_KTT); float* EAL = WSP(float, M_EAL);
    const int c = tid;
    float w2[16];
#pragma unroll
    for (int r = 0; r < 16; ++r) w2[r] = p.in[18][r * GKW + c];
    const float ba = p.in[19][c];
    for (int g = bid; g < NGRP; g += G) {
        const bool smp = g >= NCH_P; float A = 0.f;
        for (int t8 = 0; t8 < 8; ++t8) {
            unsigned kp[4] = {0u, 0u, 0u, 0u}; float eA = 1.f;
            if (smp) A = 0.f;
#pragma unroll
            for (int j = 0; j < 8; ++j) {
                const int row = g * 64 + t8 * 8 + j;
                const f32x4* ag = (const f32x4*)(GATES + (size_t)row * 32 + 8); float s = ba;
#pragma unroll
                for (int r4 = 0; r4 < 4; ++r4) { const f32x4 a4 = ag[r4]; s += a4[0] * w2[4 * r4] + a4[1] * w2[4 * r4 + 1] + a4[2] * w2[4 * r4 + 2] + a4[3] * w2[4 * r4 + 3]; }
                A += logsigmoid_(s) * 0.0625f;
                const float q = bf2f(QG[(size_t)row * GKW + c]), k = bf2f(KG[(size_t)row * GKW + c]);
                eA = expf(A); const float kt = k / eA;
                QT[(size_t)row * GKW + c] = (bf16_t)f2bf(q * 0.08838834764831845f * eA);
                const unsigned kb = f2bf(kt); KTn[(size_t)row * GKW + c] = (bf16_t)kb;
                if (j & 1) kp[j >> 1] |= kb << 16; else kp[j >> 1] = kb;
            }
            { u32x4 w = {kp[0], kp[1], kp[2], kp[3]}; *(u32x4*)(KTT + (size_t)c * T + g * 64 + t8 * 8) = w; }
            if (smp) EAL[(size_t)(256 + (g - NCH_P) * 8 + t8) * GKW + c] = eA;
            else if (t8 == 7) EAL[(size_t)g * GKW + c] = eA;
        }
    }
}

#define MFMA16(a, b, c) __builtin_amdgcn_mfma_f32_16x16x32_bf16(a, b, c, 0, 0, 0)
#define LBAR() do { asm volatile("s_waitcnt lgkmcnt(0)" ::: "memory"); __builtin_amdgcn_s_barrier(); asm volatile("" ::: "memory"); } while (0)
template <bool ML>
__device__ __forceinline__ void scan_prompt(const P& p, LAS unsigned char* lds, int b, int h, int es) {
    constexpr int DK = ML ? 256 : 128, ES = ML ? 64 : 128, NE = ML ? 80 : 128, NET = NE / 16, NDT = DK / 128  , KS = DK / 32;
    constexpr int QS = DK * 2 + 16, VS = 144;
    constexpr int OFF_Q = 0, OFF_K = OFF_Q + 64 * QS, OFF_V = OFF_K + 64 * QS, OFF_S = OFF_V + NE * VS, OFF_C = OFF_S + 64 * VS, OFF_SC = OFF_C + NE * QS;
    static_assert(OFF_SC + 1024 <= 140 * 1024, "scan LDS");
    constexpr int NT = NET * 4, TPW = (NT + 7) / 8;
    constexpr int QPT = 64 * (DK / 8) / NTHR, VPT = ES * 8 / NTHR;
    int tid_ = threadIdx.x; asm volatile("" : "+v"(tid_));
    const int tid = tid_, w = __builtin_amdgcn_readfirstlane(tid >> 6), lane = tid & 63, fr = lane & 15, fq = lane >> 4;
    const size_t row0 = (size_t)b * SEQ;
    const bf16_t* Qg = ML ? WSP(const bf16_t, A_Q) + row0 * D + h * 256 : WSP(const bf16_t, A_QT) + row0 * GKW + h * 128;
    const bf16_t* Kg = ML ? WSP(const bf16_t, A_K) + row0 * D + h * 256 : WSP(const bf16_t, G_KT) + row0 * GKW + h * 128;
    constexpr int LDQ = ML ? D : GKW;
    const bf16_t* VTg = WSP(const bf16_t, WS_VT) + (size_t)((ML ? 0 : 1024) + h * 256 + es * ES) * T + row0;
    const bf16_t* KTg = (ML ? WSP(const bf16_t, WS_KT) + (size_t)(h * 256) * T : WSP(const bf16_t, G_KTT) + (size_t)(h * 128) * T) + row0;
    const float* SC = WSP(const float, M_SC) + (size_t)h * T + row0;
    const float* EALg = WSP(const float, M_EAL) + (size_t)(b * 32) * GKW + h * 128;
    bf16_t* OUT = ML ? WSP(bf16_t, WS_HN) : WSP(bf16_t, WS_XBF);
    LAS float* scal = (LAS float*)(lds + OFF_SC);
    for (int i = tid; i < NE * QS / 4; i += NTHR) ((LAS unsigned*)(lds + OFF_C))[i] = 0u;
    if (ML) for (int i = tid; i < 16 * VS / 4; i += NTHR) ((LAS unsigned*)(lds + OFF_V + ES * VS))[i] = (i < VS / 4) ? 0x3f803f80u : 0u;
    f32x4 accC[NDT][NET];
#pragma unroll
    for (int a = 0; a < NDT; ++a)
#pragma unroll
        for (int e = 0; e < NET; ++e) accC[a][e] = (f32x4){0.f, 0.f, 0.f, 0.f};
    u32x4 sq[QPT], sk[QPT], sv[VPT]; float ssc = 0.f;
#define STAGE_LOAD(c_) do { const size_t r0_ = (size_t)(c_) * 64; \
        _Pragma("unroll") for (int j = 0; j < QPT; ++j) { const int i = tid + NTHR * j, rr = i / (DK / 8), cc = i % (DK / 8); sq[j] = *(const u32x4*)(Qg + (r0_ + rr) * LDQ + cc * 8); sk[j] = *(const u32x4*)(Kg + (r0_ + rr) * LDQ + cc * 8); } \
        _Pragma("unroll") for (int j = 0; j < VPT; ++j) { const int i = tid + NTHR * j, rr = i >> 3, cc = i & 7; sv[j] = *(const u32x4*)(VTg + (size_t)rr * T + r0_ + cc * 8); } \
        if (ML && tid < 256) ssc = SC[(size_t)((tid >> 6) == 3 ? 4 : (tid >> 6)) * SC_STRIDE + r0_ + (tid & 63)]; } while (0)
#define STAGE_WRITE() do { \
        _Pragma("unroll") for (int j = 0; j < QPT; ++j) { const int i = tid + NTHR * j, rr = i / (DK / 8), cc = i % (DK / 8); *(LAS u32x4*)(lds + OFF_Q + rr * QS + cc * 16) = sq[j]; *(LAS u32x4*)(lds + OFF_K + rr * QS + cc * 16) = sk[j]; } \
        _Pragma("unroll") for (int j = 0; j < VPT; ++j) { const int i = tid + NTHR * j, rr = i >> 3, cc = i & 7; *(LAS u32x4*)(lds + OFF_V + rr * VS + cc * 16) = sv[j]; } \
        if (ML && tid < 256) scal[tid] = ssc; } while (0)
    STAGE_LOAD(0); STAGE_WRITE(); LBAR();
    for (int c = 0; c < 32; ++c) {
        const size_t r0 = (size_t)c * 64;
        if (c + 1 < 32) STAGE_LOAD(c + 1);
        bf16x8 kt[NDT][2];
#pragma unroll
        for (int a = 0; a < NDT; ++a)
#pragma unroll
            for (int ks = 0; ks < 2; ++ks) kt[a][ks] = *(const bf16x8*)(KTg + (size_t)(16 * (NDT * w + a) + fr) * T + r0 + ks * 32 + 8 * fq);
        const int st = w & 3, tt0 = 2 * (w >> 2);
        f32x4 accS[2] = {(f32x4){0.f, 0.f, 0.f, 0.f}, (f32x4){0.f, 0.f, 0.f, 0.f}};
#pragma unroll
        for (int ks = 0; ks < KS; ++ks) { const bf16x8 af = *(const LAS bf16x8*)(lds + OFF_K + (16 * st + fr) * QS + ks * 64 + fq * 16);
#pragma unroll
            for (int j = 0; j < 2; ++j) { const bf16x8 bfr = *(const LAS bf16x8*)(lds + OFF_Q + (16 * (tt0 + j) + fr) * QS + ks * 64 + fq * 16); accS[j] = MFMA16(af, bfr, accS[j]); } }
#pragma unroll
        for (int j = 0; j < 2; ++j) { const int t = 16 * (tt0 + j) + fr, s0 = 16 * st + 4 * fq; float v[4];
#pragma unroll
            for (int r = 0; r < 4; ++r) { const int s = s0 + r; float x = accS[j][r]; if (ML) x *= __expf(scal[s] - scal[64 + t]); v[r] = (s <= t) ? x : 0.f; }
            u32x2 wv; wv.x = pk2(v[0], v[1]); wv.y = pk2(v[2], v[3]); *(LAS u32x2*)(lds + OFF_S + t * VS + s0 * 2) = wv; }
        f32x4 accO[TPW];
#pragma unroll
        for (int j = 0; j < TPW; ++j) { accO[j] = (f32x4){0.f, 0.f, 0.f, 0.f}; const int id = w + 8 * j;
            if (id < NT) { const int et = id >> 2, tt = id & 3;
#pragma unroll
                for (int ks = 0; ks < KS; ++ks) { const bf16x8 af = *(const LAS bf16x8*)(lds + OFF_C + (16 * et + fr) * QS + ks * 64 + fq * 16), bfr = *(const LAS bf16x8*)(lds + OFF_Q + (16 * tt + fr) * QS + ks * 64 + fq * 16);
                    accO[j] = MFMA16(af, bfr, accO[j]); } } }
        LBAR();
#pragma unroll
        for (int j = 0; j < TPW; ++j) { const int id = w + 8 * j;
            if (id < NT) { const int et = id >> 2, tt = id & 3, t = 16 * tt + fr;
                if (ML) accO[j] = accO[j] * scal[128 + t];
#pragma unroll
                for (int ks = 0; ks < 2; ++ks) { const bf16x8 af = *(const LAS bf16x8*)(lds + OFF_V + (16 * et + fr) * VS + ks * 64 + fq * 16), bfr = *(const LAS bf16x8*)(lds + OFF_S + t * VS + ks * 64 + fq * 16);
                    accO[j] = MFMA16(af, bfr, accO[j]); }
                const size_t grow = row0 + r0 + t;
                if (!ML || et < 4) { u32x2 wv; wv.x = pk2(accO[j][0], accO[j][1]); wv.y = pk2(accO[j][2], accO[j][3]); *(u32x2*)(OUT + grow * D + h * 256 + es * ES + 16 * et + 4 * fq) = wv; }
                else if (es == 0 && fq == 0) WSP(float, M_DEN)[grow * 4 + h] = fmaxf(fabsf(accO[j][0]), scal[192 + t]); } }
        if (ML) { const float dec = scal[128 + 63];
#pragma unroll
            for (int a = 0; a < NDT; ++a)
#pragma unroll
                for (int e = 0; e < NET; ++e) accC[a][e] = accC[a][e] * dec;
#pragma unroll
            for (int ks = 0; ks < 2; ++ks) { const f32x4 w0 = *(const f32x4*)(SC + 3 * SC_STRIDE + r0 + ks * 32 + 8 * fq), w1 = *(const f32x4*)(SC + 3 * SC_STRIDE + r0 + ks * 32 + 8 * fq + 4);
#pragma unroll
                for (int a = 0; a < NDT; ++a) { const u32x4 kw = __builtin_bit_cast(u32x4, kt[a][ks]); u32x4 o;
                    o.x = pk2(bflo(kw.x) * w0[0], bfhi(kw.x) * w0[1]); o.y = pk2(bflo(kw.y) * w0[2], bfhi(kw.y) * w0[3]); o.z = pk2(bflo(kw.z) * w1[0], bfhi(kw.z) * w1[1]); o.w = pk2(bflo(kw.w) * w1[2], bfhi(kw.w) * w1[3]);
                    kt[a][ks] = __builtin_bit_cast(bf16x8, o); } } }
#pragma unroll
        for (int ks = 0; ks < 2; ++ks)
#pragma unroll
            for (int e = 0; e < NET; ++e) { const bf16x8 bfr = *(const LAS bf16x8*)(lds + OFF_V + (16 * e + fr) * VS + ks * 64 + fq * 16);
#pragma unroll
                for (int a = 0; a < NDT; ++a) accC[a][e] = MFMA16(kt[a][ks], bfr, accC[a][e]); }
        if (!ML) {
#pragma unroll
            for (int a = 0; a < NDT; ++a) { const f32x4 ea = *(const f32x4*)(EALg + (size_t)c * GKW + 16 * (NDT * w + a) + 4 * fq);
#pragma unroll
                for (int e = 0; e < NET; ++e) accC[a][e] = accC[a][e] * ea; } }
        LBAR();
#pragma unroll
        for (int a = 0; a < NDT; ++a)
#pragma unroll
            for (int e = 0; e < NET; ++e) { u32x2 wv; wv.x = pk2(accC[a][e][0], accC[a][e][1]); wv.y = pk2(accC[a][e][2], accC[a][e][3]);
                *(LAS u32x2*)(lds + OFF_C + (16 * e + fr) * QS + (16 * (NDT * w + a) + 4 * fq) * 2) = wv; }
        if (c + 1 < 32) STAGE_WRITE();
        LBAR();
    }
    if (ML) { float* Cp = p.out + O_CP + (size_t)(b * NH + h) * HD * HD; float* np = p.out + O_NP + (size_t)(b * NH + h) * HD;
#pragma unroll
        for (int a = 0; a < NDT; ++a) { const int d = 16 * (NDT * w + a) + 4 * fq;
#pragma unroll
            for (int e = 0; e < 4; ++e) *(f32x4*)(Cp + (size_t)(es * 64 + 16 * e + fr) * HD + d) = accC[a][e];
            if (es == 0 && fr == 0) *(f32x4*)(np + d) = accC[a][NET - 1]; }
    } else { float* Sp = p.out + O_SP + (size_t)(b * NH + h) * GDK * GDV;
#pragma unroll
        for (int a = 0; a < NDT; ++a)
#pragma unroll
            for (int e = 0; e < NET; ++e)
#pragma unroll
                for (int r = 0; r < 4; ++r) Sp[(size_t)(16 * (NDT * w + a) + 4 * fq + r) * GDV + es * 128 + 16 * e + fr] = accC[a][e][r]; }
#undef STAGE_LOAD
#undef STAGE_WRITE
    LBAR();
}
#define SBAR() __syncthreads()
__device__ __forceinline__ void sample_ml(const P& p, LAS unsigned char* lds, int seq, int h) {
    LAS float* qf = (LAS float*)lds; LAS float* kf = qf + 2048; LAS float* vf = kf + 2048; LAS float* n0s = vf + 2048; LAS float* sS = n0s + 256; LAS float* sc = sS + 64; LAS float* qn = sc + 40; LAS float* part = (LAS float*)(lds + 32768);
    int tid_ = threadIdx.x; asm volatile("" : "+v"(tid_));
    const int tid = tid_, w = __builtin_amdgcn_readfirstlane(tid >> 6), lane = tid & 63, fr = lane & 15, fq = lane >> 4;
    const size_t R0 = (size_t)T_P + (size_t)seq * 8, sh = (size_t)seq * NH + h;
    { const int t = tid >> 6, d4 = (tid & 63) * 4;
      const u32x2 qw = *(const u32x2*)(WSP(const bf16_t, A_Q) + (R0 + t) * D + h * 256 + d4), kw = *(const u32x2*)(WSP(const bf16_t, A_K) + (R0 + t) * D + h * 256 + d4);
      *(LAS f32x4*)(qf + t * 256 + d4) = (f32x4){bflo(qw.x), bfhi(qw.x), bflo(qw.y), bfhi(qw.y)}; *(LAS f32x4*)(kf + t * 256 + d4) = (f32x4){bflo(kw.x), bfhi(kw.x), bflo(kw.y), bfhi(kw.y)}; }
    if (tid < 256) { const u32x4 vw = *(const u32x4*)(WSP(const bf16_t, WS_VT) + (size_t)(h * 256 + tid) * T + R0);
        vf[0 * 256 + tid] = bflo(vw.x); vf[1 * 256 + tid] = bfhi(vw.x); vf[2 * 256 + tid] = bflo(vw.y); vf[3 * 256 + tid] = bfhi(vw.y); vf[4 * 256 + tid] = bflo(vw.z); vf[5 * 256 + tid] = bfhi(vw.z); vf[6 * 256 + tid] = bflo(vw.w); vf[7 * 256 + tid] = bfhi(vw.w);
        n0s[tid] = p.in[4][sh * HD + tid]; }
    if (tid < 40) sc[tid] = WSP(const float, M_SC)[(size_t)(tid >> 3) * SC_STRIDE + (size_t)h * T + R0 + (tid & 7)];
    SBAR();
    if (tid < 64) { const int t = tid >> 3, s = tid & 7; float dot = 0.f;
        for (int d = 0; d < 256; ++d) dot += qf[t * 256 + d] * kf[s * 256 + d];
        sS[tid] = (s <= t) ? dot * expf(sc[s] - sc[8 + t]) : 0.f; }
    else if (tid < 72) { const int t = tid - 64; float dot = 0.f; for (int d = 0; d < 256; ++d) dot += qf[t * 256 + d] * n0s[d]; qn[t] = dot; }
    SBAR();
    if (tid < 8) { float den = sc[16 + tid] * qn[tid]; for (int s = 0; s < 8; ++s) den += sS[tid * 8 + s]; WSP(float, M_DEN)[(R0 + tid) * 4 + h] = fmaxf(fabsf(den), sc[32 + tid]); }
    const int d0 = 32 * w + 8 * fq; const float dec = sc[16 + 7];
    float kr[8][8];
#pragma unroll
    for (int s = 0; s < 8; ++s) { const f32x4 k0 = *(const LAS f32x4*)(kf + s * 256 + d0), k1 = *(const LAS f32x4*)(kf + s * 256 + d0 + 4); const float ws_ = sc[24 + s];
        kr[s][0] = k0[0] * ws_; kr[s][1] = k0[1] * ws_; kr[s][2] = k0[2] * ws_; kr[s][3] = k0[3] * ws_; kr[s][4] = k1[0] * ws_; kr[s][5] = k1[1] * ws_; kr[s][6] = k1[2] * ws_; kr[s][7] = k1[3] * ws_; }
    bf16x8 qfrag; { u32x4 o = {0u, 0u, 0u, 0u}; if (fr < 8) { const f32x4 q0 = *(const LAS f32x4*)(qf + fr * 256 + d0), q1 = *(const LAS f32x4*)(qf + fr * 256 + d0 + 4);
        o.x = pk2(q0[0], q0[1]); o.y = pk2(q0[2], q0[3]); o.z = pk2(q1[0], q1[1]); o.w = pk2(q1[2], q1[3]); } qfrag = __builtin_bit_cast(bf16x8, o); }
    if (fr == 0) { float nn[8];
#pragma unroll
        for (int j = 0; j < 8; ++j) { float a = dec * n0s[d0 + j];
#pragma unroll
            for (int s = 0; s < 8; ++s) a += kr[s][j]; nn[j] = a; }
        float* no = p.out + O_NS + sh * HD + d0; *(f32x4*)no = (f32x4){nn[0], nn[1], nn[2], nn[3]}; *(f32x4*)(no + 4) = (f32x4){nn[4], nn[5], nn[6], nn[7]}; }
    const float* C0 = p.in[3] + sh * HD * HD; float* Cn = p.out + O_CS + sh * HD * HD;
#pragma unroll 2
    for (int strip = 0; strip < 16; ++strip) { const int e = 16 * strip + fr;
        const f32x4 c0 = *(const f32x4*)(C0 + (size_t)e * HD + d0), c1 = *(const f32x4*)(C0 + (size_t)e * HD + d0 + 4);
        float cn[8] = {c0[0] * dec, c0[1] * dec, c0[2] * dec, c0[3] * dec, c1[0] * dec, c1[1] * dec, c1[2] * dec, c1[3] * dec};
#pragma unroll
        for (int s = 0; s < 8; ++s) { const float vv = vf[s * 256 + e];
#pragma unroll
            for (int j = 0; j < 8; ++j) cn[j] += vv * kr[s][j]; }
        *(f32x4*)(Cn + (size_t)e * HD + d0) = (f32x4){cn[0], cn[1], cn[2], cn[3]}; *(f32x4*)(Cn + (size_t)e * HD + d0 + 4) = (f32x4){cn[4], cn[5], cn[6], cn[7]};
        u32x4 o; o.x = pk2(c0[0], c0[1]); o.y = pk2(c0[2], c0[3]); o.z = pk2(c1[0], c1[1]); o.w = pk2(c1[2], c1[3]);
        const f32x4 acc = MFMA16(__builtin_bit_cast(bf16x8, o), qfrag, ((f32x4){0.f, 0.f, 0.f, 0.f}));
        if (fr < 8) {
#pragma unroll
            for (int r = 0; r < 4; ++r) part[(size_t)(w * 256 + 16 * strip + 4 * fq + r) * 8 + fr] = acc[r]; } }
    SBAR();
    { const int t = tid >> 6, e4 = (tid & 63) * 4; float o4[4];
#pragma unroll
      for (int i = 0; i < 4; ++i) { float qc = 0.f;
#pragma unroll
          for (int ww = 0; ww < 8; ++ww) qc += part[(size_t)(ww * 256 + e4 + i) * 8 + t];
          float a = sc[16 + t] * qc;
#pragma unroll
          for (int s = 0; s < 8; ++s) a += sS[t * 8 + s] * vf[s * 256 + e4 + i];
          o4[i] = a; }
      u32x2 wv; wv.x = pk2(o4[0], o4[1]); wv.y = pk2(o4[2], o4[3]); *(u32x2*)(WSP(bf16_t, WS_HN) + (R0 + t) * D + h * 256 + e4) = wv; }
    SBAR();
}
__device__ __forceinline__ void sample_gla(const P& p, LAS unsigned char* lds, int seq, int h) {
    LAS float* qf = (LAS float*)lds; LAS float* kf = qf + 1024; LAS float* vf = kf + 1024; LAS float* eal = vf + 2048; LAS float* att = eal + 128; LAS float* part = (LAS float*)(lds + 32768);
    int tid_ = threadIdx.x; asm volatile("" : "+v"(tid_));
    const int tid = tid_, w = __builtin_amdgcn_readfirstlane(tid >> 6), lane = tid & 63;
    const size_t R0 = (size_t)T_P + (size_t)seq * 8, sh = (size_t)seq * NH + h;
    { const int t = tid >> 6, d2 = (tid & 63) * 2;
      const unsigned qw = *(const unsigned*)(WSP(const bf16_t, A_QT) + (R0 + t) * GKW + h * 128 + d2), kw = *(const unsigned*)(WSP(const bf16_t, G_KT) + (R0 + t) * GKW + h * 128 + d2);
      qf[t * 128 + d2] = bflo(qw); qf[t * 128 + d2 + 1] = bfhi(qw); kf[t * 128 + d2] = bflo(kw); kf[t * 128 + d2 + 1] = bfhi(kw); }
    if (tid < 256) { const u32x4 vw = *(const u32x4*)(WSP(const bf16_t, WS_VT) + (size_t)(1024 + h * 256 + tid) * T + R0);
        vf[0 * 256 + tid] = bflo(vw.x); vf[1 * 256 + tid] = bfhi(vw.x); vf[2 * 256 + tid] = bflo(vw.y); vf[3 * 256 + tid] = bfhi(vw.y); vf[4 * 256 + tid] = bflo(vw.z); vf[5 * 256 + tid] = bfhi(vw.z); vf[6 * 256 + tid] = bflo(vw.w); vf[7 * 256 + tid] = bfhi(vw.w); }
    else if (tid < 384) eal[tid - 256] = WSP(const float, M_EAL)[(size_t)(256 + seq) * GKW + h * 128 + (tid - 256)];
    SBAR();
    if (tid < 64) { const int t = tid >> 3, s = tid & 7; float dot = 0.f; for (int d = 0; d < 128; ++d) dot += qf[t * 128 + d] * kf[s * 128 + d]; att[tid] = (s <= t) ? dot : 0.f; }
    const int e4 = 4 * lane;
    f32x4 vr[8], ai[8];
#pragma unroll
    for (int s = 0; s < 8; ++s) { vr[s] = *(const LAS f32x4*)(vf + s * 256 + e4); ai[s] = (f32x4){0.f, 0.f, 0.f, 0.f}; }
    const float* S0 = p.in[6] + sh * GDK * GDV; float* Sn = p.out + O_SS + sh * GDK * GDV;
#pragma unroll 2
    for (int dd = 0; dd < 16; ++dd) { const int d = 16 * w + dd;
        const f32x4 s0 = *(const f32x4*)(S0 + (size_t)d * GDV + e4); f32x4 up = s0;
#pragma unroll
        for (int s = 0; s < 8; ++s) { up += vr[s] * kf[s * 128 + d]; ai[s] += s0 * qf[s * 128 + d]; }
        *(f32x4*)(Sn + (size_t)d * GDV + e4) = up * eal[d]; }
#pragma unroll
    for (int t = 0; t < 8; ++t) *(LAS f32x4*)(part + (size_t)(w * 8 + t) * 256 + e4) = ai[t];
    SBAR();
    { const int t = tid >> 6; f32x4 o = {0.f, 0.f, 0.f, 0.f};
#pragma unroll
      for (int ww = 0; ww < 8; ++ww) o += *(const LAS f32x4*)(part + (size_t)(ww * 8 + t) * 256 + e4);
#pragma unroll
      for (int s = 0; s < 8; ++s) o += *(const LAS f32x4*)(vf + s * 256 + e4) * att[t * 8 + s];
      u32x2 wv; wv.x = pk2(o[0], o[1]); wv.y = pk2(o[2], o[3]); *(u32x2*)(WSP(bf16_t, WS_XBF) + (R0 + t) * D + h * 256 + e4) = wv; }
    SBAR();
}
__device__ __forceinline__ void p5_scan(const P& p, LAS unsigned char* lds, int bid, int G, unsigned* counter) {
    for (int it = bid; it < 192; it += G) {
        if (it < 128) scan_prompt<true>(p, lds, it >> 4, (it >> 2) & 3, it & 3);
        else { const int i = it - 128; scan_prompt<false>(p, lds, i >> 3, (i >> 1) & 3, i & 1); }
    }
    LAS int* slot = (LAS int*)(lds + 140 * 1024);
    for (;;) {
        if (threadIdx.x == 0) *slot = (int)atomicAdd(counter, 1u);
        SBAR();
        const int it = *slot;
        SBAR();
        if (it >= 1024) break;
        if (it < 512) sample_ml(p, lds, it >> 2, it & 3); else sample_gla(p, lds, (it - 512) >> 2, it & 3);
    }
}
__device__ __forceinline__ void p5b_norm(const P& p, int gw, int NGW, int lane) {
    const bf16_t* HN = WSP(const bf16_t, WS_HN); const bf16_t* OG = WSP(const bf16_t, WS_XBF); const bf16_t* SIGO = WSP(const bf16_t, S_SIGO); const bf16_t* SILUR = WSP(const bf16_t, S_SILUR);
    bf16_t* HM = WSP(bf16_t, A_Q); bf16_t* OGN = WSP(bf16_t, A_K); const float* DEN = WSP(const float, M_DEN);
    const int h = lane >> 4, c0 = h * 256 + (lane & 15) * 16;
    float gm[16], gg[16];
#pragma unroll
    for (int i = 0; i < 16; ++i) { gm[i] = p.in[17][c0 + i]; gg[i] = p.in[20][c0 + i]; }
    for (int row = gw; row < T; row += NGW) {
#pragma unroll
        for (int br = 0; br < 2; ++br) {
            const bf16_t* src = (br == 0 ? HN : OG) + (size_t)row * D + c0; const bf16_t* gsrc = (br == 0 ? SIGO : SILUR) + (size_t)row * D + c0;
            const u32x4 a = *(const u32x4*)src, b = *(const u32x4*)(src + 8), ga = *(const u32x4*)gsrc, gb = *(const u32x4*)(gsrc + 8);
            float v[16] = {bflo(a.x), bfhi(a.x), bflo(a.y), bfhi(a.y), bflo(a.z), bfhi(a.z), bflo(a.w), bfhi(a.w), bflo(b.x), bfhi(b.x), bflo(b.y), bfhi(b.y), bflo(b.z), bfhi(b.z), bflo(b.w), bfhi(b.w)};
            float gt[16] = {bflo(ga.x), bfhi(ga.x), bflo(ga.y), bfhi(ga.y), bflo(ga.z), bfhi(ga.z), bflo(ga.w), bfhi(ga.w), bflo(gb.x), bfhi(gb.x), bflo(gb.y), bfhi(gb.y), bflo(gb.z), bfhi(gb.z), bflo(gb.w), bfhi(gb.w)};
            float ss = 0.f;
#pragma unroll
            for (int i = 0; i < 16; ++i) ss += v[i] * v[i];
            ss += __shfl_xor(ss, 1); ss += __shfl_xor(ss, 2); ss += __shfl_xor(ss, 4); ss += __shfl_xor(ss, 8);
            float extra = EPS; if (br == 0) { const float dn = DEN[(size_t)row * 4 + h]; extra = EPS * dn * dn; }
            const float sc = 1.f / sqrtf(ss * (1.f / 256.f) + extra);
            unsigned o[8];
#pragma unroll
            for (int i = 0; i < 8; ++i) { const float g0 = br == 0 ? gm[2 * i] : gg[2 * i], g1 = br == 0 ? gm[2 * i + 1] : gg[2 * i + 1]; o[i] = pk2(gt[2 * i] * g0 * v[2 * i] * sc, gt[2 * i + 1] * g1 * v[2 * i + 1] * sc); }
            bf16_t* dst = (br == 0 ? HM : OGN) + (size_t)row * D + c0;
            *(u32x4*)dst = (u32x4){o[0], o[1], o[2], o[3]}; *(u32x4*)(dst + 8) = (u32x4){o[4], o[5], o[6], o[7]};
        }
    }
}
__device__ __forceinline__ void p10_final(const P& p, int gw, int NGW, int lane) {
    const f32x4* g4 = (const f32x4*)p.in[27] + lane; f32x4 g[4];
#pragma unroll
    for (int j = 0; j < 4; ++j) g[j] = g4[64 * j];
    for (int row = gw; row < T; row += NGW) {
        f32x4* xr = (f32x4*)(p.out + (size_t)row * D) + lane; f32x4 v[4]; float s = 0.f;
#pragma unroll
        for (int j = 0; j < 4; ++j) { v[j] = xr[64 * j]; s += (v[j].x * v[j].x + v[j].y * v[j].y) + (v[j].z * v[j].z + v[j].w * v[j].w); }
        const float rs = 1.f / sqrtf(wave_sum(s) * (1.f / D) + EPS);
#pragma unroll
        for (int j = 0; j < 4; ++j) xr[64 * j] = v[j] * rs * g[j];
    }
}
constexpr int LDS_BYTES = 147456;
constexpr int CW_CNT = 64;
#ifndef MK_PH_LO
#define MK_PH_LO 0
#endif
#ifndef MK_PH_HI
#define MK_PH_HI 99
#endif
__global__ void __launch_bounds__(NTHR, 2) mk_fwd(P p) {
    cg::grid_group grid = cg::this_grid();
    extern __shared__ __attribute__((aligned(16))) unsigned char lds_raw[];
    LAS unsigned char* lds = (LAS unsigned char*)lds_raw;
    const int bid = blockIdx.x, G = gridDim.x, NGW = G * NWAVES; const size_t gsz = (size_t)G * NTHR;
#define TIDX() int tid = threadIdx.x; asm volatile("" : "+v"(tid)); const int lane = tid & 63, wave = __builtin_amdgcn_readfirstlane(tid >> 6), gw = bid * NWAVES + wave; const size_t gtid = (size_t)bid * NTHR + tid; (void)lane; (void)gw; (void)gtid
    float* SSQ = WSP(float, M_SSQ); float* XRES = p.out;
    bf16_t* XBF = WSP(bf16_t, WS_XBF); bf16_t* ACT = WSP(bf16_t, WS_ACT);
    constexpr int NM = T / 256;
#define PH(k) (MK_PH_LO <= (k) && (k) <= MK_PH_HI)
    if (PH(0)) { TIDX(); p0_prologue(p, lds, gw, NGW, wave, lane); }
    grid.sync();
    if (PH(1)) { pg8::Gemm g{XBF, WSP(bf16_t, W_UP1), nullptr, nullptr, D, D, D, 0, 0}; pg8::Sched S; S.init(NM, 2 * FF / 256, 1, 0, 0, 0, G, bid);
        EpiUp E{SSQ, ACT}; pg8::gemm_phase(lds, g, S, E); }
    grid.sync();
    if (PH(2)) { pg8::Gemm g{ACT, WSP(bf16_t, W_DN1), nullptr, nullptr, FF, FF, FF, 0, 0}; pg8::Sched S; S.init(NM, D / 256, 1, 0, 0, 0, G, bid);
        EpiRes<true> E{p.in[0], p.in[1] - (size_t)T_P * D, XRES, XBF, SSQ, 0.5f}; pg8::gemm_phase(lds, g, S, E); }
    grid.sync();
    if (PH(3)) { const bf16_t* Wi = WSP(bf16_t, W_IN); pg8::Gemm g{XBF, Wi, Wi + (size_t)6400 * D, XBF, D, D, D, 0, 0}; pg8::Sched S; S.init(NM, 25, 1, 8, NM, 1, G, bid);
        EpiIn E{SSQ, DOP(bf16_t, DO_U), WSP(bf16_t, S_SIGO), DOP(bf16_t, DO_QG), DOP(bf16_t, DO_KG), WSP(bf16_t, S_SILUR), WSP(bf16_t, S_SIGA), WSP(bf16_t, S_SIGB), WSP(bf16_t, WS_VT), WSP(float, M_GATES)};
        pg8::gemm_phase(lds, g, S, E); }
    grid.sync();
    if (PH(4)) { TIDX(); p4_gates(p, gw, NGW, lane); p4_gla(p, bid, G, tid); p4_conv(p, gtid, gsz); }
    grid.sync();
    if (PH(5)) { const bf16_t* Wqk = WSP(bf16_t, W_QK); const bf16_t* CH = DOP(bf16_t, DO_CH); pg8::Gemm g{CH, Wqk, Wqk + (size_t)256 * D, CH, D, D, 256, 256, 256}; pg8::Sched S; S.init(NM, 2, 4, 1, NM, 4, G, bid);
        EpiQK E{WSP(bf16_t, A_Q), WSP(bf16_t, A_K), WSP(bf16_t, WS_KT)}; pg8::gemm_phase(lds, g, S, E); }
    grid.sync();
    if (PH(6)) { p5_scan(p, lds, bid, G, (unsigned*)(p.ws + WS_CTL) + CW_CNT); }
    grid.sync();
    if (PH(7)) { TIDX(); p5b_norm(p, gw, NGW, lane); }
    grid.sync();
    if (PH(8)) { pg8::Sched S; S.init(NM, D / 256, 1, 0, 0, 0, G, bid); float* YT = WSP(float, WS_VT); bf16_t* Y = WSP(bf16_t, WS_KT);
        { pg8::Gemm g{WSP(bf16_t, A_Q), WSP(bf16_t, W_PA), nullptr, nullptr, D, D, D, 0, 0}; EpiMerge<0> E{WSP(bf16_t, S_SIGA), YT, Y}; pg8::gemm_phase(lds, g, S, E); }
        { pg8::Gemm g{WSP(bf16_t, A_K), WSP(bf16_t, W_PB), nullptr, nullptr, D, D, D, 0, 0}; EpiMerge<1> E{WSP(bf16_t, S_SIGB), YT, Y}; pg8::gemm_phase(lds, g, S, E); } }
    grid.sync();
    if (PH(9)) { pg8::Gemm g{WSP(bf16_t, WS_KT), WSP(bf16_t, W_O), nullptr, nullptr, D, D, D, 0, 0}; pg8::Sched S; S.init(NM, D / 256, 1, 0, 0, 0, G, bid);
        EpiRes<true> E{XRES, XRES, XRES, XBF, SSQ, 1.0f}; pg8::gemm_phase(lds, g, S, E); }
    grid.sync();
    if (PH(10)) { pg8::Gemm g{XBF, WSP(bf16_t, W_UP2), nullptr, nullptr, D, D, D, 0, 0}; pg8::Sched S; S.init(NM, 2 * FF / 256, 1, 0, 0, 0, G, bid);
        EpiUp E{SSQ, ACT}; pg8::gemm_phase(lds, g, S, E); }
    grid.sync();
    if (PH(11)) { pg8::Gemm g{ACT, WSP(bf16_t, W_DN2), nullptr, nullptr, FF, FF, FF, 0, 0}; pg8::Sched S; S.init(NM, D / 256, 1, 0, 0, 0, G, bid);
        EpiRes<false> E{XRES, XRES, XRES, XBF, SSQ, 0.5f}; pg8::gemm_phase(lds, g, S, E); }
    grid.sync();
    if (PH(12)) { TIDX(); p10_final(p, gw, NGW, lane); }
#undef PH
#undef TIDX
}
}

static int mk_launch(void* const* d_in, const int* in_sizes, int n_in, void* d_out, int out_size, void* d_ws, size_t ws_size, hipStream_t stream) {
    static int grid = 0;
    if (grid == 0) {
        if (n_in != 28 || (size_t)out_size != mk::O_END || ws_size < mk::WS_END) { fprintf(stderr, "kernel_launch: built for 28 inputs, %zu outputs, >= %zu bytes of workspace; got n_in %d, out %d, ws %zu; nothing launched\n", (size_t)mk::O_END, (size_t)mk::WS_END, n_in, out_size, ws_size); grid = -1; return -1; }
        int dev = 0, cus = 0, per_cu = 0;
        if (hipGetDevice(&dev) != hipSuccess || hipDeviceGetAttribute(&cus, hipDeviceAttributeMultiprocessorCount, dev) != hipSuccess) { grid = -1; return -1; }
        if (hipFuncSetAttribute((const void*)mk::mk_fwd, hipFuncAttributeMaxDynamicSharedMemorySize, mk::LDS_BYTES) != hipSuccess) { fprintf(stderr, "kernel_launch: hipFuncSetAttribute failed\n"); grid = -1; return -1; }
        if (hipOccupancyMaxActiveBlocksPerMultiprocessor(&per_cu, (const void*)mk::mk_fwd, mk::NTHR, mk::LDS_BYTES) != hipSuccess || per_cu < 1) { fprintf(stderr, "kernel_launch: occupancy query reports %d blocks per CU\n", per_cu); grid = -1; (void)hipGetLastError(); return -1; }
        grid = cus;
    }
    if (grid < 0) return -1;
    if (hipMemsetAsync((char*)d_ws + mk::WS_CTL, 0, 4096, stream) != hipSuccess) return -1;
    mk::P prm{}; for (int i = 0; i < 28; ++i) prm.in[i] = (const float*)d_in[i]; prm.out = (float*)d_out; prm.ws = (unsigned char*)d_ws;
    void* args[] = {&prm};
    const hipError_t e = hipLaunchCooperativeKernel((const void*)mk::mk_fwd, dim3(grid), dim3(mk::NTHR), args, mk::LDS_BYTES, stream);
    if (e != hipSuccess) { fprintf(stderr, "cooperative launch failed: %s (grid %d)\n", hipGetErrorString(e), grid); return -1; }
    return 0;
}
extern "C" void kernel_launch(void* const* d_in, const int* in_sizes, int n_in, void* d_out, int out_size, void* d_ws, size_t ws_size, hipStream_t stream) {
    (void)mk_launch(d_in, in_sizes, n_in, d_out, out_size, d_ws, ws_size, stream);
}
```

```cpp
#include <hip/hip_runtime.h>
#include <cstdio>
#include <cstdint>
#include <hip/hip_cooperative_groups.h>
namespace cg = cooperative_groups;
namespace mk {
#define LAS __attribute__((address_space(3)))
#define GAS __attribute__((address_space(1)))
typedef unsigned short bf16_t;
typedef short bf16x8 __attribute__((ext_vector_type(8)));
typedef float f32x4 __attribute__((ext_vector_type(4)));
typedef float f32x2 __attribute__((ext_vector_type(2)));
typedef unsigned u32x4 __attribute__((ext_vector_type(4)));
typedef unsigned u32x2 __attribute__((ext_vector_type(2)));

constexpr int D = 1024, FF = 2816, T_P = 16384, T_S = 1024, T = T_P + T_S, SEQ = 2048, NB = 8, DEC_B = 128, DEC_T = 8;
constexpr int NH = 4, HD = 256, GDK = 128, GDV = 256, GKW = 512, INW = 8216;
constexpr int NWAVES = 8, NTHR = 512;
constexpr float EPS = 1e-6f;
constexpr int NCH_P = T_P / 64;
constexpr int NGRP = T / 64;

__device__ __forceinline__ unsigned f2bf(float f) { unsigned u = __builtin_bit_cast(unsigned, f); return (u + 0x7fffu + ((u >> 16) & 1u)) >> 16; }
__device__ __forceinline__ unsigned pk2(float lo, float hi) { return f2bf(lo) | (f2bf(hi) << 16); }
__device__ __forceinline__ float bf2f(unsigned short b) { return __builtin_bit_cast(float, (unsigned)b << 16); }
__device__ __forceinline__ float bflo(unsigned w) { return __builtin_bit_cast(float, w << 16); }
__device__ __forceinline__ float bfhi(unsigned w) { return __builtin_bit_cast(float, w & 0xffff0000u); }
__device__ __forceinline__ float sigmoid_(float x) { return 1.f / (1.f + __expf(-x)); }
__device__ __forceinline__ float silu_(float x) { return x / (1.f + __expf(-x)); }
__device__ __forceinline__ float logsigmoid_(float x) { return fminf(x, 0.f) - log1pf(expf(-fabsf(x))); }
__device__ __forceinline__ float wave_sum(float v) {
#pragma unroll
    for (int o = 1; o < 64; o <<= 1) v += __shfl_xor(v, o);
    return v;
}

#define XB_TMO      128
#define XB_XCNT(j)  (256  + 64 * (j))
#define XB_XSUB(j)  (1280 + 64 * (j))
#define XB_XGEN(j)  (2304 + 64 * (j))
#define XB_TOP      3328
#define XB_TOPGEN   3392
#define XCD_BAR_WORDS 3456
#define XB_SPIN_CAP (1u << 18)
__device__ __forceinline__ unsigned xb_ld(unsigned* p)              { return __hip_atomic_load(p, __ATOMIC_RELAXED, __HIP_MEMORY_SCOPE_AGENT); }
__device__ __forceinline__ unsigned xb_add(unsigned* p, unsigned v) { return __hip_atomic_fetch_add(p, v, __ATOMIC_RELAXED, __HIP_MEMORY_SCOPE_AGENT); }
__device__ __forceinline__ unsigned xb_xcc_id() { return (unsigned)__builtin_amdgcn_s_getreg((3 << 11) | 20) & 0xFu; }
#define XB_SPIN(cond, bar) do { unsigned _sp = 0; while (cond) { __builtin_amdgcn_s_sleep(1); \
    if ((++_sp & 255u) == 0u) { if (xb_ld(&(bar)[XB_TMO])) break; if (_sp > XB_SPIN_CAP) { atomicAdd(&(bar)[XB_TMO], 1u); break; } } } } while (0)
struct XcdBarrier { unsigned* bar; unsigned x; volatile LAS unsigned* st; };
__device__ __forceinline__ XcdBarrier xcd_barrier_post(unsigned* bar, volatile LAS unsigned* st) {
    XcdBarrier b; b.bar = bar; b.x = xb_xcc_id(); b.st = st;
    if (threadIdx.x == 0) (void)xb_add(&bar[XB_XCNT(b.x)], 1u);
    return b;
}
__device__ __forceinline__ void xcd_barrier_complete(unsigned* bar, unsigned x, unsigned& nloc, unsigned& nx) {
    const unsigned G = gridDim.x * gridDim.y * gridDim.z;
    unsigned sum, cnt, mine, sp = 0u;
    for (;;) {
        sum = 0u; cnt = 0u; mine = 0u;
#pragma unroll
        for (unsigned j = 0; j < 16; ++j) { const unsigned c = xb_ld(&bar[XB_XCNT(j)]); sum += c; cnt += (c > 0u) ? 1u : 0u; mine = (j == x) ? c : mine; }
        if (sum == G) break;
        __builtin_amdgcn_s_sleep(1);
        if ((++sp & 255u) == 0u) { if (xb_ld(&bar[XB_TMO])) break; if (sp > XB_SPIN_CAP) { atomicAdd(&bar[XB_TMO], 1u); break; } }
    }
    nloc = mine > 0u ? mine : 1u; nx = cnt > 0u ? cnt : 1u;
}
__device__ __forceinline__ void xcd_barrier(const XcdBarrier& b) {
    asm volatile("s_waitcnt vmcnt(0)" ::: "memory");
    __syncthreads();
    if (threadIdx.x == 0) {
        unsigned* bar = b.bar;
        __builtin_amdgcn_s_waitcnt(0);
        unsigned nloc = b.st[0], nx = b.st[1];
        if (nloc == 0u) { xcd_barrier_complete(bar, b.x, nloc, nx); b.st[0] = nloc; b.st[1] = nx; }
        const unsigned old = xb_add(&bar[XB_XSUB(b.x)], 1u);
        const unsigned gen = old / nloc;
        if (old + 1u == (gen + 1u) * nloc) {
            __builtin_amdgcn_fence(__ATOMIC_RELEASE, "agent");
            asm volatile("s_waitcnt vmcnt(0)" ::: "memory");
            const unsigned og = xb_add(&bar[XB_TOP], 1u);
            const unsigned tg = og / nx;
            if (og + 1u == (tg + 1u) * nx) xb_add(&bar[XB_TOPGEN], 1u);
            else XB_SPIN(xb_ld(&bar[XB_TOPGEN]) == tg, bar);
            __builtin_amdgcn_fence(__ATOMIC_ACQUIRE, "agent");
            xb_add(&bar[XB_XGEN(b.x)], 1u);
            asm volatile("s_waitcnt vmcnt(0)" ::: "memory");
        } else {
            XB_SPIN(xb_ld(&bar[XB_XGEN(b.x)]) == gen, bar);
            __builtin_amdgcn_fence(__ATOMIC_ACQUIRE, "agent");
            asm volatile("s_waitcnt vmcnt(0)" ::: "memory");
        }
    }
    __syncthreads();
}

namespace pg8 {
constexpr int BM = 256, BK = 64, HALF = 128, HTB = HALF * BK * 2, STAGE_BYTES = 8 * HTB, NXCD = 8, WGM = 8;
__host__ __device__ __forceinline__ int lds_byte(int r, int c) { const int st = (r >> 4) * 2 + (c >> 5), rr = r & 15, cc = c & 31, ob = rr * 64 + cc * 2; return st * 1024 + (ob ^ (((ob >> 9) & 1) << 5)); }
__host__ __device__ __forceinline__ void stage_rc(int b, int& R, int& C) { const int st = b / 1024, sb = b % 1024, swz = sb ^ (((sb >> 9) & 1) << 5); R = (st >> 1) * 16 + swz / 64; C = (st & 1) * 32 + (swz % 64) / 2; }
__host__ __device__ __forceinline__ int perm32(int rho) { const int n = rho >> 4, i = rho & 15; return 8 * (i >> 2) + 4 * n + (i & 3); }

struct Unit { int pm, pn, seg, z; };
struct Gemm { const bf16_t* A0; const bf16_t* B0; const bf16_t* A1; const bf16_t* B1; int lda, ldb, K, zA, zB; };
struct Sched {
    int nM0, nN0, nM1, nN1, n0, ntot, G, c;
    __device__ void init(int nM0_, int nN0_, int nz0, int nM1_, int nN1_, int nz1, int G_, int c_) { nM0 = nM0_; nN0 = nN0_; nM1 = nM1_; nN1 = nN1_; n0 = nM0 * nN0 * nz0; ntot = n0 + nM1 * nN1 * nz1; G = G_; c = c_; }
    __device__ bool next(int i, Unit& u) const {
        int L = i * G + c; if (L >= ntot) return false;
        int nM = nM0, nN = nN0; u.seg = 0; if (L >= n0) { L -= n0; nM = nM1; nN = nN1; u.seg = 1; }
        const int nwg = nM * nN; u.z = L / nwg; int wgid = L - u.z * nwg;
        { const int q = nwg / NXCD, r = nwg % NXCD, xcd = wgid % NXCD, off = wgid / NXCD; wgid = (xcd < r ? xcd * (q + 1) : r * (q + 1) + (xcd - r) * q) + off; }
        const int nig = WGM * nN, gid = wgid / nig, fm = gid * WGM, gsz = (nM - fm) < WGM ? (nM - fm) : WGM;
        u.pm = fm + ((wgid % nig) % gsz); u.pn = (wgid % nig) / gsz; return true;
    }
};
template <class Epi>
__device__ __forceinline__ void gemm_phase(LAS unsigned char* lds, const Gemm g, const Sched& S, const Epi& E) {
    int tid_ = threadIdx.x; asm volatile("" : "+v"(tid_));
    const int tid = tid_, wid = __builtin_amdgcn_readfirstlane(tid >> 6), lane = tid & 63, wr = wid >> 2, wc = wid & 3, fr = lane & 15, fq = lane >> 4;
    const int K = g.K, nt = K / BK;
    unsigned voffA[2], voffB[2];
#pragma unroll
    for (int i = 0; i < 2; ++i) { int R, C; stage_rc(tid * 16 + i * 8192, R, C); const int Rb = (R & ~31) + perm32(R & 31);
        voffA[i] = (unsigned)(R * g.lda + C) * 2u; voffB[i] = (unsigned)(Rb * g.ldb + C) * 2u; }
    const size_t kstep = (size_t)(BK * 2);
    const size_t hstepA = (size_t)HALF * g.lda * 2, hstepB = (size_t)HALF * g.ldb * 2;
    const unsigned ldsw = (unsigned)wid * 1024u;
    const int aoff = lds_byte(wr * 64 + fr, fq * 8), boff = lds_byte(wc * 32 + fr, fq * 8);
#define PG8_SA(b, h) (((b) * 2 + (h)) * HTB)
#define PG8_SB(b, h) ((4 + (b) * 2 + (h)) * HTB)
#define PG8_STAGE(bufoff, gbase, voff) do { _Pragma("unroll") for (int _i = 0; _i < 2; ++_i) \
        __builtin_amdgcn_global_load_lds((const unsigned*)((const char*)(gbase) + (voff)[_i]), (LAS unsigned*)(lds + (bufoff) + ldsw + _i * 8192), 16, 0, 0); } while (0)
#define PG8_LDA(dst, b, h) do { _Pragma("unroll") for (int m = 0; m < 4; ++m) _Pragma("unroll") for (int k = 0; k < 2; ++k) dst[m][k] = *(const LAS bf16x8*)(lds + PG8_SA(b, h) + aoff + m * 2048 + k * 1024); } while (0)
#define PG8_LDB(dst, b, h) do { _Pragma("unroll") for (int n = 0; n < 2; ++n) _Pragma("unroll") for (int k = 0; k < 2; ++k) dst[n][k] = *(const LAS bf16x8*)(lds + PG8_SB(b, h) + boff + n * 2048 + k * 1024); } while (0)
#define PG8_MMA(ai, bj, At, Bt) do { __builtin_amdgcn_s_setprio(1); _Pragma("unroll") for (int m = 0; m < 4; ++m) _Pragma("unroll") for (int n = 0; n < 2; ++n) _Pragma("unroll") for (int k = 0; k < 2; ++k) \
        acc[ai][bj][m][n] = __builtin_amdgcn_mfma_f32_16x16x32_bf16(Bt[n][k], At[m][k], acc[ai][bj][m][n], 0, 0, 0); __builtin_amdgcn_s_setprio(0); } while (0)
#define PG8_WAIT_V(n) asm volatile("s_waitcnt vmcnt(" #n ")" ::: "memory")
#define PG8_WAIT_L(n) asm volatile("s_waitcnt lgkmcnt(" #n ")" ::: "memory")
#define PG8_BAR __builtin_amdgcn_s_barrier()
#define PG8_SCHED __builtin_amdgcn_sched_barrier(0)
#define PG8_ABASE(u) ((const char*)((u).seg ? g.A1 : g.A0) + ((size_t)(u).z * g.zA) * 2 + (size_t)(u).pm * 2 * hstepA)
#define PG8_BBASE(u) ((const char*)((u).seg ? g.B1 : g.B0) + ((size_t)(u).z * g.zB) * 2 + (size_t)(u).pn * 2 * hstepB)
    Unit cur, nxt; int ui = 0;
    if (!S.next(0, cur)) return;
    f32x4 acc[2][2][4][2];
#pragma unroll
    for (int a = 0; a < 2; ++a)
#pragma unroll
        for (int b = 0; b < 2; ++b)
#pragma unroll
            for (int m = 0; m < 4; ++m)
#pragma unroll
                for (int n = 0; n < 2; ++n) acc[a][b][m][n] = (f32x4){0.f, 0.f, 0.f, 0.f};
    bf16x8 At[4][2], B0[2][2], B1[2][2];
    const char* cA = PG8_ABASE(cur); const char* cB = PG8_BBASE(cur);
    PG8_STAGE(PG8_SB(0, 0), cB, voffB); PG8_STAGE(PG8_SB(0, 1), cB + hstepB, voffB); PG8_STAGE(PG8_SA(0, 0), cA, voffA); PG8_STAGE(PG8_SA(0, 1), cA + hstepA, voffA);
    if (wr == 1) PG8_BAR;
    PG8_WAIT_V(2); PG8_BAR;
    PG8_STAGE(PG8_SB(1, 0), cB + kstep, voffB); PG8_STAGE(PG8_SA(1, 0), cA + kstep, voffA); PG8_STAGE(PG8_SB(1, 1), cB + hstepB + kstep, voffB);
    PG8_WAIT_V(6); PG8_BAR;
    for (;;) {
        const bool has_next = S.next(ui + 1, nxt);
        const char* nA = has_next ? PG8_ABASE(nxt) : cA; const char* nB = has_next ? PG8_BBASE(nxt) : cB;
        for (int t = 0; t < nt; t += 2) {
            const bool last = (t == nt - 2);
            const char* a1 = cA + (size_t)(t + 1) * kstep;
            const char* a2 = last ? nA : cA + (size_t)(t + 2) * kstep; const char* b2 = last ? nB : cB + (size_t)(t + 2) * kstep;
            const char* a3 = a2 + kstep; const char* b3 = b2 + kstep;
            PG8_LDB(B0, 0, 0); PG8_LDB(B1, 0, 1); PG8_SCHED; PG8_LDA(At, 0, 0); PG8_STAGE(PG8_SA(1, 1), a1 + hstepA, voffA);
            PG8_WAIT_V(8); PG8_WAIT_L(0); PG8_BAR; PG8_MMA(0, 0, At, B0); PG8_MMA(0, 1, At, B1); PG8_BAR; PG8_SCHED;
            PG8_LDA(At, 0, 1); PG8_STAGE(PG8_SB(0, 0), b2, voffB); PG8_STAGE(PG8_SB(0, 1), b2 + hstepB, voffB); PG8_STAGE(PG8_SA(0, 0), a2, voffA);
            PG8_WAIT_V(8); PG8_WAIT_L(0); PG8_BAR; PG8_MMA(1, 0, At, B0); PG8_MMA(1, 1, At, B1); PG8_BAR; PG8_SCHED;
            PG8_LDB(B0, 1, 0); PG8_LDB(B1, 1, 1); PG8_SCHED; PG8_LDA(At, 1, 0); PG8_STAGE(PG8_SA(0, 1), a2 + hstepA, voffA);
            PG8_WAIT_V(8); PG8_WAIT_L(0); PG8_BAR; PG8_MMA(0, 0, At, B0); PG8_MMA(0, 1, At, B1); PG8_BAR; PG8_SCHED;
            PG8_LDA(At, 1, 1); PG8_STAGE(PG8_SB(1, 0), b3, voffB); PG8_STAGE(PG8_SB(1, 1), b3 + hstepB, voffB); PG8_STAGE(PG8_SA(1, 0), a3, voffA);
            PG8_WAIT_V(8); PG8_WAIT_L(0); PG8_BAR; PG8_MMA(1, 0, At, B0); PG8_MMA(1, 1, At, B1); PG8_BAR; PG8_SCHED;
        }
        if (wr == 0) PG8_BAR;
        E(acc, cur, wr, wc, fr, fq);
        if (!has_next) break;
#pragma unroll
        for (int a = 0; a < 2; ++a)
#pragma unroll
            for (int b = 0; b < 2; ++b)
#pragma unroll
                for (int m = 0; m < 4; ++m)
#pragma unroll
                    for (int n = 0; n < 2; ++n) acc[a][b][m][n] = (f32x4){0.f, 0.f, 0.f, 0.f};
        cur = nxt; cA = nA; cB = nB; ++ui;
        if (wr == 1) PG8_BAR;
    }
    PG8_WAIT_V(0);
    PG8_BAR;
#undef PG8_SA
#undef PG8_SB
#undef PG8_STAGE
#undef PG8_LDA
#undef PG8_LDB
#undef PG8_MMA
#undef PG8_WAIT_V
#undef PG8_WAIT_L
#undef PG8_BAR
#undef PG8_SCHED
#undef PG8_ABASE
#undef PG8_BBASE
}
}
constexpr size_t MiB = 1u << 20;
constexpr size_t SZ_TD2 = (size_t)T * D * 2;
constexpr size_t WS_CTL = 0;
constexpr size_t WS_W = 1 * MiB;
constexpr size_t W_UP1 = WS_W, W_DN1 = W_UP1 + (size_t)2 * FF * D * 2, W_IN = W_DN1 + (size_t)D * FF * 2;
constexpr int NIN = 8448;
constexpr size_t W_QK = W_IN + (size_t)NIN * D * 2, W_PA = W_QK + (size_t)512 * D * 2, W_PB = W_PA + (size_t)D * D * 2, W_O = W_PB + (size_t)D * D * 2;
constexpr size_t W_UP2 = W_O + (size_t)D * D * 2, W_DN2 = W_UP2 + (size_t)2 * FF * D * 2, W_END = W_DN2 + (size_t)D * FF * 2;
static_assert(W_END <= 61 * MiB, "weights");
constexpr size_t WS_XBF = 61 * MiB;
constexpr size_t WS_MISC = WS_XBF + SZ_TD2;
constexpr size_t M_SSQ = WS_MISC;
constexpr size_t M_GATES = M_SSQ + (size_t)T * 16 * 4;
constexpr size_t M_SC = M_GATES + (size_t)T * 32 * 4;
constexpr size_t M_EAL = M_SC + (size_t)5 * NH * T * 4;
constexpr size_t M_DEN = M_EAL + (size_t)384 * GKW * 4;
constexpr size_t M_END = M_DEN + (size_t)T * 4 * 4;
static_assert(M_END <= WS_MISC + 6 * MiB, "misc");
constexpr size_t WS_ACT = WS_MISC + 6 * MiB;
constexpr size_t A_Q = WS_ACT, A_K = A_Q + SZ_TD2, A_QT = A_K + SZ_TD2;
constexpr size_t WS_SIG = WS_ACT + 94 * MiB;
constexpr size_t S_SIGO = WS_SIG, S_SILUR = S_SIGO + SZ_TD2, S_SIGA = S_SILUR + SZ_TD2, S_SIGB = S_SIGA + SZ_TD2;
constexpr size_t WS_VT = WS_SIG + 4 * SZ_TD2;
constexpr size_t WS_KT = WS_VT + 2 * SZ_TD2;
constexpr size_t WS_G = WS_KT + SZ_TD2;
constexpr size_t G_KT = WS_G, G_KTT = WS_G + SZ_TD2 / 2;
constexpr size_t WS_HN = WS_G + SZ_TD2;
constexpr size_t WS_END = WS_HN + SZ_TD2;
static_assert(A_QT + SZ_TD2 / 2 <= WS_SIG && WS_END <= 502 * MiB, "ws map");
constexpr size_t O_YP = 0, O_YS = 16777216, O_CONVP = 17825792, O_CP = 17850368, O_NP = 19947520, O_MP = 19955712, O_SP = 19955744, O_CONVS = 21004320, O_CS = 21397536, O_NS = 54951968, O_MS = 55083040, O_SS = 55083552, O_END = 71860768;
constexpr size_t DO_U = O_CS * 4, DO_QG = DO_U + SZ_TD2, DO_KG = DO_QG + SZ_TD2 / 2, DO_CH = DO_KG + SZ_TD2 / 2;
static_assert(DO_CH + SZ_TD2 <= O_NS * 4, "d_out temporaries");

struct P {
    const float* in[28]; float* out; unsigned char* ws;
};
#define WSP(T_, off) ((T_*)(p.ws + (off)))
#define DOP(T_, off) ((T_*)((unsigned char*)p.out + (off)))

__device__ __forceinline__ int win_src(int n) {
    if (n < 1024) return n;
    if (n < 2048) return 2048 + (n - 1024);
    if (n < 2560) return 3080 + (n - 2048);
    if (n < 3072) return 3592 + (n - 2560);
    if (n < 4096) return 5128 + (n - 3072);
    if (n < 5120) return 6168 + (n - 4096);
    if (n < 6144) return 7192 + (n - 5120);
    if (n < 6400) { const int j = n - 6144; return j < 8 ? 3072 + j : (j < 24 ? 6152 + (j - 8) : -1); }
    if (n < 7424) return 1024 + (n - 6400);
    return 4104 + (n - 7424);
}
__device__ __forceinline__ int up_src(int n) { const int t = n >> 8, r = n & 255; return (r >> 7) * FF + t * 128 + (r & 127); }
template <int MAP>
__device__ __forceinline__ void p0_item(const float* W, int K, int N, const float* gk, float scale, bf16_t* WT, int dst_row0, int ndst, LAS float* scr, int item, int lane) {
    const int nblk = ndst / 32, kb = item / nblk, nb = item % nblk, k0 = 64 * kb, n0 = 32 * nb;
    const int nn = n0 + (lane & 31); const int src = MAP == 0 ? nn : (MAP == 1 ? up_src(nn) : win_src(nn));
    float v[32];
#pragma unroll
    for (int i = 0; i < 32; ++i) { const int kk = 2 * i + (lane >> 5); v[i] = src >= 0 ? W[(size_t)(k0 + kk) * N + src] : 0.f; }
#pragma unroll
    for (int i = 0; i < 32; ++i) scr[(2 * i + (lane >> 5)) * 33 + (lane & 31)] = v[i];
    asm volatile("s_waitcnt lgkmcnt(0)" ::: "memory");
    const int c = lane & 7;
    f32x4 g0 = {scale, scale, scale, scale}, g1 = g0;
    if (gk) { g0 = *(const f32x4*)(gk + k0 + 8 * c) * scale; g1 = *(const f32x4*)(gk + k0 + 8 * c + 4) * scale; }
#pragma unroll
    for (int j = 0; j < 4; ++j) { const int n = (lane >> 3) + 8 * j; const LAS float* s = scr + (8 * c) * 33 + n;
        u32x4 o; o.x = pk2(s[0 * 33] * g0[0], s[1 * 33] * g0[1]); o.y = pk2(s[2 * 33] * g0[2], s[3 * 33] * g0[3]); o.z = pk2(s[4 * 33] * g1[0], s[5 * 33] * g1[1]); o.w = pk2(s[6 * 33] * g1[2], s[7 * 33] * g1[3]);
        *(u32x4*)(WT + (size_t)(dst_row0 + n0 + n) * K + k0 + 8 * c) = o; }
    asm volatile("s_waitcnt lgkmcnt(0)" ::: "memory");
}
__device__ __forceinline__ void p0_prologue(const P& p, LAS unsigned char* lds, int gw, int NGW, int wave, int lane) {
    LAS float* scr = (LAS float*)(lds + wave * 16384);
    constexpr int I_UP = (D / 64) * (2 * FF / 32), I_DN = (FF / 64) * (D / 32), I_IN = (D / 64) * (NIN / 32), I_QK = (D / 64) * (256 / 32), I_SQ = (D / 64) * (D / 32);
    constexpr int NITEMS = 2 * I_UP + 2 * I_DN + I_IN + 2 * I_QK + 3 * I_SQ;
    for (int it = gw; it < NITEMS; it += NGW) {
        int r = it;
        if (r < I_IN) { p0_item<2>(p.in[11], D, INW, p.in[10], 1.f, WSP(bf16_t, W_IN), 0, NIN, scr, r, lane); continue; } r -= I_IN;
        if (r < I_UP) { p0_item<1>(p.in[8], D, 2 * FF, p.in[7], 1.f, WSP(bf16_t, W_UP1), 0, 2 * FF, scr, r, lane); continue; } r -= I_UP;
        if (r < I_UP) { p0_item<1>(p.in[25], D, 2 * FF, p.in[24], 1.f, WSP(bf16_t, W_UP2), 0, 2 * FF, scr, r, lane); continue; } r -= I_UP;
        if (r < I_DN) { p0_item<0>(p.in[9], FF, D, nullptr, 1.f, WSP(bf16_t, W_DN1), 0, D, scr, r, lane); continue; } r -= I_DN;
        if (r < I_DN) { p0_item<0>(p.in[26], FF, D, nullptr, 1.f, WSP(bf16_t, W_DN2), 0, D, scr, r, lane); continue; } r -= I_DN;
        if (r < I_QK) { p0_item<0>(p.in[14], D, 256, nullptr, 1.f, WSP(bf16_t, W_QK), 0, 256, scr, r, lane); continue; } r -= I_QK;
        if (r < I_QK) { p0_item<0>(p.in[15], D, 256, nullptr, 0.0625f, WSP(bf16_t, W_QK), 256, 256, scr, r, lane); continue; } r -= I_QK;
        if (r < I_SQ) { p0_item<0>(p.in[21], D, D, nullptr, 1.f, WSP(bf16_t, W_PA), 0, D, scr, r, lane); continue; } r -= I_SQ;
        if (r < I_SQ) { p0_item<0>(p.in[22], D, D, nullptr, 1.f, WSP(bf16_t, W_PB), 0, D, scr, r, lane); continue; } r -= I_SQ;
        p0_item<0>(p.in[23], D, D, nullptr, 1.f, WSP(bf16_t, W_O), 0, D, scr, r, lane);
    }
    bf16_t* XB = WSP(bf16_t, WS_XBF); float* SSQ = WSP(float, M_SSQ);
    for (int m0 = 2 * gw; m0 < T; m0 += 2 * NGW) {
        f32x4 v[2][4];
#pragma unroll
        for (int r = 0; r < 2; ++r) { const int m = m0 + r; const float* xrow = m < T_P ? p.in[0] + (size_t)m * D : p.in[1] + (size_t)(m - T_P) * D; const f32x4* xr = (const f32x4*)xrow + lane;
#pragma unroll
            for (int j = 0; j < 4; ++j) v[r][j] = xr[64 * j]; }
#pragma unroll
        for (int r = 0; r < 2; ++r) { const int m = m0 + r; float s = 0.f;
#pragma unroll
            for (int j = 0; j < 4; ++j) s += (v[r][j].x * v[r][j].x + v[r][j].y * v[r][j].y) + (v[r][j].z * v[r][j].z + v[r][j].w * v[r][j].w);
            s = wave_sum(s);
            u32x2* o8 = (u32x2*)(XB + (size_t)m * D) + lane;
#pragma unroll
            for (int j = 0; j < 4; ++j) { u32x2 w; w.x = pk2(v[r][j].x, v[r][j].y); w.y = pk2(v[r][j].z, v[r][j].w); o8[64 * j] = w; }
            if (lane < 16) SSQ[(size_t)m * 16 + lane] = lane == 0 ? s : 0.f; }
    }
}
__device__ __forceinline__ float row_rs(const float* SSQ, int row) {
    const f32x4* q = (const f32x4*)(SSQ + (size_t)row * 16); const f32x4 a = q[0], b = q[1], c = q[2], d = q[3];
    const float s = ((a.x + a.y) + (a.z + a.w)) + ((b.x + b.y) + (b.z + b.w)) + ((c.x + c.y) + (c.z + c.w)) + ((d.x + d.y) + (d.z + d.w));
    return 1.f / sqrtf(s * (1.f / D) + EPS);
}

typedef pg8::Unit Unit;
#define EPI_ARGS const f32x4 (&acc)[2][2][4][2], const Unit& u, int wr, int wc, int fr, int fq
struct EpiUp { const float* SSQ; bf16_t* ACT;
    __device__ __forceinline__ void operator()(EPI_ARGS) const {
        const int row0 = u.pm * 256 + wr * 64 + fr, col0 = u.pn * 128 + wc * 32 + 8 * fq;
#pragma unroll
        for (int ai = 0; ai < 2; ++ai)
#pragma unroll
            for (int m = 0; m < 4; ++m) { const int row = row0 + ai * 128 + m * 16; const float rs = row_rs(SSQ, row); u32x4 w; unsigned* wp = (unsigned*)&w;
#pragma unroll
                for (int n = 0; n < 2; ++n) { const f32x4 a = acc[ai][0][m][n] * rs, g = acc[ai][1][m][n] * rs;
                    wp[2 * n] = pk2(silu_(g[0]) * a[0], silu_(g[1]) * a[1]); wp[2 * n + 1] = pk2(silu_(g[2]) * a[2], silu_(g[3]) * a[3]); }
                *(u32x4*)(ACT + (size_t)row * FF + col0) = w; }
    }
};
template <bool WB> struct EpiRes { const float* xi_p; const float* xi_s; float* xo; bf16_t* XBo; float* SSQ; float alpha;
    __device__ __forceinline__ void operator()(EPI_ARGS) const {
        const int row0 = u.pm * 256 + wr * 64 + fr; const float* xi = u.pm < T_P / 256 ? xi_p : xi_s;
#pragma unroll
        for (int ai = 0; ai < 2; ++ai)
#pragma unroll
            for (int m = 0; m < 4; ++m) { const int row = row0 + ai * 128 + m * 16; float ss = 0.f;
#pragma unroll
                for (int bj = 0; bj < 2; ++bj) { const int col = u.pn * 256 + bj * 128 + wc * 32 + 8 * fq; const size_t off = (size_t)row * D + col;
                    const f32x4 x0 = *(const f32x4*)(xi + off), x1 = *(const f32x4*)(xi + off + 4);
                    const f32x4 y0 = x0 + acc[ai][bj][m][0] * alpha, y1 = x1 + acc[ai][bj][m][1] * alpha;
                    *(f32x4*)(xo + off) = y0; *(f32x4*)(xo + off + 4) = y1;
                    ss += (y0[0] * y0[0] + y0[1] * y0[1]) + (y0[2] * y0[2] + y0[3] * y0[3]) + (y1[0] * y1[0] + y1[1] * y1[1]) + (y1[2] * y1[2] + y1[3] * y1[3]);
                    if (WB) { u32x4 w; w.x = pk2(y0[0], y0[1]); w.y = pk2(y0[2], y0[3]); w.z = pk2(y1[0], y1[1]); w.w = pk2(y1[2], y1[3]); *(u32x4*)(XBo + off) = w; } }
                ss += __shfl_xor(ss, 16); ss += __shfl_xor(ss, 32);
                if (fq == 0) SSQ[(size_t)row * 16 + u.pn * 4 + wc] = ss; }
    }
};
struct EpiIn { const float* SSQ; bf16_t *U, *SIGO, *QG, *KG, *SILUR, *SIGA, *SIGB, *VT; float* GATES;
    __device__ __forceinline__ void operator()(EPI_ARGS) const {
        if (u.seg == 0) {
            const int row0 = u.pm * 256 + wr * 64 + fr; const int pn = u.pn;
            bf16_t* dst; int ld, cb, act;
            if (pn < 4) { dst = U; ld = D; cb = pn * 256; act = 0; } else if (pn < 8) { dst = SIGO; ld = D; cb = (pn - 4) * 256; act = 1; }
            else if (pn < 10) { dst = QG; ld = GKW; cb = (pn - 8) * 256; act = 0; } else if (pn < 12) { dst = KG; ld = GKW; cb = (pn - 10) * 256; act = 0; }
            else if (pn < 16) { dst = SILUR; ld = D; cb = (pn - 12) * 256; act = 2; } else if (pn < 20) { dst = SIGA; ld = D; cb = (pn - 16) * 256; act = 1; }
            else { dst = SIGB; ld = D; cb = (pn - 20) * 256; act = 1; }
#pragma unroll
            for (int ai = 0; ai < 2; ++ai)
#pragma unroll
                for (int m = 0; m < 4; ++m) { const int row = row0 + ai * 128 + m * 16; const float rs = row_rs(SSQ, row);
                    if (pn == 24) { if (wc == 0) { *(f32x4*)(GATES + (size_t)row * 32 + 8 * fq) = acc[ai][0][m][0] * rs; *(f32x4*)(GATES + (size_t)row * 32 + 8 * fq + 4) = acc[ai][0][m][1] * rs; } continue; }
#pragma unroll
                    for (int bj = 0; bj < 2; ++bj) { f32x4 v0 = acc[ai][bj][m][0] * rs, v1 = acc[ai][bj][m][1] * rs;
                        if (act == 1) { for (int i = 0; i < 4; ++i) { v0[i] = sigmoid_(v0[i]); v1[i] = sigmoid_(v1[i]); } }
                        else if (act == 2) { for (int i = 0; i < 4; ++i) { v0[i] = silu_(v0[i]); v1[i] = silu_(v1[i]); } }
                        u32x4 w; w.x = pk2(v0[0], v0[1]); w.y = pk2(v0[2], v0[3]); w.z = pk2(v1[0], v1[1]); w.w = pk2(v1[2], v1[3]);
                        *(u32x4*)(dst + (size_t)row * ld + cb + bj * 128 + wc * 32 + 8 * fq) = w; } }
        } else {
            const int vrow0 = u.pm * 256 + wr * 64 + fr;
            float rs[2][8];
#pragma unroll
            for (int bj = 0; bj < 2; ++bj)
#pragma unroll
                for (int j = 0; j < 8; ++j) rs[bj][j] = row_rs(SSQ, u.pn * 256 + bj * 128 + wc * 32 + 8 * fq + j);
#pragma unroll
            for (int ai = 0; ai < 2; ++ai)
#pragma unroll
                for (int m = 0; m < 4; ++m) { const int vr = vrow0 + ai * 128 + m * 16;
#pragma unroll
                    for (int bj = 0; bj < 2; ++bj) { const f32x4 a0 = acc[ai][bj][m][0], a1 = acc[ai][bj][m][1]; u32x4 w;
                        w.x = pk2(a0[0] * rs[bj][0], a0[1] * rs[bj][1]); w.y = pk2(a0[2] * rs[bj][2], a0[3] * rs[bj][3]); w.z = pk2(a1[0] * rs[bj][4], a1[1] * rs[bj][5]); w.w = pk2(a1[2] * rs[bj][6], a1[3] * rs[bj][7]);
                        *(u32x4*)(VT + (size_t)vr * T + u.pn * 256 + bj * 128 + wc * 32 + 8 * fq) = w; } }
        }
    }
};
struct EpiQK { bf16_t *Q, *K, *KT;
    __device__ __forceinline__ void operator()(EPI_ARGS) const {
        const int row0 = u.pm * 256 + wr * 64 + fr;
#pragma unroll
        for (int ai = 0; ai < 2; ++ai)
#pragma unroll
            for (int m = 0; m < 4; ++m) { const int row = row0 + ai * 128 + m * 16;
#pragma unroll
                for (int bj = 0; bj < 2; ++bj) { const f32x4 v0 = acc[ai][bj][m][0], v1 = acc[ai][bj][m][1]; const int cc = bj * 128 + wc * 32 + 8 * fq;
                    u32x4 w; w.x = pk2(v0[0], v0[1]); w.y = pk2(v0[2], v0[3]); w.z = pk2(v1[0], v1[1]); w.w = pk2(v1[2], v1[3]);
                    if (u.seg == 0) *(u32x4*)((u.pn == 0 ? Q : K) + (size_t)row * D + u.z * 256 + cc) = w;
                    else *(u32x4*)(KT + (size_t)(u.z * 256 + row) * T + u.pn * 256 + cc) = w; } }
    }
};
template <int MODE> struct EpiMerge { const bf16_t* G; float* YT; bf16_t* Y;
    __device__ __forceinline__ void operator()(EPI_ARGS) const {
        const int row0 = u.pm * 256 + wr * 64 + fr;
#pragma unroll
        for (int ai = 0; ai < 2; ++ai)
#pragma unroll
            for (int m = 0; m < 4; ++m) { const int row = row0 + ai * 128 + m * 16;
#pragma unroll
                for (int bj = 0; bj < 2; ++bj) { const size_t off = (size_t)row * D + u.pn * 256 + bj * 128 + wc * 32 + 8 * fq;
                    const u32x4 gw = *(const u32x4*)(G + off);
                    f32x4 g0 = {bflo(gw.x), bfhi(gw.x), bflo(gw.y), bfhi(gw.y)}, g1 = {bflo(gw.z), bfhi(gw.z), bflo(gw.w), bfhi(gw.w)};
                    f32x4 y0 = g0 * acc[ai][bj][m][0], y1 = g1 * acc[ai][bj][m][1];
                    if (MODE == 0) { *(f32x4*)(YT + off) = y0; *(f32x4*)(YT + off + 4) = y1; }
                    else { y0 += *(const f32x4*)(YT + off); y1 += *(const f32x4*)(YT + off + 4);
                        u32x4 w; w.x = pk2(y0[0], y0[1]); w.y = pk2(y0[2], y0[3]); w.z = pk2(y1[0], y1[1]); w.w = pk2(y1[2], y1[3]); *(u32x4*)(Y + off) = w; } } }
    }
};
constexpr size_t SC_STRIDE = (size_t)NH * T;
__device__ __forceinline__ void p4_conv(const P& p, size_t gtid, size_t gsz) {
    const bf16_t* U = DOP(const bf16_t, DO_U); bf16_t* CH = DOP(bf16_t, DO_CH);
    const float* cw = p.in[12]; const float* cb = p.in[13]; const float* stc = p.in[2];
    for (size_t idx = gtid; idx < (size_t)T * 128; idx += gsz) {
        const int row = (int)(idx >> 7), c8 = (int)(idx & 127) * 8;
        int t, Tl, seq; if (row < T_P) { t = row & (SEQ - 1); Tl = SEQ; seq = row >> 11; } else { t = (row - T_P) & 7; Tl = DEC_T; seq = (row - T_P) >> 3; }
        float a[8]; { const f32x4 b0 = *(const f32x4*)(cb + c8), b1 = *(const f32x4*)(cb + c8 + 4); a[0] = b0[0]; a[1] = b0[1]; a[2] = b0[2]; a[3] = b0[3]; a[4] = b1[0]; a[5] = b1[1]; a[6] = b1[2]; a[7] = b1[3]; }
        u32x4 ucur = {0u, 0u, 0u, 0u};
#pragma unroll
        for (int j = 0; j < 4; ++j) { const int tt = t - 3 + j; float uv[8];
            if (tt >= 0) { const u32x4 w = *(const u32x4*)(U + (size_t)(row - 3 + j) * D + c8); if (j == 3) ucur = w;
                uv[0] = bflo(w.x); uv[1] = bfhi(w.x); uv[2] = bflo(w.y); uv[3] = bfhi(w.y); uv[4] = bflo(w.z); uv[5] = bfhi(w.z); uv[6] = bflo(w.w); uv[7] = bfhi(w.w); }
            else if (row >= T_P) { const float* s = stc + ((size_t)seq * 3 + (3 + tt)) * D + c8; const f32x4 s0 = *(const f32x4*)s, s1 = *(const f32x4*)(s + 4);
                uv[0] = s0[0]; uv[1] = s0[1]; uv[2] = s0[2]; uv[3] = s0[3]; uv[4] = s1[0]; uv[5] = s1[1]; uv[6] = s1[2]; uv[7] = s1[3]; }
            else { for (int i = 0; i < 8; ++i) uv[i] = 0.f; }
            const f32x4 w0 = *(const f32x4*)(cw + j * D + c8), w1 = *(const f32x4*)(cw + j * D + c8 + 4);
            a[0] += uv[0] * w0[0]; a[1] += uv[1] * w0[1]; a[2] += uv[2] * w0[2]; a[3] += uv[3] * w0[3]; a[4] += uv[4] * w1[0]; a[5] += uv[5] * w1[1]; a[6] += uv[6] * w1[2]; a[7] += uv[7] * w1[3]; }
        u32x4 o; o.x = pk2(silu_(a[0]), silu_(a[1])); o.y = pk2(silu_(a[2]), silu_(a[3])); o.z = pk2(silu_(a[4]), silu_(a[5])); o.w = pk2(silu_(a[6]), silu_(a[7]));
        *(u32x4*)(CH + (size_t)row * D + c8) = o;
        if (t >= Tl - 3) { float* co = (row < T_P ? p.out + O_CONVP : p.out + O_CONVS) + ((size_t)seq * 3 + (t - (Tl - 3))) * D + c8;
            *(f32x4*)co = (f32x4){bflo(ucur.x), bfhi(ucur.x), bflo(ucur.y), bfhi(ucur.y)}; *(f32x4*)(co + 4) = (f32x4){bflo(ucur.z), bfhi(ucur.z), bflo(ucur.w), bfhi(ucur.w)}; }
    }
}
__device__ __forceinline__ void p4_gates(const P& p, LAS unsigned char* lds, int bid, int tid) {
    const float* GATES = WSP(const float, M_GATES); float* SC = WSP(float, M_SC); const float* bif = p.in[16];
    const int lane = tid & 63, w = __builtin_amdgcn_readfirstlane(tid >> 6);
    if (bid < 32) {
        const int b = bid >> 2, h = bid & 3; LAS float* sum = (LAS float*)lds; LAS float* mp = sum + 64;
        const float bi = bif[h], bfg = bif[NH + h]; float a[4], bb[4], cm[4];
#pragma unroll
        for (int j = 0; j < 4; ++j) { const int c = 4 * w + j, row = b * SEQ + c * 64 + lane;
            const float gi = GATES[(size_t)row * 32 + h] + bi, gf = GATES[(size_t)row * 32 + NH + h] + bfg;
            float x = logsigmoid_(gf);
#pragma unroll
            for (int o = 1; o < 64; o <<= 1) { const float y = __shfl_up(x, o, 64); if (lane >= o) x += y; }
            float m = gi - x; a[j] = m;
#pragma unroll
            for (int o = 1; o < 64; o <<= 1) { const float y = __shfl_up(m, o, 64); if (lane >= o) m = fmaxf(m, y); }
            bb[j] = x; cm[j] = m; if (lane == 63) { sum[2 * c] = x; sum[2 * c + 1] = m; } }
        __syncthreads();
        if (tid == 0) { float m = 0.f; for (int c = 0; c < 32; ++c) { mp[c] = m; m = sum[2 * c] + fmaxf(m, sum[2 * c + 1]); } p.out[O_MP + (size_t)b * NH + h] = m; }
        __syncthreads();
#pragma unroll
        for (int j = 0; j < 4; ++j) { const int c = 4 * w + j, row = b * SEQ + c * 64 + lane; const float mprev = mp[c];
            const float Mt = fmaxf(mprev, cm[j]), mt = bb[j] + Mt, ML = __shfl(Mt, 63, 64); const size_t o = (size_t)h * T + row;
            SC[o] = a[j]; SC[SC_STRIDE + o] = Mt; SC[2 * SC_STRIDE + o] = expf(mprev - Mt); SC[3 * SC_STRIDE + o] = expf(a[j] - ML); SC[4 * SC_STRIDE + o] = expf(-mt); }
        __syncthreads();
    } else if (bid < 40) {
        const int job = (bid - 32) * 8 + w, h = job & 3, li = lane & 7, seq = (job >> 2) * 8 + (lane >> 3), row = T_P + seq * 8 + li;
        const float mprev = p.in[5][seq * NH + h];
        const float gi = GATES[(size_t)row * 32 + h] + bif[h], gf = GATES[(size_t)row * 32 + NH + h] + bif[NH + h];
        float b = logsigmoid_(gf);
#pragma unroll
        for (int o = 1; o < 8; o <<= 1) { const float x = __shfl_up(b, o, 8); if (li >= o) b += x; }
        const float a = gi - b; float cm = a;
#pragma unroll
        for (int o = 1; o < 8; o <<= 1) { const float x = __shfl_up(cm, o, 8); if (li >= o) cm = fmaxf(cm, x); }
        const float Mt = fmaxf(mprev, cm), mt = b + Mt, ML = __shfl(Mt, 7, 8), bL = __shfl(b, 7, 8); const size_t o = (size_t)h * T + row;
        SC[o] = a; SC[SC_STRIDE + o] = Mt; SC[2 * SC_STRIDE + o] = expf(mprev - Mt); SC[3 * SC_STRIDE + o] = expf(a - ML); SC[4 * SC_STRIDE + o] = expf(-mt);
        if (li == 7) p.out[O_MS + (size_t)seq * NH + h] = bL + ML;
    }
}
__device__ __forceinline__ void p4_gla(const P& p, int bid, int G, int tid) {
    const float* GATES = WSP(const float, M_GATES); const bf16_t* QG = DOP(const bf16_t, DO_QG); const bf16_t* KG = DOP(const bf16_t, DO_KG);
    bf16_t* QT = WSP(bf16_t, A_QT); bf16_t* KTn = WSP(bf16_t, G_KT); bf16_t* KTT = WSP(bf16_t, G_KTT); float* EAL = WSP(float, M_EAL);
    const int c = tid;
    float w2[16];
#pragma unroll
    for (int r = 0; r < 16; ++r) w2[r] = p.in[18][r * GKW + c];
    const float ba = p.in[19][c];
    for (int g = G - 1 - bid; g < NGRP; g += G) {
        const bool smp = g >= NCH_P; float A = 0.f;
        for (int t8 = 0; t8 < 8; ++t8) {
            unsigned kp[4] = {0u, 0u, 0u, 0u}; float eA = 1.f;
            if (smp) A = 0.f;
#pragma unroll
            for (int j = 0; j < 8; ++j) {
                const int row = g * 64 + t8 * 8 + j;
                const f32x4* ag = (const f32x4*)(GATES + (size_t)row * 32 + 8); float s = ba;
#pragma unroll
                for (int r4 = 0; r4 < 4; ++r4) { const f32x4 a4 = ag[r4]; s += a4[0] * w2[4 * r4] + a4[1] * w2[4 * r4 + 1] + a4[2] * w2[4 * r4 + 2] + a4[3] * w2[4 * r4 + 3]; }
                A += (fminf(s, 0.f) - __logf(1.f + __expf(-fabsf(s)))) * 0.0625f;
                const float q = bf2f(QG[(size_t)row * GKW + c]), k = bf2f(KG[(size_t)row * GKW + c]);
                eA = __expf(A); const float kt = k * __expf(-A);
                QT[(size_t)row * GKW + c] = (bf16_t)f2bf(q * 0.08838834764831845f * eA);
                const unsigned kb = f2bf(kt); KTn[(size_t)row * GKW + c] = (bf16_t)kb;
                if (j & 1) kp[j >> 1] |= kb << 16; else kp[j >> 1] = kb;
            }
            { u32x4 w = {kp[0], kp[1], kp[2], kp[3]}; *(u32x4*)(KTT + (size_t)c * T + g * 64 + t8 * 8) = w; }
            if (smp) EAL[(size_t)(256 + (g - NCH_P) * 8 + t8) * GKW + c] = eA;
            else if (t8 == 7) EAL[(size_t)g * GKW + c] = eA;
        }
    }
}

#define MFMA16(a, b, c) __builtin_amdgcn_mfma_f32_16x16x32_bf16(a, b, c, 0, 0, 0)
#define LBAR() do { asm volatile("s_waitcnt lgkmcnt(0)" ::: "memory"); __builtin_amdgcn_s_barrier(); asm volatile("" ::: "memory"); } while (0)
template <bool ML>
__device__ __forceinline__ void scan_prompt(const P& p, LAS unsigned char* lds, int b, int h, int es) {
    constexpr int DK = ML ? 256 : 128, ES = ML ? 64 : 128, NE = ML ? 80 : 128, NET = NE / 16, NDT = DK / 128  , KS = DK / 32;
    constexpr int QS = DK * 2 + 16, VS = 144;
    constexpr int OFF_Q = 0, OFF_K = OFF_Q + 64 * QS, OFF_V = OFF_K + 64 * QS, OFF_S = OFF_V + NE * VS, OFF_C = OFF_S + 64 * VS, OFF_SC = OFF_C + NE * QS;
    static_assert(OFF_SC + 1280 <= 140 * 1024, "scan LDS");
    constexpr int NT = NET * 4, TPW = (NT + 7) / 8;
    constexpr int QPT = 64 * (DK / 8) / NTHR, VPT = ES * 8 / NTHR;
    int tid_ = threadIdx.x; asm volatile("" : "+v"(tid_));
    const int tid = tid_, w = __builtin_amdgcn_readfirstlane(tid >> 6), lane = tid & 63, fr = lane & 15, fq = lane >> 4;
    const size_t row0 = (size_t)b * SEQ;
    const bf16_t* Qg = ML ? WSP(const bf16_t, A_Q) + row0 * D + h * 256 : WSP(const bf16_t, A_QT) + row0 * GKW + h * 128;
    const bf16_t* Kg = ML ? WSP(const bf16_t, A_K) + row0 * D + h * 256 : WSP(const bf16_t, G_KT) + row0 * GKW + h * 128;
    constexpr int LDQ = ML ? D : GKW;
    const bf16_t* VTg = WSP(const bf16_t, WS_VT) + (size_t)((ML ? 0 : 1024) + h * 256 + es * ES) * T + row0;
    const bf16_t* KTg = (ML ? WSP(const bf16_t, WS_KT) + (size_t)(h * 256) * T : WSP(const bf16_t, G_KTT) + (size_t)(h * 128) * T) + row0;
    const float* SC = WSP(const float, M_SC) + (size_t)h * T + row0;
    const float* EALg = WSP(const float, M_EAL) + (size_t)(b * 32) * GKW + h * 128;
    bf16_t* OUT = ML ? WSP(bf16_t, WS_HN) : WSP(bf16_t, WS_XBF);
    LAS float* scal = (LAS float*)(lds + OFF_SC);
    for (int i = tid; i < NE * QS / 4; i += NTHR) ((LAS unsigned*)(lds + OFF_C))[i] = 0u;
    if (ML) for (int i = tid; i < 16 * VS / 4; i += NTHR) ((LAS unsigned*)(lds + OFF_V + ES * VS))[i] = (i < VS / 4) ? 0x3f803f80u : 0u;
    f32x4 accC[NDT][NET];
#pragma unroll
    for (int a = 0; a < NDT; ++a)
#pragma unroll
        for (int e = 0; e < NET; ++e) accC[a][e] = (f32x4){0.f, 0.f, 0.f, 0.f};
    u32x4 sq[QPT], sk[QPT], sv[VPT]; float ssc = 0.f;
#define STAGE_LOAD(c_) do { const size_t r0_ = (size_t)(c_) * 64; \
        _Pragma("unroll") for (int j = 0; j < QPT; ++j) { const int i = tid + NTHR * j, rr = i / (DK / 8), cc = i % (DK / 8); sq[j] = *(const u32x4*)(Qg + (r0_ + rr) * LDQ + cc * 8); sk[j] = *(const u32x4*)(Kg + (r0_ + rr) * LDQ + cc * 8); } \
        _Pragma("unroll") for (int j = 0; j < VPT; ++j) { const int i = tid + NTHR * j, rr = i >> 3, cc = i & 7; sv[j] = *(const u32x4*)(VTg + (size_t)rr * T + r0_ + cc * 8); } \
        if (ML) { if (tid < 320) ssc = SC[(size_t)((tid >> 6) == 3 ? 4 : ((tid >> 6) == 4 ? 3 : (tid >> 6))) * SC_STRIDE + r0_ + (tid & 63)]; } else if (tid < 128) ssc = EALg[(size_t)(c_) * GKW + tid]; } while (0)
#define STAGE_WRITE() do { \
        _Pragma("unroll") for (int j = 0; j < QPT; ++j) { const int i = tid + NTHR * j, rr = i / (DK / 8), cc = i % (DK / 8); *(LAS u32x4*)(lds + OFF_Q + rr * QS + cc * 16) = sq[j]; *(LAS u32x4*)(lds + OFF_K + rr * QS + cc * 16) = sk[j]; } \
        _Pragma("unroll") for (int j = 0; j < VPT; ++j) { const int i = tid + NTHR * j, rr = i >> 3, cc = i & 7; *(LAS u32x4*)(lds + OFF_V + rr * VS + cc * 16) = sv[j]; } \
        if (tid < (ML ? 320 : 128)) scal[tid] = ssc; } while (0)
    STAGE_LOAD(0); STAGE_WRITE(); LBAR();
    for (int c = 0; c < 32; ++c) {
        const size_t r0 = (size_t)c * 64;
        if (c + 1 < 32) STAGE_LOAD(c + 1);
        bf16x8 kt[NDT][2];
#pragma unroll
        for (int a = 0; a < NDT; ++a)
#pragma unroll
            for (int ks = 0; ks < 2; ++ks) kt[a][ks] = *(const bf16x8*)(KTg + (size_t)(16 * (NDT * w + a) + fr) * T + r0 + ks * 32 + 8 * fq);
        const int st = w & 3, tt0 = 2 * (w >> 2);
        f32x4 accS[2] = {(f32x4){0.f, 0.f, 0.f, 0.f}, (f32x4){0.f, 0.f, 0.f, 0.f}};
#pragma unroll
        for (int ks = 0; ks < KS; ++ks) { const bf16x8 af = *(const LAS bf16x8*)(lds + OFF_K + (16 * st + fr) * QS + ks * 64 + fq * 16);
#pragma unroll
            for (int j = 0; j < 2; ++j) { const bf16x8 bfr = *(const LAS bf16x8*)(lds + OFF_Q + (16 * (tt0 + j) + fr) * QS + ks * 64 + fq * 16); accS[j] = MFMA16(af, bfr, accS[j]); } }
#pragma unroll
        for (int j = 0; j < 2; ++j) { const int t = 16 * (tt0 + j) + fr, s0 = 16 * st + 4 * fq; float v[4];
#pragma unroll
            for (int r = 0; r < 4; ++r) { const int s = s0 + r; float x = accS[j][r]; if (ML) x *= __expf(scal[s] - scal[64 + t]); v[r] = (s <= t) ? x : 0.f; }
            u32x2 wv; wv.x = pk2(v[0], v[1]); wv.y = pk2(v[2], v[3]); *(LAS u32x2*)(lds + OFF_S + t * VS + s0 * 2) = wv; }
        f32x4 accO[TPW];
#pragma unroll
        for (int j = 0; j < TPW; ++j) { accO[j] = (f32x4){0.f, 0.f, 0.f, 0.f}; const int id = w + 8 * j;
            if (id < NT) { const int et = id >> 2, tt = id & 3;
#pragma unroll
                for (int ks = 0; ks < KS; ++ks) { const bf16x8 af = *(const LAS bf16x8*)(lds + OFF_C + (16 * et + fr) * QS + ks * 64 + fq * 16), bfr = *(const LAS bf16x8*)(lds + OFF_Q + (16 * tt + fr) * QS + ks * 64 + fq * 16);
                    accO[j] = MFMA16(af, bfr, accO[j]); } } }
        LBAR();
#pragma unroll
        for (int j = 0; j < TPW; ++j) { const int id = w + 8 * j;
            if (id < NT) { const int et = id >> 2, tt = id & 3, t = 16 * tt + fr;
                if (ML) accO[j] = accO[j] * scal[128 + t];
#pragma unroll
                for (int ks = 0; ks < 2; ++ks) { const bf16x8 af = *(const LAS bf16x8*)(lds + OFF_V + (16 * et + fr) * VS + ks * 64 + fq * 16), bfr = *(const LAS bf16x8*)(lds + OFF_S + t * VS + ks * 64 + fq * 16);
                    accO[j] = MFMA16(af, bfr, accO[j]); }
                const size_t grow = row0 + r0 + t;
                if (!ML || et < 4) { u32x2 wv; wv.x = pk2(accO[j][0], accO[j][1]); wv.y = pk2(accO[j][2], accO[j][3]); *(u32x2*)(OUT + grow * D + h * 256 + es * ES + 16 * et + 4 * fq) = wv; }
                else if (es == 0 && fq == 0) WSP(float, M_DEN)[grow * 4 + h] = fmaxf(fabsf(accO[j][0]), scal[192 + t]); } }
        if (ML) { const float dec = scal[128 + 63];
#pragma unroll
            for (int a = 0; a < NDT; ++a)
#pragma unroll
                for (int e = 0; e < NET; ++e) accC[a][e] = accC[a][e] * dec;
#pragma unroll
            for (int ks = 0; ks < 2; ++ks) { const f32x4 w0 = *(const LAS f32x4*)(scal + 256 + ks * 32 + 8 * fq), w1 = *(const LAS f32x4*)(scal + 256 + ks * 32 + 8 * fq + 4);
#pragma unroll
                for (int a = 0; a < NDT; ++a) { const u32x4 kw = __builtin_bit_cast(u32x4, kt[a][ks]); u32x4 o;
                    o.x = pk2(bflo(kw.x) * w0[0], bfhi(kw.x) * w0[1]); o.y = pk2(bflo(kw.y) * w0[2], bfhi(kw.y) * w0[3]); o.z = pk2(bflo(kw.z) * w1[0], bfhi(kw.z) * w1[1]); o.w = pk2(bflo(kw.w) * w1[2], bfhi(kw.w) * w1[3]);
                    kt[a][ks] = __builtin_bit_cast(bf16x8, o); } } }
#pragma unroll
        for (int ks = 0; ks < 2; ++ks)
#pragma unroll
            for (int e = 0; e < NET; ++e) { const bf16x8 bfr = *(const LAS bf16x8*)(lds + OFF_V + (16 * e + fr) * VS + ks * 64 + fq * 16);
#pragma unroll
                for (int a = 0; a < NDT; ++a) accC[a][e] = MFMA16(kt[a][ks], bfr, accC[a][e]); }
        if (!ML) {
#pragma unroll
            for (int a = 0; a < NDT; ++a) { const f32x4 ea = *(const LAS f32x4*)(scal + 16 * (NDT * w + a) + 4 * fq);
#pragma unroll
                for (int e = 0; e < NET; ++e) accC[a][e] = accC[a][e] * ea; } }
        LBAR();
#pragma unroll
        for (int a = 0; a < NDT; ++a)
#pragma unroll
            for (int e = 0; e < NET; ++e) { u32x2 wv; wv.x = pk2(accC[a][e][0], accC[a][e][1]); wv.y = pk2(accC[a][e][2], accC[a][e][3]);
                *(LAS u32x2*)(lds + OFF_C + (16 * e + fr) * QS + (16 * (NDT * w + a) + 4 * fq) * 2) = wv; }
        if (c + 1 < 32) STAGE_WRITE();
        LBAR();
    }
    if (ML) { float* Cp = p.out + O_CP + (size_t)(b * NH + h) * HD * HD; float* np = p.out + O_NP + (size_t)(b * NH + h) * HD;
#pragma unroll
        for (int a = 0; a < NDT; ++a) { const int d = 16 * (NDT * w + a) + 4 * fq;
#pragma unroll
            for (int e = 0; e < 4; ++e) *(f32x4*)(Cp + (size_t)(es * 64 + 16 * e + fr) * HD + d) = accC[a][e];
            if (es == 0 && fr == 0) *(f32x4*)(np + d) = accC[a][NET - 1]; }
    } else { float* Sp = p.out + O_SP + (size_t)(b * NH + h) * GDK * GDV;
#pragma unroll
        for (int a = 0; a < NDT; ++a)
#pragma unroll
            for (int e = 0; e < NET; ++e)
#pragma unroll
                for (int r = 0; r < 4; ++r) Sp[(size_t)(16 * (NDT * w + a) + 4 * fq + r) * GDV + es * 128 + 16 * e + fr] = accC[a][e][r]; }
#undef STAGE_LOAD
#undef STAGE_WRITE
    LBAR();
}
#define SBAR() __syncthreads()
__device__ __forceinline__ void sample_ml(const P& p, LAS unsigned char* lds, int seq, int h) {
    LAS float* qf = (LAS float*)lds; LAS float* kf = qf + 2048; LAS float* vf = kf + 2048; LAS float* n0s = vf + 2048; LAS float* sS = n0s + 256; LAS float* sc = sS + 64; LAS float* qn = sc + 40; LAS float* part = (LAS float*)(lds + 32768);
    int tid_ = threadIdx.x; asm volatile("" : "+v"(tid_));
    const int tid = tid_, w = __builtin_amdgcn_readfirstlane(tid >> 6), lane = tid & 63, fr = lane & 15, fq = lane >> 4;
    const size_t R0 = (size_t)T_P + (size_t)seq * 8, sh = (size_t)seq * NH + h;
    { const int t = tid >> 6, d4 = (tid & 63) * 4;
      const u32x2 qw = *(const u32x2*)(WSP(const bf16_t, A_Q) + (R0 + t) * D + h * 256 + d4), kw = *(const u32x2*)(WSP(const bf16_t, A_K) + (R0 + t) * D + h * 256 + d4);
      *(LAS f32x4*)(qf + t * 256 + d4) = (f32x4){bflo(qw.x), bfhi(qw.x), bflo(qw.y), bfhi(qw.y)}; *(LAS f32x4*)(kf + t * 256 + d4) = (f32x4){bflo(kw.x), bfhi(kw.x), bflo(kw.y), bfhi(kw.y)}; }
    if (tid < 256) { const u32x4 vw = *(const u32x4*)(WSP(const bf16_t, WS_VT) + (size_t)(h * 256 + tid) * T + R0);
        vf[0 * 256 + tid] = bflo(vw.x); vf[1 * 256 + tid] = bfhi(vw.x); vf[2 * 256 + tid] = bflo(vw.y); vf[3 * 256 + tid] = bfhi(vw.y); vf[4 * 256 + tid] = bflo(vw.z); vf[5 * 256 + tid] = bfhi(vw.z); vf[6 * 256 + tid] = bflo(vw.w); vf[7 * 256 + tid] = bfhi(vw.w);
        n0s[tid] = p.in[4][sh * HD + tid]; }
    if (tid < 40) sc[tid] = WSP(const float, M_SC)[(size_t)(tid >> 3) * SC_STRIDE + (size_t)h * T + R0 + (tid & 7)];
    SBAR();
    if (tid < 64) { const int t = tid >> 3, s = tid & 7; float dot = 0.f;
        for (int d = 0; d < 256; ++d) dot += qf[t * 256 + d] * kf[s * 256 + d];
        sS[tid] = (s <= t) ? dot * expf(sc[s] - sc[8 + t]) : 0.f; }
    else if (tid < 72) { const int t = tid - 64; float dot = 0.f; for (int d = 0; d < 256; ++d) dot += qf[t * 256 + d] * n0s[d]; qn[t] = dot; }
    SBAR();
    if (tid < 8) { float den = sc[16 + tid] * qn[tid]; for (int s = 0; s < 8; ++s) den += sS[tid * 8 + s]; WSP(float, M_DEN)[(R0 + tid) * 4 + h] = fmaxf(fabsf(den), sc[32 + tid]); }
    const int d0 = 32 * w + 8 * fq; const float dec = sc[16 + 7];
    float kr[8][8];
#pragma unroll
    for (int s = 0; s < 8; ++s) { const f32x4 k0 = *(const LAS f32x4*)(kf + s * 256 + d0), k1 = *(const LAS f32x4*)(kf + s * 256 + d0 + 4); const float ws_ = sc[24 + s];
        kr[s][0] = k0[0] * ws_; kr[s][1] = k0[1] * ws_; kr[s][2] = k0[2] * ws_; kr[s][3] = k0[3] * ws_; kr[s][4] = k1[0] * ws_; kr[s][5] = k1[1] * ws_; kr[s][6] = k1[2] * ws_; kr[s][7] = k1[3] * ws_; }
    bf16x8 qfrag; { u32x4 o = {0u, 0u, 0u, 0u}; if (fr < 8) { const f32x4 q0 = *(const LAS f32x4*)(qf + fr * 256 + d0), q1 = *(const LAS f32x4*)(qf + fr * 256 + d0 + 4);
        o.x = pk2(q0[0], q0[1]); o.y = pk2(q0[2], q0[3]); o.z = pk2(q1[0], q1[1]); o.w = pk2(q1[2], q1[3]); } qfrag = __builtin_bit_cast(bf16x8, o); }
    if (fr == 0) { float nn[8];
#pragma unroll
        for (int j = 0; j < 8; ++j) { float a = dec * n0s[d0 + j];
#pragma unroll
            for (int s = 0; s < 8; ++s) a += kr[s][j]; nn[j] = a; }
        float* no = p.out + O_NS + sh * HD + d0; *(f32x4*)no = (f32x4){nn[0], nn[1], nn[2], nn[3]}; *(f32x4*)(no + 4) = (f32x4){nn[4], nn[5], nn[6], nn[7]}; }
    const float* C0 = p.in[3] + sh * HD * HD; float* Cn = p.out + O_CS + sh * HD * HD;
#pragma unroll 4
    for (int strip = 0; strip < 16; ++strip) { const int e = 16 * strip + fr;
        const f32x4 c0 = *(const f32x4*)(C0 + (size_t)e * HD + d0), c1 = *(const f32x4*)(C0 + (size_t)e * HD + d0 + 4);
        float cn[8] = {c0[0] * dec, c0[1] * dec, c0[2] * dec, c0[3] * dec, c1[0] * dec, c1[1] * dec, c1[2] * dec, c1[3] * dec};
#pragma unroll
        for (int s = 0; s < 8; ++s) { const float vv = vf[s * 256 + e];
#pragma unroll
            for (int j = 0; j < 8; ++j) cn[j] += vv * kr[s][j]; }
        *(f32x4*)(Cn + (size_t)e * HD + d0) = (f32x4){cn[0], cn[1], cn[2], cn[3]}; *(f32x4*)(Cn + (size_t)e * HD + d0 + 4) = (f32x4){cn[4], cn[5], cn[6], cn[7]};
        u32x4 o; o.x = pk2(c0[0], c0[1]); o.y = pk2(c0[2], c0[3]); o.z = pk2(c1[0], c1[1]); o.w = pk2(c1[2], c1[3]);
        const f32x4 acc = MFMA16(__builtin_bit_cast(bf16x8, o), qfrag, ((f32x4){0.f, 0.f, 0.f, 0.f}));
        if (fr < 8) {
#pragma unroll
            for (int r = 0; r < 4; ++r) part[(size_t)(w * 256 + 16 * strip + 4 * fq + r) * 8 + fr] = acc[r]; } }
    SBAR();
    { const int t = tid >> 6, e4 = (tid & 63) * 4; float o4[4];
#pragma unroll
      for (int i = 0; i < 4; ++i) { float qc = 0.f;
#pragma unroll
          for (int ww = 0; ww < 8; ++ww) qc += part[(size_t)(ww * 256 + e4 + i) * 8 + t];
          float a = sc[16 + t] * qc;
#pragma unroll
          for (int s = 0; s < 8; ++s) a += sS[t * 8 + s] * vf[s * 256 + e4 + i];
          o4[i] = a; }
      u32x2 wv; wv.x = pk2(o4[0], o4[1]); wv.y = pk2(o4[2], o4[3]); *(u32x2*)(WSP(bf16_t, WS_HN) + (R0 + t) * D + h * 256 + e4) = wv; }
    SBAR();
}
__device__ __forceinline__ void sample_gla(const P& p, LAS unsigned char* lds, int seq, int h) {
    LAS float* qf = (LAS float*)lds; LAS float* kf = qf + 1024; LAS float* vf = kf + 1024; LAS float* eal = vf + 2048; LAS float* att = eal + 128; LAS float* part = (LAS float*)(lds + 32768);
    int tid_ = threadIdx.x; asm volatile("" : "+v"(tid_));
    const int tid = tid_, w = __builtin_amdgcn_readfirstlane(tid >> 6), lane = tid & 63;
    const size_t R0 = (size_t)T_P + (size_t)seq * 8, sh = (size_t)seq * NH + h;
    { const int t = tid >> 6, d2 = (tid & 63) * 2;
      const unsigned qw = *(const unsigned*)(WSP(const bf16_t, A_QT) + (R0 + t) * GKW + h * 128 + d2), kw = *(const unsigned*)(WSP(const bf16_t, G_KT) + (R0 + t) * GKW + h * 128 + d2);
      qf[t * 128 + d2] = bflo(qw); qf[t * 128 + d2 + 1] = bfhi(qw); kf[t * 128 + d2] = bflo(kw); kf[t * 128 + d2 + 1] = bfhi(kw); }
    if (tid < 256) { const u32x4 vw = *(const u32x4*)(WSP(const bf16_t, WS_VT) + (size_t)(1024 + h * 256 + tid) * T + R0);
        vf[0 * 256 + tid] = bflo(vw.x); vf[1 * 256 + tid] = bfhi(vw.x); vf[2 * 256 + tid] = bflo(vw.y); vf[3 * 256 + tid] = bfhi(vw.y); vf[4 * 256 + tid] = bflo(vw.z); vf[5 * 256 + tid] = bfhi(vw.z); vf[6 * 256 + tid] = bflo(vw.w); vf[7 * 256 + tid] = bfhi(vw.w); }
    else if (tid < 384) eal[tid - 256] = WSP(const float, M_EAL)[(size_t)(256 + seq) * GKW + h * 128 + (tid - 256)];
    SBAR();
    if (tid < 64) { const int t = tid >> 3, s = tid & 7; float dot = 0.f; for (int d = 0; d < 128; ++d) dot += qf[t * 128 + d] * kf[s * 128 + d]; att[tid] = (s <= t) ? dot : 0.f; }
    const int e4 = 4 * lane;
    f32x4 vr[8], ai[8];
#pragma unroll
    for (int s = 0; s < 8; ++s) { vr[s] = *(const LAS f32x4*)(vf + s * 256 + e4); ai[s] = (f32x4){0.f, 0.f, 0.f, 0.f}; }
    const float* S0 = p.in[6] + sh * GDK * GDV; float* Sn = p.out + O_SS + sh * GDK * GDV;
#pragma unroll 4
    for (int dd = 0; dd < 16; ++dd) { const int d = 16 * w + dd;
        const f32x4 s0 = *(const f32x4*)(S0 + (size_t)d * GDV + e4); f32x4 up = s0;
#pragma unroll
        for (int s = 0; s < 8; ++s) { up += vr[s] * kf[s * 128 + d]; ai[s] += s0 * qf[s * 128 + d]; }
        *(f32x4*)(Sn + (size_t)d * GDV + e4) = up * eal[d]; }
#pragma unroll
    for (int t = 0; t < 8; ++t) *(LAS f32x4*)(part + (size_t)(w * 8 + t) * 256 + e4) = ai[t];
    SBAR();
    { const int t = tid >> 6; f32x4 o = {0.f, 0.f, 0.f, 0.f};
#pragma unroll
      for (int ww = 0; ww < 8; ++ww) o += *(const LAS f32x4*)(part + (size_t)(ww * 8 + t) * 256 + e4);
#pragma unroll
      for (int s = 0; s < 8; ++s) o += *(const LAS f32x4*)(vf + s * 256 + e4) * att[t * 8 + s];
      u32x2 wv; wv.x = pk2(o[0], o[1]); wv.y = pk2(o[2], o[3]); *(u32x2*)(WSP(bf16_t, WS_XBF) + (R0 + t) * D + h * 256 + e4) = wv; }
    SBAR();
}
#ifndef MK_SCAN_PARTS
#define MK_SCAN_PARTS 3
#endif
__device__ __forceinline__ void p5_scan(const P& p, LAS unsigned char* lds, int bid, int G, unsigned* counter, int parts) {
    if (parts & 1) for (int it = bid; it < 192; it += G) {
        if (it < 128) scan_prompt<true>(p, lds, it >> 4, (it >> 2) & 3, it & 3);
        else { const int i = it - 128; scan_prompt<false>(p, lds, i >> 3, (i >> 1) & 3, i & 1); }
    }
    LAS int* slot = (LAS int*)(lds + 140 * 1024);
    if (parts & 2) for (;;) {
        if (threadIdx.x == 0) *slot = (int)atomicAdd(counter, 1u);
        SBAR();
        const int it = *slot;
        SBAR();
        if (it >= 1024) break;
        if (it < 512) sample_ml(p, lds, it >> 2, it & 3); else sample_gla(p, lds, (it - 512) >> 2, it & 3);
    }
}
__device__ __forceinline__ void p5b_norm(const P& p, int gw, int NGW, int lane) {
    const bf16_t* HN = WSP(const bf16_t, WS_HN); const bf16_t* OG = WSP(const bf16_t, WS_XBF); const bf16_t* SIGO = WSP(const bf16_t, S_SIGO); const bf16_t* SILUR = WSP(const bf16_t, S_SILUR);
    bf16_t* HM = WSP(bf16_t, A_Q); bf16_t* OGN = WSP(bf16_t, A_K); const float* DEN = WSP(const float, M_DEN);
    const int h = lane >> 4, c0 = h * 256 + (lane & 15) * 16;
    float gm[16], gg[16];
#pragma unroll
    for (int i = 0; i < 16; ++i) { gm[i] = p.in[17][c0 + i]; gg[i] = p.in[20][c0 + i]; }
    for (int row = gw; row < T; row += NGW) {
#pragma unroll
        for (int br = 0; br < 2; ++br) {
            const bf16_t* src = (br == 0 ? HN : OG) + (size_t)row * D + c0; const bf16_t* gsrc = (br == 0 ? SIGO : SILUR) + (size_t)row * D + c0;
            const u32x4 a = *(const u32x4*)src, b = *(const u32x4*)(src + 8), ga = *(const u32x4*)gsrc, gb = *(const u32x4*)(gsrc + 8);
            float v[16] = {bflo(a.x), bfhi(a.x), bflo(a.y), bfhi(a.y), bflo(a.z), bfhi(a.z), bflo(a.w), bfhi(a.w), bflo(b.x), bfhi(b.x), bflo(b.y), bfhi(b.y), bflo(b.z), bfhi(b.z), bflo(b.w), bfhi(b.w)};
            float gt[16] = {bflo(ga.x), bfhi(ga.x), bflo(ga.y), bfhi(ga.y), bflo(ga.z), bfhi(ga.z), bflo(ga.w), bfhi(ga.w), bflo(gb.x), bfhi(gb.x), bflo(gb.y), bfhi(gb.y), bflo(gb.z), bfhi(gb.z), bflo(gb.w), bfhi(gb.w)};
            float ss = 0.f;
#pragma unroll
            for (int i = 0; i < 16; ++i) ss += v[i] * v[i];
            ss += __shfl_xor(ss, 1); ss += __shfl_xor(ss, 2); ss += __shfl_xor(ss, 4); ss += __shfl_xor(ss, 8);
            float extra = EPS; if (br == 0) { const float dn = DEN[(size_t)row * 4 + h]; extra = EPS * dn * dn; }
            const float sc = 1.f / sqrtf(ss * (1.f / 256.f) + extra);
            unsigned o[8];
#pragma unroll
            for (int i = 0; i < 8; ++i) { const float g0 = br == 0 ? gm[2 * i] : gg[2 * i], g1 = br == 0 ? gm[2 * i + 1] : gg[2 * i + 1]; o[i] = pk2(gt[2 * i] * g0 * v[2 * i] * sc, gt[2 * i + 1] * g1 * v[2 * i + 1] * sc); }
            bf16_t* dst = (br == 0 ? HM : OGN) + (size_t)row * D + c0;
            *(u32x4*)dst = (u32x4){o[0], o[1], o[2], o[3]}; *(u32x4*)(dst + 8) = (u32x4){o[4], o[5], o[6], o[7]};
        }
    }
}
__device__ __forceinline__ void p10_final(const P& p, int gw, int NGW, int lane) {
    const f32x4* g4 = (const f32x4*)p.in[27] + lane; f32x4 g[4];
#pragma unroll
    for (int j = 0; j < 4; ++j) g[j] = g4[64 * j];
    for (int row = gw; row < T; row += NGW) {
        f32x4* xr = (f32x4*)(p.out + (size_t)row * D) + lane; f32x4 v[4]; float s = 0.f;
#pragma unroll
        for (int j = 0; j < 4; ++j) { v[j] = xr[64 * j]; s += (v[j].x * v[j].x + v[j].y * v[j].y) + (v[j].z * v[j].z + v[j].w * v[j].w); }
        const float rs = 1.f / sqrtf(wave_sum(s) * (1.f / D) + EPS);
#pragma unroll
        for (int j = 0; j < 4; ++j) xr[64 * j] = v[j] * rs * g[j];
    }
}
constexpr int LDS_BYTES = 147456;
constexpr int CW_CNT = 64;
constexpr int CW_BAR = 1024;
constexpr int CTL_ZERO_BYTES = 32768;
#ifndef MK_PH_LO
#define MK_PH_LO 0
#endif
#ifndef MK_PH_HI
#define MK_PH_HI 99
#endif
#ifndef MK_REP
#define MK_REP 0
#endif
__global__ void __launch_bounds__(NTHR, 2) mk_fwd(P p) {
    cg::grid_group grid = cg::this_grid();
    extern __shared__ __attribute__((aligned(16))) unsigned char lds_raw[];
    LAS unsigned char* lds = (LAS unsigned char*)lds_raw;
    const int bid = blockIdx.x, G = gridDim.x, NGW = G * NWAVES; const size_t gsz = (size_t)G * NTHR;
    if (threadIdx.x < 4) ((LAS unsigned*)(lds + 140 * 1024 + 16))[threadIdx.x] = 0u;
    __syncthreads();
    const XcdBarrier xbar = xcd_barrier_post((unsigned*)(p.ws + WS_CTL) + CW_BAR, (volatile LAS unsigned*)(lds + 140 * 1024 + 16));
#define GRID_BAR() xcd_barrier(xbar)
#define TIDX() int tid = threadIdx.x; asm volatile("" : "+v"(tid)); const int lane = tid & 63, wave = __builtin_amdgcn_readfirstlane(tid >> 6), gw = bid * NWAVES + wave; const size_t gtid = (size_t)bid * NTHR + tid; (void)lane; (void)gw; (void)gtid
    float* SSQ = WSP(float, M_SSQ); float* XRES = p.out;
    bf16_t* XBF = WSP(bf16_t, WS_XBF); bf16_t* ACT = WSP(bf16_t, WS_ACT);
    constexpr int NM = T / 256;
#define PH(k) (MK_PH_LO <= (k) && (k) <= MK_PH_HI)
#define PHASE_BEGIN(k) for (int rep_ = 0; rep_ <= ((MK_REP >> (k)) & 1); ++rep_) { if (rep_) GRID_BAR(); if (PH(k)) {
#define PHASE_END } }
    PHASE_BEGIN(0) TIDX(); p0_prologue(p, lds, gw, NGW, wave, lane); PHASE_END
    grid.sync();
    PHASE_BEGIN(1) pg8::Gemm g{XBF, WSP(bf16_t, W_UP1), nullptr, nullptr, D, D, D, 0, 0}; pg8::Sched S; S.init(NM, 2 * FF / 256, 1, 0, 0, 0, G, bid);
        EpiUp E{SSQ, ACT}; pg8::gemm_phase(lds, g, S, E); PHASE_END
    GRID_BAR();
    PHASE_BEGIN(2) pg8::Gemm g{ACT, WSP(bf16_t, W_DN1), nullptr, nullptr, FF, FF, FF, 0, 0}; pg8::Sched S; S.init(NM, D / 256, 1, 0, 0, 0, G, bid);
        EpiRes<true> E{p.in[0], p.in[1] - (size_t)T_P * D, XRES, XBF, SSQ, 0.5f}; pg8::gemm_phase(lds, g, S, E); PHASE_END
    GRID_BAR();
    PHASE_BEGIN(3) const bf16_t* Wi = WSP(bf16_t, W_IN); pg8::Gemm g{XBF, Wi, Wi + (size_t)6400 * D, XBF, D, D, D, 0, 0}; pg8::Sched S; S.init(NM, 25, 1, 8, NM, 1, G, bid);
        EpiIn E{SSQ, DOP(bf16_t, DO_U), WSP(bf16_t, S_SIGO), DOP(bf16_t, DO_QG), DOP(bf16_t, DO_KG), WSP(bf16_t, S_SILUR), WSP(bf16_t, S_SIGA), WSP(bf16_t, S_SIGB), WSP(bf16_t, WS_VT), WSP(float, M_GATES)};
        pg8::gemm_phase(lds, g, S, E); PHASE_END
    GRID_BAR();
    PHASE_BEGIN(4) TIDX(); p4_gates(p, lds, bid, tid); p4_gla(p, bid, G, tid); p4_conv(p, gtid, gsz); PHASE_END
    GRID_BAR();
    PHASE_BEGIN(5) const bf16_t* Wqk = WSP(bf16_t, W_QK); const bf16_t* CH = DOP(bf16_t, DO_CH); pg8::Gemm g{CH, Wqk, Wqk + (size_t)256 * D, CH, D, D, 256, 256, 256}; pg8::Sched S; S.init(NM, 2, 4, 1, NM, 4, G, bid);
        EpiQK E{WSP(bf16_t, A_Q), WSP(bf16_t, A_K), WSP(bf16_t, WS_KT)}; pg8::gemm_phase(lds, g, S, E); PHASE_END
    GRID_BAR();
    PHASE_BEGIN(6) p5_scan(p, lds, bid, G, (unsigned*)(p.ws + WS_CTL) + CW_CNT + rep_, rep_ ? MK_SCAN_PARTS : 3); PHASE_END
    GRID_BAR();
    PHASE_BEGIN(7) TIDX(); p5b_norm(p, gw, NGW, lane); PHASE_END
    GRID_BAR();
    PHASE_BEGIN(8) pg8::Sched S; S.init(NM, D / 256, 1, 0, 0, 0, G, bid); float* YT = WSP(float, WS_VT); bf16_t* Y = WSP(bf16_t, WS_KT);
        { pg8::Gemm g{WSP(bf16_t, A_Q), WSP(bf16_t, W_PA), nullptr, nullptr, D, D, D, 0, 0}; EpiMerge<0> E{WSP(bf16_t, S_SIGA), YT, Y}; pg8::gemm_phase(lds, g, S, E); }
        { pg8::Gemm g{WSP(bf16_t, A_K), WSP(bf16_t, W_PB), nullptr, nullptr, D, D, D, 0, 0}; EpiMerge<1> E{WSP(bf16_t, S_SIGB), YT, Y}; pg8::gemm_phase(lds, g, S, E); } PHASE_END
    GRID_BAR();
    PHASE_BEGIN(9) pg8::Gemm g{WSP(bf16_t, WS_KT), WSP(bf16_t, W_O), nullptr, nullptr, D, D, D, 0, 0}; pg8::Sched S; S.init(NM, D / 256, 1, 0, 0, 0, G, bid);
        EpiRes<true> E{XRES, XRES, XRES, XBF, SSQ, 1.0f}; pg8::gemm_phase(lds, g, S, E); PHASE_END
    GRID_BAR();
    PHASE_BEGIN(10) pg8::Gemm g{XBF, WSP(bf16_t, W_UP2), nullptr, nullptr, D, D, D, 0, 0}; pg8::Sched S; S.init(NM, 2 * FF / 256, 1, 0, 0, 0, G, bid);
        EpiUp E{SSQ, ACT}; pg8::gemm_phase(lds, g, S, E); PHASE_END
    GRID_BAR();
    PHASE_BEGIN(11) pg8::Gemm g{ACT, WSP(bf16_t, W_DN2), nullptr, nullptr, FF, FF, FF, 0, 0}; pg8::Sched S; S.init(NM, D / 256, 1, 0, 0, 0, G, bid);
        EpiRes<false> E{XRES, XRES, XRES, XBF, SSQ, 0.5f}; pg8::gemm_phase(lds, g, S, E); PHASE_END
    GRID_BAR();
#ifdef MK_EXTRA_SYNCS
    for (int i_ = 0; i_ < MK_EXTRA_SYNCS; ++i_) GRID_BAR();
#endif
    PHASE_BEGIN(12) TIDX(); p10_final(p, gw, NGW, lane); PHASE_END
#undef PH
#undef TIDX
#undef PHASE_BEGIN
#undef PHASE_END
#undef GRID_BAR
}
}

static int mk_launch(void* const* d_in, const int* in_sizes, int n_in, void* d_out, int out_size, void* d_ws, size_t ws_size, hipStream_t stream) {
    static int grid = 0;
    if (grid == 0) {
        if (n_in != 28 || (size_t)out_size != mk::O_END || ws_size < mk::WS_END) { fprintf(stderr, "kernel_launch: built for 28 inputs, %zu outputs, >= %zu bytes of workspace; got n_in %d, out %d, ws %zu; nothing launched\n", (size_t)mk::O_END, (size_t)mk::WS_END, n_in, out_size, ws_size); grid = -1; return -1; }
        int dev = 0, cus = 0, per_cu = 0;
        if (hipGetDevice(&dev) != hipSuccess || hipDeviceGetAttribute(&cus, hipDeviceAttributeMultiprocessorCount, dev) != hipSuccess) { grid = -1; return -1; }
        if (hipFuncSetAttribute((const void*)mk::mk_fwd, hipFuncAttributeMaxDynamicSharedMemorySize, mk::LDS_BYTES) != hipSuccess) { fprintf(stderr, "kernel_launch: hipFuncSetAttribute failed\n"); grid = -1; return -1; }
        if (hipOccupancyMaxActiveBlocksPerMultiprocessor(&per_cu, (const void*)mk::mk_fwd, mk::NTHR, mk::LDS_BYTES) != hipSuccess || per_cu < 1) { fprintf(stderr, "kernel_launch: occupancy query reports %d blocks per CU\n", per_cu); grid = -1; (void)hipGetLastError(); return -1; }
        grid = cus;
    }
    if (grid < 0) return -1;
    if (hipMemsetAsync((char*)d_ws + mk::WS_CTL, 0, mk::CTL_ZERO_BYTES, stream) != hipSuccess) return -1;
    mk::P prm{}; for (int i = 0; i < 28; ++i) prm.in[i] = (const float*)d_in[i]; prm.out = (float*)d_out; prm.ws = (unsigned char*)d_ws;
    void* args[] = {&prm};
    const hipError_t e = hipLaunchCooperativeKernel((const void*)mk::mk_fwd, dim3(grid), dim3(mk::NTHR), args, mk::LDS_BYTES, stream);
    if (e != hipSuccess) { fprintf(stderr, "cooperative launch failed: %s (grid %d)\n", hipGetErrorString(e), grid); return -1; }
    return 0;
}
extern "C" void kernel_launch(void* const* d_in, const int* in_sizes, int n_in, void* d_out, int out_size, void* d_ws, size_t ws_size, hipStream_t stream) {
    (void)mk_launch(d_in, in_sizes, n_in, d_out, out_size, d_ws, ws_size, stream);
}
```

```cpp
#include <hip/hip_runtime.h>
#include <cstdio>
#include <cstdint>
#include <hip/hip_cooperative_groups.h>
namespace cg = cooperative_groups;
namespace mk {
#define LAS __attribute__((address_space(3)))
#define GAS __attribute__((address_space(1)))
typedef unsigned short bf16_t;
typedef short bf16x8 __attribute__((ext_vector_type(8)));
typedef float f32x4 __attribute__((ext_vector_type(4)));
typedef float f32x2 __attribute__((ext_vector_type(2)));
typedef unsigned u32x4 __attribute__((ext_vector_type(4)));
typedef unsigned u32x2 __attribute__((ext_vector_type(2)));

constexpr int D = 1024, FF = 2816, T_P = 16384, T_S = 1024, T = T_P + T_S, SEQ = 2048, NB = 8, DEC_B = 128, DEC_T = 8;
constexpr int NH = 4, HD = 256, GDK = 128, GDV = 256, GKW = 512, INW = 8216;
constexpr int NWAVES = 8, NTHR = 512;
constexpr float EPS = 1e-6f;
constexpr int NCH_P = T_P / 64;
constexpr int NGRP = T / 64;

__device__ __forceinline__ unsigned f2bf(float f) { unsigned u = __builtin_bit_cast(unsigned, f); return (u + 0x7fffu + ((u >> 16) & 1u)) >> 16; }
__device__ __forceinline__ unsigned pk2(float lo, float hi) { return f2bf(lo) | (f2bf(hi) << 16); }
__device__ __forceinline__ float bf2f(unsigned short b) { return __builtin_bit_cast(float, (unsigned)b << 16); }
__device__ __forceinline__ float bflo(unsigned w) { return __builtin_bit_cast(float, w << 16); }
__device__ __forceinline__ float bfhi(unsigned w) { return __builtin_bit_cast(float, w & 0xffff0000u); }
__device__ __forceinline__ float sigmoid_(float x) { return 1.f / (1.f + __expf(-x)); }
__device__ __forceinline__ float silu_(float x) { return x / (1.f + __expf(-x)); }
__device__ __forceinline__ float logsigmoid_(float x) { return fminf(x, 0.f) - log1pf(expf(-fabsf(x))); }
__device__ __forceinline__ float wave_sum(float v) {
#pragma unroll
    for (int o = 1; o < 64; o <<= 1) v += __shfl_xor(v, o);
    return v;
}

#define XB_TMO      128
#define XB_XCNT(j)  (256  + 64 * (j))
#define XB_XSUB(j)  (1280 + 64 * (j))
#define XB_XGEN(j)  (2304 + 64 * (j))
#define XB_TOP      3328
#define XB_TOPGEN   3392
#define XCD_BAR_WORDS 3456
#define XB_SPIN_CAP (1u << 18)
__device__ __forceinline__ unsigned xb_ld(unsigned* p)              { return __hip_atomic_load(p, __ATOMIC_RELAXED, __HIP_MEMORY_SCOPE_AGENT); }
__device__ __forceinline__ unsigned xb_add(unsigned* p, unsigned v) { return __hip_atomic_fetch_add(p, v, __ATOMIC_RELAXED, __HIP_MEMORY_SCOPE_AGENT); }
__device__ __forceinline__ unsigned xb_xcc_id() { return (unsigned)__builtin_amdgcn_s_getreg((3 << 11) | 20) & 0xFu; }
#define XB_SPIN(cond, bar) do { unsigned _sp = 0; while (cond) { __builtin_amdgcn_s_sleep(1); \
    if ((++_sp & 255u) == 0u) { if (xb_ld(&(bar)[XB_TMO])) break; if (_sp > XB_SPIN_CAP) { atomicAdd(&(bar)[XB_TMO], 1u); break; } } } } while (0)
struct XcdBarrier { unsigned* bar; unsigned x; volatile LAS unsigned* st; };
__device__ __forceinline__ XcdBarrier xcd_barrier_post(unsigned* bar, volatile LAS unsigned* st) {
    XcdBarrier b; b.bar = bar; b.x = xb_xcc_id(); b.st = st;
    if (threadIdx.x == 0) (void)xb_add(&bar[XB_XCNT(b.x)], 1u);
    return b;
}
__device__ __forceinline__ void xcd_barrier_complete(unsigned* bar, unsigned x, unsigned& nloc, unsigned& nx) {
    const unsigned G = gridDim.x * gridDim.y * gridDim.z;
    unsigned sum, cnt, mine, sp = 0u;
    for (;;) {
        sum = 0u; cnt = 0u; mine = 0u;
#pragma unroll
        for (unsigned j = 0; j < 16; ++j) { const unsigned c = xb_ld(&bar[XB_XCNT(j)]); sum += c; cnt += (c > 0u) ? 1u : 0u; mine = (j == x) ? c : mine; }
        if (sum == G) break;
        __builtin_amdgcn_s_sleep(1);
        if ((++sp & 255u) == 0u) { if (xb_ld(&bar[XB_TMO])) break; if (sp > XB_SPIN_CAP) { atomicAdd(&bar[XB_TMO], 1u); break; } }
    }
    nloc = mine > 0u ? mine : 1u; nx = cnt > 0u ? cnt : 1u;
}
__device__ __forceinline__ void xcd_barrier(const XcdBarrier& b) {
    asm volatile("s_waitcnt vmcnt(0)" ::: "memory");
    __syncthreads();
    if (threadIdx.x == 0) {
        unsigned* bar = b.bar;
        __builtin_amdgcn_s_waitcnt(0);
        unsigned nloc = b.st[0], nx = b.st[1];
        if (nloc == 0u) { xcd_barrier_complete(bar, b.x, nloc, nx); b.st[0] = nloc; b.st[1] = nx; }
        const unsigned old = xb_add(&bar[XB_XSUB(b.x)], 1u);
        const unsigned gen = old / nloc;
        if (old + 1u == (gen + 1u) * nloc) {
            __builtin_amdgcn_fence(__ATOMIC_RELEASE, "agent");
            asm volatile("s_waitcnt vmcnt(0)" ::: "memory");
            const unsigned og = xb_add(&bar[XB_TOP], 1u);
            const unsigned tg = og / nx;
            if (og + 1u == (tg + 1u) * nx) xb_add(&bar[XB_TOPGEN], 1u);
            else XB_SPIN(xb_ld(&bar[XB_TOPGEN]) == tg, bar);
            __builtin_amdgcn_fence(__ATOMIC_ACQUIRE, "agent");
            xb_add(&bar[XB_XGEN(b.x)], 1u);
            asm volatile("s_waitcnt vmcnt(0)" ::: "memory");
        } else {
            XB_SPIN(xb_ld(&bar[XB_XGEN(b.x)]) == gen, bar);
            __builtin_amdgcn_fence(__ATOMIC_ACQUIRE, "agent");
            asm volatile("s_waitcnt vmcnt(0)" ::: "memory");
        }
    }
    __syncthreads();
}

namespace pg8 {
constexpr int BM = 256, BK = 64, HALF = 128, HTB = HALF * BK * 2, STAGE_BYTES = 8 * HTB, NXCD = 8, WGM = 8;
__host__ __device__ __forceinline__ int lds_byte(int r, int c) { const int st = (r >> 4) * 2 + (c >> 5), rr = r & 15, cc = c & 31, ob = rr * 64 + cc * 2; return st * 1024 + (ob ^ (((ob >> 9) & 1) << 5)); }
__host__ __device__ __forceinline__ void stage_rc(int b, int& R, int& C) { const int st = b / 1024, sb = b % 1024, swz = sb ^ (((sb >> 9) & 1) << 5); R = (st >> 1) * 16 + swz / 64; C = (st & 1) * 32 + (swz % 64) / 2; }
__host__ __device__ __forceinline__ int perm32(int rho) { const int n = rho >> 4, i = rho & 15; return 8 * (i >> 2) + 4 * n + (i & 3); }

struct Unit { int pm, pn, seg, z; };
struct Gemm { const bf16_t* A0; const bf16_t* B0; const bf16_t* A1; const bf16_t* B1; int lda, ldb, K, zA, zB; };
struct Sched {
    int nM0, nN0, nM1, nN1, n0, ntot, G, c;
    __device__ void init(int nM0_, int nN0_, int nz0, int nM1_, int nN1_, int nz1, int G_, int c_) { nM0 = nM0_; nN0 = nN0_; nM1 = nM1_; nN1 = nN1_; n0 = nM0 * nN0 * nz0; ntot = n0 + nM1 * nN1 * nz1; G = G_; c = c_; }
    __device__ bool next(int i, Unit& u) const {
        int L = i * G + c; if (L >= ntot) return false;
        int nM = nM0, nN = nN0; u.seg = 0; if (L >= n0) { L -= n0; nM = nM1; nN = nN1; u.seg = 1; }
        const int nwg = nM * nN; u.z = L / nwg; int wgid = L - u.z * nwg;
        { const int q = nwg / NXCD, r = nwg % NXCD, xcd = wgid % NXCD, off = wgid / NXCD; wgid = (xcd < r ? xcd * (q + 1) : r * (q + 1) + (xcd - r) * q) + off; }
        const int nig = WGM * nN, gid = wgid / nig, fm = gid * WGM, gsz = (nM - fm) < WGM ? (nM - fm) : WGM;
        u.pm = fm + ((wgid % nig) % gsz); u.pn = (wgid % nig) / gsz; return true;
    }
};
template <class Epi>
__device__ __forceinline__ void gemm_phase(LAS unsigned char* lds, const Gemm g, const Sched& S, const Epi& E) {
    int tid_ = threadIdx.x; asm volatile("" : "+v"(tid_));
    const int tid = tid_, wid = __builtin_amdgcn_readfirstlane(tid >> 6), lane = tid & 63, wr = wid >> 2, wc = wid & 3, fr = lane & 15, fq = lane >> 4;
    int K_ = g.K; asm volatile("" : "+s"(K_));
    const int K = K_, nt = K / BK;
    unsigned voffA[2], voffB[2];
#pragma unroll
    for (int i = 0; i < 2; ++i) { int R, C; stage_rc(tid * 16 + i * 8192, R, C); const int Rb = (R & ~31) + perm32(R & 31);
        voffA[i] = (unsigned)(R * g.lda + C) * 2u; voffB[i] = (unsigned)(Rb * g.ldb + C) * 2u; }
    const size_t kstep = (size_t)(BK * 2);
    const size_t hstepA = (size_t)HALF * g.lda * 2, hstepB = (size_t)HALF * g.ldb * 2;
    const unsigned ldsw = (unsigned)wid * 1024u;
    const int aoff = lds_byte(wr * 64 + fr, fq * 8), boff = lds_byte(wc * 32 + fr, fq * 8);
#define PG8_SA(b, h) (((b) * 2 + (h)) * HTB)
#define PG8_SB(b, h) ((4 + (b) * 2 + (h)) * HTB)
#define PG8_STAGE(bufoff, gbase, voff) do { _Pragma("unroll") for (int _i = 0; _i < 2; ++_i) \
        __builtin_amdgcn_global_load_lds((const unsigned*)((const char*)(gbase) + (voff)[_i]), (LAS unsigned*)(lds + (bufoff) + ldsw + _i * 8192), 16, 0, 0); } while (0)
#define PG8_LDA(dst, b, h) do { _Pragma("unroll") for (int m = 0; m < 4; ++m) _Pragma("unroll") for (int k = 0; k < 2; ++k) dst[m][k] = *(const LAS bf16x8*)(lds + PG8_SA(b, h) + aoff + m * 2048 + k * 1024); } while (0)
#define PG8_LDB(dst, b, h) do { _Pragma("unroll") for (int n = 0; n < 2; ++n) _Pragma("unroll") for (int k = 0; k < 2; ++k) dst[n][k] = *(const LAS bf16x8*)(lds + PG8_SB(b, h) + boff + n * 2048 + k * 1024); } while (0)
#define PG8_MMA(ai, bj, At, Bt) do { __builtin_amdgcn_s_setprio(1); _Pragma("unroll") for (int m = 0; m < 4; ++m) _Pragma("unroll") for (int n = 0; n < 2; ++n) _Pragma("unroll") for (int k = 0; k < 2; ++k) \
        acc[ai][bj][m][n] = __builtin_amdgcn_mfma_f32_16x16x32_bf16(Bt[n][k], At[m][k], acc[ai][bj][m][n], 0, 0, 0); __builtin_amdgcn_s_setprio(0); } while (0)
#define PG8_WAIT_V(n) asm volatile("s_waitcnt vmcnt(" #n ")" ::: "memory")
#define PG8_WAIT_L(n) asm volatile("s_waitcnt lgkmcnt(" #n ")" ::: "memory")
#define PG8_BAR __builtin_amdgcn_s_barrier()
#define PG8_SCHED __builtin_amdgcn_sched_barrier(0)
#define PG8_ABASE(u) ((const char*)((u).seg ? g.A1 : g.A0) + ((size_t)(u).z * g.zA) * 2 + (size_t)(u).pm * 2 * hstepA)
#define PG8_BBASE(u) ((const char*)((u).seg ? g.B1 : g.B0) + ((size_t)(u).z * g.zB) * 2 + (size_t)(u).pn * 2 * hstepB)
    Unit cur, nxt; int ui = 0;
    if (!S.next(0, cur)) return;
    f32x4 acc[2][2][4][2];
#pragma unroll
    for (int a = 0; a < 2; ++a)
#pragma unroll
        for (int b = 0; b < 2; ++b)
#pragma unroll
            for (int m = 0; m < 4; ++m)
#pragma unroll
                for (int n = 0; n < 2; ++n) acc[a][b][m][n] = (f32x4){0.f, 0.f, 0.f, 0.f};
    bf16x8 At[4][2], B0[2][2], B1[2][2];
    const char* cA = PG8_ABASE(cur); const char* cB = PG8_BBASE(cur);
    PG8_STAGE(PG8_SB(0, 0), cB, voffB); PG8_STAGE(PG8_SB(0, 1), cB + hstepB, voffB); PG8_STAGE(PG8_SA(0, 0), cA, voffA); PG8_STAGE(PG8_SA(0, 1), cA + hstepA, voffA);
    if (wr == 1) PG8_BAR;
    PG8_WAIT_V(2); PG8_BAR;
    PG8_STAGE(PG8_SB(1, 0), cB + kstep, voffB); PG8_STAGE(PG8_SA(1, 0), cA + kstep, voffA); PG8_STAGE(PG8_SB(1, 1), cB + hstepB + kstep, voffB);
    PG8_WAIT_V(6); PG8_BAR;
    for (;;) {
        const bool has_next = S.next(ui + 1, nxt);
        const char* nA = has_next ? PG8_ABASE(nxt) : cA; const char* nB = has_next ? PG8_BBASE(nxt) : cB;
        for (int t = 0; t < nt; t += 2) {
            const bool last = (t == nt - 2);
            const char* a1 = cA + (size_t)(t + 1) * kstep;
            const char* a2 = last ? nA : cA + (size_t)(t + 2) * kstep; const char* b2 = last ? nB : cB + (size_t)(t + 2) * kstep;
            const char* a3 = a2 + kstep; const char* b3 = b2 + kstep;
            PG8_LDB(B0, 0, 0); PG8_LDB(B1, 0, 1); PG8_SCHED; PG8_LDA(At, 0, 0); PG8_STAGE(PG8_SA(1, 1), a1 + hstepA, voffA);
            PG8_WAIT_V(8); PG8_WAIT_L(0); PG8_BAR; PG8_MMA(0, 0, At, B0); PG8_MMA(0, 1, At, B1); PG8_BAR; PG8_SCHED;
            PG8_LDA(At, 0, 1); PG8_STAGE(PG8_SB(0, 0), b2, voffB); PG8_STAGE(PG8_SB(0, 1), b2 + hstepB, voffB); PG8_STAGE(PG8_SA(0, 0), a2, voffA);
            PG8_WAIT_V(8); PG8_WAIT_L(0); PG8_BAR; PG8_MMA(1, 0, At, B0); PG8_MMA(1, 1, At, B1); PG8_BAR; PG8_SCHED;
            PG8_LDB(B0, 1, 0); PG8_LDB(B1, 1, 1); PG8_SCHED; PG8_LDA(At, 1, 0); PG8_STAGE(PG8_SA(0, 1), a2 + hstepA, voffA);
            PG8_WAIT_V(8); PG8_WAIT_L(0); PG8_BAR; PG8_MMA(0, 0, At, B0); PG8_MMA(0, 1, At, B1); PG8_BAR; PG8_SCHED;
            PG8_LDA(At, 1, 1); PG8_STAGE(PG8_SB(1, 0), b3, voffB); PG8_STAGE(PG8_SB(1, 1), b3 + hstepB, voffB); PG8_STAGE(PG8_SA(1, 0), a3, voffA);
            PG8_WAIT_V(8); PG8_WAIT_L(0); PG8_BAR; PG8_MMA(1, 0, At, B0); PG8_MMA(1, 1, At, B1); PG8_BAR; PG8_SCHED;
        }
        if (wr == 0) PG8_BAR;
        if constexpr (Epi::NEEDS_RS) {
            if (tid < 256) { const float* q_ = E.SSQ + (size_t)((cur.seg ? cur.pn : cur.pm) * 256 + tid) * 16; const f32x4 a_ = *(const f32x4*)q_, b_ = *(const f32x4*)(q_ + 4), c_ = *(const f32x4*)(q_ + 8), d_ = *(const f32x4*)(q_ + 12);
                const float s_ = ((a_.x + a_.y) + (a_.z + a_.w)) + ((b_.x + b_.y) + (b_.z + b_.w)) + ((c_.x + c_.y) + (c_.z + c_.w)) + ((d_.x + d_.y) + (d_.z + d_.w));
                ((LAS float*)(lds + STAGE_BYTES))[tid] = 1.f / sqrtf(s_ * (1.f / 1024.f) + 1e-6f); }
            PG8_WAIT_L(0); PG8_BAR; asm volatile("" ::: "memory");
        }
        E(acc, cur, wr, wc, fr, fq, (const LAS float*)(lds + STAGE_BYTES));
        if (!has_next) break;
#pragma unroll
        for (int a = 0; a < 2; ++a)
#pragma unroll
            for (int b = 0; b < 2; ++b)
#pragma unroll
                for (int m = 0; m < 4; ++m)
#pragma unroll
                    for (int n = 0; n < 2; ++n) acc[a][b][m][n] = (f32x4){0.f, 0.f, 0.f, 0.f};
        cur = nxt; cA = nA; cB = nB; ++ui;
        if (wr == 1) PG8_BAR;
    }
    PG8_WAIT_V(0);
    PG8_BAR;
#undef PG8_SA
#undef PG8_SB
#undef PG8_STAGE
#undef PG8_LDA
#undef PG8_LDB
#undef PG8_MMA
#undef PG8_WAIT_V
#undef PG8_WAIT_L
#undef PG8_BAR
#undef PG8_SCHED
#undef PG8_ABASE
#undef PG8_BBASE
}
}
constexpr size_t MiB = 1u << 20;
constexpr size_t SZ_TD2 = (size_t)T * D * 2;
constexpr size_t WS_CTL = 0;
constexpr size_t WS_W = 1 * MiB;
constexpr size_t W_UP1 = WS_W, W_DN1 = W_UP1 + (size_t)2 * FF * D * 2, W_IN = W_DN1 + (size_t)D * FF * 2;
constexpr int NIN = 8448;
constexpr size_t W_QK = W_IN + (size_t)NIN * D * 2, W_PA = W_QK + (size_t)512 * D * 2, W_PB = W_PA + (size_t)D * D * 2, W_O = W_PB + (size_t)D * D * 2;
constexpr size_t W_UP2 = W_O + (size_t)D * D * 2, W_DN2 = W_UP2 + (size_t)2 * FF * D * 2, W_END = W_DN2 + (size_t)D * FF * 2;
static_assert(W_END <= 61 * MiB, "weights");
constexpr size_t WS_XBF = 61 * MiB;
constexpr size_t WS_MISC = WS_XBF + SZ_TD2;
constexpr size_t M_SSQ = WS_MISC;
constexpr size_t M_GATES = M_SSQ + (size_t)T * 16 * 4;
constexpr size_t M_SC = M_GATES + (size_t)T * 32 * 4;
constexpr size_t M_EAL = M_SC + (size_t)5 * NH * T * 4;
constexpr size_t M_DEN = M_EAL + (size_t)384 * GKW * 4;
constexpr size_t M_END = M_DEN + (size_t)T * 4 * 4;
static_assert(M_END <= WS_MISC + 6 * MiB, "misc");
constexpr size_t WS_ACT = WS_MISC + 6 * MiB;
constexpr size_t A_Q = WS_ACT, A_K = A_Q + SZ_TD2, A_QT = A_K + SZ_TD2;
constexpr size_t WS_SIG = WS_ACT + 94 * MiB;
constexpr size_t S_SIGO = WS_SIG, S_SILUR = S_SIGO + SZ_TD2, S_SIGA = S_SILUR + SZ_TD2, S_SIGB = S_SIGA + SZ_TD2;
constexpr size_t WS_VT = WS_SIG + 4 * SZ_TD2;
constexpr size_t WS_KT = WS_VT + 2 * SZ_TD2;
constexpr size_t WS_G = WS_KT + SZ_TD2;
constexpr size_t G_KT = WS_G, G_KTT = WS_G + SZ_TD2 / 2;
constexpr size_t WS_HN = WS_G + SZ_TD2;
constexpr size_t WS_END = WS_HN + SZ_TD2;
static_assert(A_QT + SZ_TD2 / 2 <= WS_SIG && WS_END <= 502 * MiB, "ws map");
constexpr size_t O_YP = 0, O_YS = 16777216, O_CONVP = 17825792, O_CP = 17850368, O_NP = 19947520, O_MP = 19955712, O_SP = 19955744, O_CONVS = 21004320, O_CS = 21397536, O_NS = 54951968, O_MS = 55083040, O_SS = 55083552, O_END = 71860768;
constexpr size_t DO_U = O_CS * 4, DO_QG = DO_U + SZ_TD2, DO_KG = DO_QG + SZ_TD2 / 2, DO_CH = DO_KG + SZ_TD2 / 2;
static_assert(DO_CH + SZ_TD2 <= O_NS * 4, "d_out temporaries");

struct P {
    const float* in[28]; float* out; unsigned char* ws;
};
#define WSP(T_, off) ((T_*)(p.ws + (off)))
#define DOP(T_, off) ((T_*)((unsigned char*)p.out + (off)))

__device__ __forceinline__ int win_src(int n) {
    if (n < 1024) return n;
    if (n < 2048) return 2048 + (n - 1024);
    if (n < 2560) return 3080 + (n - 2048);
    if (n < 3072) return 3592 + (n - 2560);
    if (n < 4096) return 5128 + (n - 3072);
    if (n < 5120) return 6168 + (n - 4096);
    if (n < 6144) return 7192 + (n - 5120);
    if (n < 6400) { const int j = n - 6144; return j < 8 ? 3072 + j : (j < 24 ? 6152 + (j - 8) : -1); }
    if (n < 7424) return 1024 + (n - 6400);
    return 4104 + (n - 7424);
}
__device__ __forceinline__ int up_src(int n) { const int t = n >> 8, r = n & 255; return (r >> 7) * FF + t * 128 + (r & 127); }
template <int MAP>
__device__ __forceinline__ void p0_item(const float* W, int K, int N, const float* gk, float scale, bf16_t* WT, int dst_row0, int ndst, LAS float* scr, int item, int lane) {
    const int nblk = ndst / 32, kb = item / nblk, nb = item % nblk, k0 = 64 * kb, n0 = 32 * nb;
    const int nn = n0 + (lane & 31); const int src = MAP == 0 ? nn : (MAP == 1 ? up_src(nn) : win_src(nn));
    float v[32];
#pragma unroll
    for (int i = 0; i < 32; ++i) { const int kk = 2 * i + (lane >> 5); v[i] = src >= 0 ? W[(size_t)(k0 + kk) * N + src] : 0.f; }
#pragma unroll
    for (int i = 0; i < 32; ++i) scr[(2 * i + (lane >> 5)) * 33 + (lane & 31)] = v[i];
    asm volatile("s_waitcnt lgkmcnt(0)" ::: "memory");
    const int c = lane & 7;
    f32x4 g0 = {scale, scale, scale, scale}, g1 = g0;
    if (gk) { g0 = *(const f32x4*)(gk + k0 + 8 * c) * scale; g1 = *(const f32x4*)(gk + k0 + 8 * c + 4) * scale; }
#pragma unroll
    for (int j = 0; j < 4; ++j) { const int n = (lane >> 3) + 8 * j; const LAS float* s = scr + (8 * c) * 33 + n;
        u32x4 o; o.x = pk2(s[0 * 33] * g0[0], s[1 * 33] * g0[1]); o.y = pk2(s[2 * 33] * g0[2], s[3 * 33] * g0[3]); o.z = pk2(s[4 * 33] * g1[0], s[5 * 33] * g1[1]); o.w = pk2(s[6 * 33] * g1[2], s[7 * 33] * g1[3]);
        *(u32x4*)(WT + (size_t)(dst_row0 + n0 + n) * K + k0 + 8 * c) = o; }
    asm volatile("s_waitcnt lgkmcnt(0)" ::: "memory");
}
__device__ __forceinline__ void p0_prologue(const P& p, LAS unsigned char* lds, int gw, int NGW, int wave, int lane) {
    LAS float* scr = (LAS float*)(lds + wave * 16384);
    constexpr int I_UP = (D / 64) * (2 * FF / 32), I_DN = (FF / 64) * (D / 32), I_IN = (D / 64) * (NIN / 32), I_QK = (D / 64) * (256 / 32), I_SQ = (D / 64) * (D / 32);
    constexpr int NITEMS = 2 * I_UP + 2 * I_DN + I_IN + 2 * I_QK + 3 * I_SQ;
    for (int it = gw; it < NITEMS; it += NGW) {
        int r = it;
        if (r < I_IN) { p0_item<2>(p.in[11], D, INW, p.in[10], 1.f, WSP(bf16_t, W_IN), 0, NIN, scr, r, lane); continue; } r -= I_IN;
        if (r < I_UP) { p0_item<1>(p.in[8], D, 2 * FF, p.in[7], 1.f, WSP(bf16_t, W_UP1), 0, 2 * FF, scr, r, lane); continue; } r -= I_UP;
        if (r < I_UP) { p0_item<1>(p.in[25], D, 2 * FF, p.in[24], 1.f, WSP(bf16_t, W_UP2), 0, 2 * FF, scr, r, lane); continue; } r -= I_UP;
        if (r < I_DN) { p0_item<0>(p.in[9], FF, D, nullptr, 1.f, WSP(bf16_t, W_DN1), 0, D, scr, r, lane); continue; } r -= I_DN;
        if (r < I_DN) { p0_item<0>(p.in[26], FF, D, nullptr, 1.f, WSP(bf16_t, W_DN2), 0, D, scr, r, lane); continue; } r -= I_DN;
        if (r < I_QK) { p0_item<0>(p.in[14], D, 256, nullptr, 1.f, WSP(bf16_t, W_QK), 0, 256, scr, r, lane); continue; } r -= I_QK;
        if (r < I_QK) { p0_item<0>(p.in[15], D, 256, nullptr, 0.0625f, WSP(bf16_t, W_QK), 256, 256, scr, r, lane); continue; } r -= I_QK;
        if (r < I_SQ) { p0_item<0>(p.in[21], D, D, nullptr, 1.f, WSP(bf16_t, W_PA), 0, D, scr, r, lane); continue; } r -= I_SQ;
        if (r < I_SQ) { p0_item<0>(p.in[22], D, D, nullptr, 1.f, WSP(bf16_t, W_PB), 0, D, scr, r, lane); continue; } r -= I_SQ;
        p0_item<0>(p.in[23], D, D, nullptr, 1.f, WSP(bf16_t, W_O), 0, D, scr, r, lane);
    }
    bf16_t* XB = WSP(bf16_t, WS_XBF); float* SSQ = WSP(float, M_SSQ);
    for (int m0 = 2 * gw; m0 < T; m0 += 2 * NGW) {
        f32x4 v[2][4];
#pragma unroll
        for (int r = 0; r < 2; ++r) { const int m = m0 + r; const float* xrow = m < T_P ? p.in[0] + (size_t)m * D : p.in[1] + (size_t)(m - T_P) * D; const f32x4* xr = (const f32x4*)xrow + lane;
#pragma unroll
            for (int j = 0; j < 4; ++j) v[r][j] = xr[64 * j]; }
#pragma unroll
        for (int r = 0; r < 2; ++r) { const int m = m0 + r; float s = 0.f;
#pragma unroll
            for (int j = 0; j < 4; ++j) s += (v[r][j].x * v[r][j].x + v[r][j].y * v[r][j].y) + (v[r][j].z * v[r][j].z + v[r][j].w * v[r][j].w);
            s = wave_sum(s);
            u32x2* o8 = (u32x2*)(XB + (size_t)m * D) + lane;
#pragma unroll
            for (int j = 0; j < 4; ++j) { u32x2 w; w.x = pk2(v[r][j].x, v[r][j].y); w.y = pk2(v[r][j].z, v[r][j].w); o8[64 * j] = w; }
            if (lane < 16) SSQ[(size_t)m * 16 + lane] = lane == 0 ? s : 0.f; }
    }
}
__device__ __forceinline__ float row_rs(const float* SSQ, int row) {
    const f32x4* q = (const f32x4*)(SSQ + (size_t)row * 16); const f32x4 a = q[0], b = q[1], c = q[2], d = q[3];
    const float s = ((a.x + a.y) + (a.z + a.w)) + ((b.x + b.y) + (b.z + b.w)) + ((c.x + c.y) + (c.z + c.w)) + ((d.x + d.y) + (d.z + d.w));
    return 1.f / sqrtf(s * (1.f / D) + EPS);
}

typedef pg8::Unit Unit;
#define EPI_ARGS const f32x4 (&acc)[2][2][4][2], const Unit& u, int wr, int wc, int fr, int fq, const LAS float* rst
struct EpiUp { static constexpr bool NEEDS_RS = true; const float* SSQ; bf16_t* ACT;
    __device__ __forceinline__ void operator()(EPI_ARGS) const {
        const int row0 = u.pm * 256 + wr * 64 + fr, col0 = u.pn * 128 + wc * 32 + 8 * fq;
#pragma unroll
        for (int ai = 0; ai < 2; ++ai)
#pragma unroll
            for (int m = 0; m < 4; ++m) { const int row = row0 + ai * 128 + m * 16; const float rs = rst[wr * 64 + fr + ai * 128 + m * 16]; u32x4 w; unsigned* wp = (unsigned*)&w;
#pragma unroll
                for (int n = 0; n < 2; ++n) { const f32x4 a = acc[ai][0][m][n] * rs, g = acc[ai][1][m][n] * rs;
                    wp[2 * n] = pk2(silu_(g[0]) * a[0], silu_(g[1]) * a[1]); wp[2 * n + 1] = pk2(silu_(g[2]) * a[2], silu_(g[3]) * a[3]); }
                *(u32x4*)(ACT + (size_t)row * FF + col0) = w; }
    }
};
template <bool WB> struct EpiRes { static constexpr bool NEEDS_RS = false; const float* xi_p; const float* xi_s; float* xo; bf16_t* XBo; float* SSQ; float alpha;
    __device__ __forceinline__ void operator()(EPI_ARGS) const {
        const int row0 = u.pm * 256 + wr * 64 + fr; const float* xi = u.pm < T_P / 256 ? xi_p : xi_s;
#pragma unroll
        for (int ai = 0; ai < 2; ++ai)
#pragma unroll
            for (int m = 0; m < 4; ++m) { const int row = row0 + ai * 128 + m * 16; float ss = 0.f;
#pragma unroll
                for (int bj = 0; bj < 2; ++bj) { const int col = u.pn * 256 + bj * 128 + wc * 32 + 8 * fq; const size_t off = (size_t)row * D + col;
                    const f32x4 x0 = *(const f32x4*)(xi + off), x1 = *(const f32x4*)(xi + off + 4);
                    const f32x4 y0 = x0 + acc[ai][bj][m][0] * alpha, y1 = x1 + acc[ai][bj][m][1] * alpha;
                    *(f32x4*)(xo + off) = y0; *(f32x4*)(xo + off + 4) = y1;
                    ss += (y0[0] * y0[0] + y0[1] * y0[1]) + (y0[2] * y0[2] + y0[3] * y0[3]) + (y1[0] * y1[0] + y1[1] * y1[1]) + (y1[2] * y1[2] + y1[3] * y1[3]);
                    if (WB) { u32x4 w; w.x = pk2(y0[0], y0[1]); w.y = pk2(y0[2], y0[3]); w.z = pk2(y1[0], y1[1]); w.w = pk2(y1[2], y1[3]); *(u32x4*)(XBo + off) = w; } }
                ss += __shfl_xor(ss, 16); ss += __shfl_xor(ss, 32);
                if (fq == 0) SSQ[(size_t)row * 16 + u.pn * 4 + wc] = ss; }
    }
};
struct EpiIn { static constexpr bool NEEDS_RS = true; const float* SSQ; bf16_t *U, *SIGO, *QG, *KG, *SILUR, *SIGA, *SIGB, *VT; float* GATES;
    __device__ __forceinline__ void operator()(EPI_ARGS) const {
        if (u.seg == 0) {
            const int row0 = u.pm * 256 + wr * 64 + fr; const int pn = u.pn;
            bf16_t* dst; int ld, cb, act;
            if (pn < 4) { dst = U; ld = D; cb = pn * 256; act = 0; } else if (pn < 8) { dst = SIGO; ld = D; cb = (pn - 4) * 256; act = 1; }
            else if (pn < 10) { dst = QG; ld = GKW; cb = (pn - 8) * 256; act = 0; } else if (pn < 12) { dst = KG; ld = GKW; cb = (pn - 10) * 256; act = 0; }
            else if (pn < 16) { dst = SILUR; ld = D; cb = (pn - 12) * 256; act = 2; } else if (pn < 20) { dst = SIGA; ld = D; cb = (pn - 16) * 256; act = 1; }
            else { dst = SIGB; ld = D; cb = (pn - 20) * 256; act = 1; }
#pragma unroll
            for (int ai = 0; ai < 2; ++ai)
#pragma unroll
                for (int m = 0; m < 4; ++m) { const int row = row0 + ai * 128 + m * 16; const float rs = rst[wr * 64 + fr + ai * 128 + m * 16];
                    if (pn == 24) { if (wc == 0) { *(f32x4*)(GATES + (size_t)row * 32 + 8 * fq) = acc[ai][0][m][0] * rs; *(f32x4*)(GATES + (size_t)row * 32 + 8 * fq + 4) = acc[ai][0][m][1] * rs; } continue; }
#pragma unroll
                    for (int bj = 0; bj < 2; ++bj) { f32x4 v0 = acc[ai][bj][m][0] * rs, v1 = acc[ai][bj][m][1] * rs;
                        if (act == 1) { for (int i = 0; i < 4; ++i) { v0[i] = sigmoid_(v0[i]); v1[i] = sigmoid_(v1[i]); } }
                        else if (act == 2) { for (int i = 0; i < 4; ++i) { v0[i] = silu_(v0[i]); v1[i] = silu_(v1[i]); } }
                        u32x4 w; w.x = pk2(v0[0], v0[1]); w.y = pk2(v0[2], v0[3]); w.z = pk2(v1[0], v1[1]); w.w = pk2(v1[2], v1[3]);
                        *(u32x4*)(dst + (size_t)row * ld + cb + bj * 128 + wc * 32 + 8 * fq) = w; } }
        } else {
            const int vrow0 = u.pm * 256 + wr * 64 + fr;
            float rs[2][8];
#pragma unroll
            for (int bj = 0; bj < 2; ++bj)
#pragma unroll
                for (int j = 0; j < 8; ++j) rs[bj][j] = rst[bj * 128 + wc * 32 + 8 * fq + j];
#pragma unroll
            for (int ai = 0; ai < 2; ++ai)
#pragma unroll
                for (int m = 0; m < 4; ++m) { const int vr = vrow0 + ai * 128 + m * 16;
#pragma unroll
                    for (int bj = 0; bj < 2; ++bj) { const f32x4 a0 = acc[ai][bj][m][0], a1 = acc[ai][bj][m][1]; u32x4 w;
                        w.x = pk2(a0[0] * rs[bj][0], a0[1] * rs[bj][1]); w.y = pk2(a0[2] * rs[bj][2], a0[3] * rs[bj][3]); w.z = pk2(a1[0] * rs[bj][4], a1[1] * rs[bj][5]); w.w = pk2(a1[2] * rs[bj][6], a1[3] * rs[bj][7]);
                        *(u32x4*)(VT + (size_t)vr * T + u.pn * 256 + bj * 128 + wc * 32 + 8 * fq) = w; } }
        }
    }
};
struct EpiQK { static constexpr bool NEEDS_RS = false; bf16_t *Q, *K, *KT;
    __device__ __forceinline__ void operator()(EPI_ARGS) const {
        const int row0 = u.pm * 256 + wr * 64 + fr;
#pragma unroll
        for (int ai = 0; ai < 2; ++ai)
#pragma unroll
            for (int m = 0; m < 4; ++m) { const int row = row0 + ai * 128 + m * 16;
#pragma unroll
                for (int bj = 0; bj < 2; ++bj) { const f32x4 v0 = acc[ai][bj][m][0], v1 = acc[ai][bj][m][1]; const int cc = bj * 128 + wc * 32 + 8 * fq;
                    u32x4 w; w.x = pk2(v0[0], v0[1]); w.y = pk2(v0[2], v0[3]); w.z = pk2(v1[0], v1[1]); w.w = pk2(v1[2], v1[3]);
                    if (u.seg == 0) *(u32x4*)((u.pn == 0 ? Q : K) + (size_t)row * D + u.z * 256 + cc) = w;
                    else *(u32x4*)(KT + (size_t)(u.z * 256 + row) * T + u.pn * 256 + cc) = w; } }
    }
};
template <int MODE> struct EpiMerge { static constexpr bool NEEDS_RS = false; const bf16_t* G; float* YT; bf16_t* Y;
    __device__ __forceinline__ void operator()(EPI_ARGS) const {
        const int row0 = u.pm * 256 + wr * 64 + fr;
#pragma unroll
        for (int ai = 0; ai < 2; ++ai)
#pragma unroll
            for (int m = 0; m < 4; ++m) { const int row = row0 + ai * 128 + m * 16;
#pragma unroll
                for (int bj = 0; bj < 2; ++bj) { const size_t off = (size_t)row * D + u.pn * 256 + bj * 128 + wc * 32 + 8 * fq;
                    const u32x4 gw = *(const u32x4*)(G + off);
                    f32x4 g0 = {bflo(gw.x), bfhi(gw.x), bflo(gw.y), bfhi(gw.y)}, g1 = {bflo(gw.z), bfhi(gw.z), bflo(gw.w), bfhi(gw.w)};
                    f32x4 y0 = g0 * acc[ai][bj][m][0], y1 = g1 * acc[ai][bj][m][1];
                    if (MODE == 0) { *(f32x4*)(YT + off) = y0; *(f32x4*)(YT + off + 4) = y1; }
                    else { y0 += *(const f32x4*)(YT + off); y1 += *(const f32x4*)(YT + off + 4);
                        u32x4 w; w.x = pk2(y0[0], y0[1]); w.y = pk2(y0[2], y0[3]); w.z = pk2(y1[0], y1[1]); w.w = pk2(y1[2], y1[3]); *(u32x4*)(Y + off) = w; } } }
    }
};
constexpr size_t SC_STRIDE = (size_t)NH * T;
__device__ __forceinline__ void p4_conv(const P& p, size_t gtid, size_t gsz) {
    const bf16_t* U = DOP(const bf16_t, DO_U); bf16_t* CH = DOP(bf16_t, DO_CH);
    const float* cw = p.in[12]; const float* cb = p.in[13]; const float* stc = p.in[2];
    const int c8 = (int)(gtid & 127) * 8; const int rstep = (int)(gsz >> 7);
    float wt[4][8], bs[8];
#pragma unroll
    for (int j = 0; j < 4; ++j) { const f32x4 w0 = *(const f32x4*)(cw + j * D + c8), w1 = *(const f32x4*)(cw + j * D + c8 + 4); wt[j][0] = w0[0]; wt[j][1] = w0[1]; wt[j][2] = w0[2]; wt[j][3] = w0[3]; wt[j][4] = w1[0]; wt[j][5] = w1[1]; wt[j][6] = w1[2]; wt[j][7] = w1[3]; }
    { const f32x4 b0 = *(const f32x4*)(cb + c8), b1 = *(const f32x4*)(cb + c8 + 4); bs[0] = b0[0]; bs[1] = b0[1]; bs[2] = b0[2]; bs[3] = b0[3]; bs[4] = b1[0]; bs[5] = b1[1]; bs[6] = b1[2]; bs[7] = b1[3]; }
#pragma unroll 2
    for (int row = (int)(gtid >> 7); row < T; row += rstep) {
        int t, Tl, seq; if (row < T_P) { t = row & (SEQ - 1); Tl = SEQ; seq = row >> 11; } else { t = (row - T_P) & 7; Tl = DEC_T; seq = (row - T_P) >> 3; }
        float a[8];
#pragma unroll
        for (int i = 0; i < 8; ++i) a[i] = bs[i];
        u32x4 ucur = {0u, 0u, 0u, 0u};
#pragma unroll
        for (int j = 0; j < 4; ++j) { const int tt = t - 3 + j; float uv[8];
            if (tt >= 0) { const u32x4 w = *(const u32x4*)(U + (size_t)(row - 3 + j) * D + c8); if (j == 3) ucur = w;
                uv[0] = bflo(w.x); uv[1] = bfhi(w.x); uv[2] = bflo(w.y); uv[3] = bfhi(w.y); uv[4] = bflo(w.z); uv[5] = bfhi(w.z); uv[6] = bflo(w.w); uv[7] = bfhi(w.w); }
            else if (row >= T_P) { const float* s = stc + ((size_t)seq * 3 + (3 + tt)) * D + c8; const f32x4 s0 = *(const f32x4*)s, s1 = *(const f32x4*)(s + 4);
                uv[0] = s0[0]; uv[1] = s0[1]; uv[2] = s0[2]; uv[3] = s0[3]; uv[4] = s1[0]; uv[5] = s1[1]; uv[6] = s1[2]; uv[7] = s1[3]; }
            else {
#pragma unroll
                for (int i = 0; i < 8; ++i) uv[i] = 0.f; }
#pragma unroll
            for (int i = 0; i < 8; ++i) a[i] += uv[i] * wt[j][i]; }
        u32x4 o; o.x = pk2(silu_(a[0]), silu_(a[1])); o.y = pk2(silu_(a[2]), silu_(a[3])); o.z = pk2(silu_(a[4]), silu_(a[5])); o.w = pk2(silu_(a[6]), silu_(a[7]));
        *(u32x4*)(CH + (size_t)row * D + c8) = o;
        if (t >= Tl - 3) { float* co = (row < T_P ? p.out + O_CONVP : p.out + O_CONVS) + ((size_t)seq * 3 + (t - (Tl - 3))) * D + c8;
            *(f32x4*)co = (f32x4){bflo(ucur.x), bfhi(ucur.x), bflo(ucur.y), bfhi(ucur.y)}; *(f32x4*)(co + 4) = (f32x4){bflo(ucur.z), bfhi(ucur.z), bflo(ucur.w), bfhi(ucur.w)}; }
    }
}
__device__ __forceinline__ void p4_gates(const P& p, LAS unsigned char* lds, int bid, int tid) {
    const float* GATES = WSP(const float, M_GATES); float* SC = WSP(float, M_SC); const float* bif = p.in[16];
    const int lane = tid & 63, w = __builtin_amdgcn_readfirstlane(tid >> 6);
    if (bid < 32) {
        const int b = bid >> 2, h = bid & 3; LAS float* sum = (LAS float*)lds; LAS float* mp = sum + 64;
        const float bi = bif[h], bfg = bif[NH + h]; float a[4], bb[4], cm[4];
#pragma unroll
        for (int j = 0; j < 4; ++j) { const int c = 4 * w + j, row = b * SEQ + c * 64 + lane;
            const float gi = GATES[(size_t)row * 32 + h] + bi, gf = GATES[(size_t)row * 32 + NH + h] + bfg;
            float x = logsigmoid_(gf);
#pragma unroll
            for (int o = 1; o < 64; o <<= 1) { const float y = __shfl_up(x, o, 64); if (lane >= o) x += y; }
            float m = gi - x; a[j] = m;
#pragma unroll
            for (int o = 1; o < 64; o <<= 1) { const float y = __shfl_up(m, o, 64); if (lane >= o) m = fmaxf(m, y); }
            bb[j] = x; cm[j] = m; if (lane == 63) { sum[2 * c] = x; sum[2 * c + 1] = m; } }
        __syncthreads();
        if (tid == 0) { float m = 0.f; for (int c = 0; c < 32; ++c) { mp[c] = m; m = sum[2 * c] + fmaxf(m, sum[2 * c + 1]); } p.out[O_MP + (size_t)b * NH + h] = m; }
        __syncthreads();
#pragma unroll
        for (int j = 0; j < 4; ++j) { const int c = 4 * w + j, row = b * SEQ + c * 64 + lane; const float mprev = mp[c];
            const float Mt = fmaxf(mprev, cm[j]), mt = bb[j] + Mt, ML = __shfl(Mt, 63, 64); const size_t o = (size_t)h * T + row;
            SC[o] = a[j]; SC[SC_STRIDE + o] = Mt; SC[2 * SC_STRIDE + o] = expf(mprev - Mt); SC[3 * SC_STRIDE + o] = expf(a[j] - ML); SC[4 * SC_STRIDE + o] = expf(-mt); }
        __syncthreads();
    } else if (bid < 40) {
        const int job = (bid - 32) * 8 + w, h = job & 3, li = lane & 7, seq = (job >> 2) * 8 + (lane >> 3), row = T_P + seq * 8 + li;
        const float mprev = p.in[5][seq * NH + h];
        const float gi = GATES[(size_t)row * 32 + h] + bif[h], gf = GATES[(size_t)row * 32 + NH + h] + bif[NH + h];
        float b = logsigmoid_(gf);
#pragma unroll
        for (int o = 1; o < 8; o <<= 1) { const float x = __shfl_up(b, o, 8); if (li >= o) b += x; }
        const float a = gi - b; float cm = a;
#pragma unroll
        for (int o = 1; o < 8; o <<= 1) { const float x = __shfl_up(cm, o, 8); if (li >= o) cm = fmaxf(cm, x); }
        const float Mt = fmaxf(mprev, cm), mt = b + Mt, ML = __shfl(Mt, 7, 8), bL = __shfl(b, 7, 8); const size_t o = (size_t)h * T + row;
        SC[o] = a; SC[SC_STRIDE + o] = Mt; SC[2 * SC_STRIDE + o] = expf(mprev - Mt); SC[3 * SC_STRIDE + o] = expf(a - ML); SC[4 * SC_STRIDE + o] = expf(-mt);
        if (li == 7) p.out[O_MS + (size_t)seq * NH + h] = bL + ML;
    }
}
__device__ __forceinline__ void p4_gla(const P& p, int bid, int G, int tid) {
    const float* GATES = WSP(const float, M_GATES); const bf16_t* QG = DOP(const bf16_t, DO_QG); const bf16_t* KG = DOP(const bf16_t, DO_KG);
    bf16_t* QT = WSP(bf16_t, A_QT); bf16_t* KTn = WSP(bf16_t, G_KT); bf16_t* KTT = WSP(bf16_t, G_KTT); float* EAL = WSP(float, M_EAL);
    const int c = tid;
    float w2[16];
#pragma unroll
    for (int r = 0; r < 16; ++r) w2[r] = p.in[18][r * GKW + c];
    const float ba = p.in[19][c];
    for (int g = G - 1 - bid; g < NGRP; g += G) {
        const bool smp = g >= NCH_P; float A = 0.f;
        for (int t8 = 0; t8 < 8; ++t8) {
            unsigned kp[4] = {0u, 0u, 0u, 0u}; float eA = 1.f;
            if (smp) A = 0.f;
#pragma unroll
            for (int j = 0; j < 8; ++j) {
                const int row = g * 64 + t8 * 8 + j;
                const f32x4* ag = (const f32x4*)(GATES + (size_t)row * 32 + 8); float s = ba;
#pragma unroll
                for (int r4 = 0; r4 < 4; ++r4) { const f32x4 a4 = ag[r4]; s += a4[0] * w2[4 * r4] + a4[1] * w2[4 * r4 + 1] + a4[2] * w2[4 * r4 + 2] + a4[3] * w2[4 * r4 + 3]; }
                A += (fminf(s, 0.f) - __logf(1.f + __expf(-fabsf(s)))) * 0.0625f;
                const float q = bf2f(QG[(size_t)row * GKW + c]), k = bf2f(KG[(size_t)row * GKW + c]);
                eA = __expf(A); const float kt = k * __expf(-A);
                QT[(size_t)row * GKW + c] = (bf16_t)f2bf(q * 0.08838834764831845f * eA);
                const unsigned kb = f2bf(kt); KTn[(size_t)row * GKW + c] = (bf16_t)kb;
                if (j & 1) kp[j >> 1] |= kb << 16; else kp[j >> 1] = kb;
            }
            { u32x4 w = {kp[0], kp[1], kp[2], kp[3]}; *(u32x4*)(KTT + (size_t)c * T + g * 64 + t8 * 8) = w; }
            if (smp) EAL[(size_t)(256 + (g - NCH_P) * 8 + t8) * GKW + c] = eA;
            else if (t8 == 7) EAL[(size_t)g * GKW + c] = eA;
        }
    }
}

#define MFMA16(a, b, c) __builtin_amdgcn_mfma_f32_16x16x32_bf16(a, b, c, 0, 0, 0)
#define LBAR() do { asm volatile("s_waitcnt lgkmcnt(0)" ::: "memory"); __builtin_amdgcn_s_barrier(); asm volatile("" ::: "memory"); } while (0)
template <bool ML>
__device__ __forceinline__ void scan_prompt(const P& p, LAS unsigned char* lds, int b, int h, int es) {
    constexpr int DK = ML ? 256 : 128, ES = ML ? 64 : 128, NE = ML ? 80 : 128, NET = NE / 16, NDT = DK / 128  , KS = DK / 32;
    constexpr int QS = DK * 2 + 16, VS = 144;
    constexpr int OFF_Q = 0, OFF_K = OFF_Q + 64 * QS, OFF_V = OFF_K + 64 * QS, OFF_S = OFF_V + NE * VS, OFF_C = OFF_S + 64 * VS, OFF_SC = OFF_C + NE * QS;
    static_assert(OFF_SC + 1280 <= 140 * 1024, "scan LDS");
    constexpr int NT = NET * 4, TPW = (NT + 7) / 8;
    constexpr int QPT = 64 * (DK / 8) / NTHR, VPT = ES * 8 / NTHR;
    int tid_ = threadIdx.x; asm volatile("" : "+v"(tid_));
    const int tid = tid_, w = __builtin_amdgcn_readfirstlane(tid >> 6), lane = tid & 63, fr = lane & 15, fq = lane >> 4;
    const size_t row0 = (size_t)b * SEQ;
    const bf16_t* Qg = ML ? WSP(const bf16_t, A_Q) + row0 * D + h * 256 : WSP(const bf16_t, A_QT) + row0 * GKW + h * 128;
    const bf16_t* Kg = ML ? WSP(const bf16_t, A_K) + row0 * D + h * 256 : WSP(const bf16_t, G_KT) + row0 * GKW + h * 128;
    constexpr int LDQ = ML ? D : GKW;
    const bf16_t* VTg = WSP(const bf16_t, WS_VT) + (size_t)((ML ? 0 : 1024) + h * 256 + es * ES) * T + row0;
    const bf16_t* KTg = (ML ? WSP(const bf16_t, WS_KT) + (size_t)(h * 256) * T : WSP(const bf16_t, G_KTT) + (size_t)(h * 128) * T) + row0;
    const float* SC = WSP(const float, M_SC) + (size_t)h * T + row0;
    const float* EALg = WSP(const float, M_EAL) + (size_t)(b * 32) * GKW + h * 128;
    bf16_t* OUT = ML ? WSP(bf16_t, WS_HN) : WSP(bf16_t, WS_XBF);
    LAS float* scal = (LAS float*)(lds + OFF_SC);
    for (int i = tid; i < NE * QS / 4; i += NTHR) ((LAS unsigned*)(lds + OFF_C))[i] = 0u;
    if (ML) for (int i = tid; i < 16 * VS / 4; i += NTHR) ((LAS unsigned*)(lds + OFF_V + ES * VS))[i] = (i < VS / 4) ? 0x3f803f80u : 0u;
    f32x4 accC[NDT][NET];
#pragma unroll
    for (int a = 0; a < NDT; ++a)
#pragma unroll
        for (int e = 0; e < NET; ++e) accC[a][e] = (f32x4){0.f, 0.f, 0.f, 0.f};
    u32x4 sq[QPT], sk[QPT], sv[VPT]; float ssc = 0.f;
#define STAGE_LOAD(c_) do { const size_t r0_ = (size_t)(c_) * 64; \
        _Pragma("unroll") for (int j = 0; j < QPT; ++j) { const int i = tid + NTHR * j, rr = i / (DK / 8), cc = i % (DK / 8); sq[j] = *(const u32x4*)(Qg + (r0_ + rr) * LDQ + cc * 8); sk[j] = *(const u32x4*)(Kg + (r0_ + rr) * LDQ + cc * 8); } \
        _Pragma("unroll") for (int j = 0; j < VPT; ++j) { const int i = tid + NTHR * j, rr = i >> 3, cc = i & 7; sv[j] = *(const u32x4*)(VTg + (size_t)rr * T + r0_ + cc * 8); } \
        if (ML) { if (tid < 320) ssc = SC[(size_t)((tid >> 6) == 3 ? 4 : ((tid >> 6) == 4 ? 3 : (tid >> 6))) * SC_STRIDE + r0_ + (tid & 63)]; } else if (tid < 128) ssc = EALg[(size_t)(c_) * GKW + tid]; } while (0)
#define STAGE_WRITE() do { \
        _Pragma("unroll") for (int j = 0; j < QPT; ++j) { const int i = tid + NTHR * j, rr = i / (DK / 8), cc = i % (DK / 8); *(LAS u32x4*)(lds + OFF_Q + rr * QS + cc * 16) = sq[j]; *(LAS u32x4*)(lds + OFF_K + rr * QS + cc * 16) = sk[j]; } \
        _Pragma("unroll") for (int j = 0; j < VPT; ++j) { const int i = tid + NTHR * j, rr = i >> 3, cc = i & 7; *(LAS u32x4*)(lds + OFF_V + rr * VS + cc * 16) = sv[j]; } \
        if (tid < (ML ? 320 : 128)) scal[tid] = ssc; } while (0)
    STAGE_LOAD(0); STAGE_WRITE(); LBAR();
    for (int c = 0; c < 32; ++c) {
        const size_t r0 = (size_t)c * 64;
        if (c + 1 < 32) STAGE_LOAD(c + 1);
        bf16x8 kt[NDT][2];
#pragma unroll
        for (int a = 0; a < NDT; ++a)
#pragma unroll
            for (int ks = 0; ks < 2; ++ks) kt[a][ks] = *(const bf16x8*)(KTg + (size_t)(16 * (NDT * w + a) + fr) * T + r0 + ks * 32 + 8 * fq);
        const int st = w & 3, tt0 = 2 * (w >> 2);
        f32x4 accS[2] = {(f32x4){0.f, 0.f, 0.f, 0.f}, (f32x4){0.f, 0.f, 0.f, 0.f}};
#pragma unroll
        for (int ks = 0; ks < KS; ++ks) { const bf16x8 af = *(const LAS bf16x8*)(lds + OFF_K + (16 * st + fr) * QS + ks * 64 + fq * 16);
#pragma unroll
            for (int j = 0; j < 2; ++j) { const bf16x8 bfr = *(const LAS bf16x8*)(lds + OFF_Q + (16 * (tt0 + j) + fr) * QS + ks * 64 + fq * 16); accS[j] = MFMA16(af, bfr, accS[j]); } }
#pragma unroll
        for (int j = 0; j < 2; ++j) { const int t = 16 * (tt0 + j) + fr, s0 = 16 * st + 4 * fq; float v[4];
#pragma unroll
            for (int r = 0; r < 4; ++r) { const int s = s0 + r; float x = accS[j][r]; if (ML) x *= __expf(scal[s] - scal[64 + t]); v[r] = (s <= t) ? x : 0.f; }
            u32x2 wv; wv.x = pk2(v[0], v[1]); wv.y = pk2(v[2], v[3]); *(LAS u32x2*)(lds + OFF_S + t * VS + s0 * 2) = wv; }
        f32x4 accO[TPW];
#pragma unroll
        for (int j = 0; j < TPW; ++j) { accO[j] = (f32x4){0.f, 0.f, 0.f, 0.f}; const int id = w + 8 * j;
            if (id < NT) { const int et = id >> 2, tt = id & 3;
#pragma unroll
                for (int ks = 0; ks < KS; ++ks) { const bf16x8 af = *(const LAS bf16x8*)(lds + OFF_C + (16 * et + fr) * QS + ks * 64 + fq * 16), bfr = *(const LAS bf16x8*)(lds + OFF_Q + (16 * tt + fr) * QS + ks * 64 + fq * 16);
                    accO[j] = MFMA16(af, bfr, accO[j]); } } }
        LBAR();
#pragma unroll
        for (int j = 0; j < TPW; ++j) { const int id = w + 8 * j;
            if (id < NT) { const int et = id >> 2, tt = id & 3, t = 16 * tt + fr;
                if (ML) accO[j] = accO[j] * scal[128 + t];
#pragma unroll
                for (int ks = 0; ks < 2; ++ks) { const bf16x8 af = *(const LAS bf16x8*)(lds + OFF_V + (16 * et + fr) * VS + ks * 64 + fq * 16), bfr = *(const LAS bf16x8*)(lds + OFF_S + t * VS + ks * 64 + fq * 16);
                    accO[j] = MFMA16(af, bfr, accO[j]); }
                const size_t grow = row0 + r0 + t;
                if (!ML || et < 4) { u32x2 wv; wv.x = pk2(accO[j][0], accO[j][1]); wv.y = pk2(accO[j][2], accO[j][3]); *(u32x2*)(OUT + grow * D + h * 256 + es * ES + 16 * et + 4 * fq) = wv; }
                else if (es == 0 && fq == 0) WSP(float, M_DEN)[grow * 4 + h] = fmaxf(fabsf(accO[j][0]), scal[192 + t]); } }
        if (ML) { const float dec = scal[128 + 63];
#pragma unroll
            for (int a = 0; a < NDT; ++a)
#pragma unroll
                for (int e = 0; e < NET; ++e) accC[a][e] = accC[a][e] * dec;
#pragma unroll
            for (int ks = 0; ks < 2; ++ks) { const f32x4 w0 = *(const LAS f32x4*)(scal + 256 + ks * 32 + 8 * fq), w1 = *(const LAS f32x4*)(scal + 256 + ks * 32 + 8 * fq + 4);
#pragma unroll
                for (int a = 0; a < NDT; ++a) { const u32x4 kw = __builtin_bit_cast(u32x4, kt[a][ks]); u32x4 o;
                    o.x = pk2(bflo(kw.x) * w0[0], bfhi(kw.x) * w0[1]); o.y = pk2(bflo(kw.y) * w0[2], bfhi(kw.y) * w0[3]); o.z = pk2(bflo(kw.z) * w1[0], bfhi(kw.z) * w1[1]); o.w = pk2(bflo(kw.w) * w1[2], bfhi(kw.w) * w1[3]);
                    kt[a][ks] = __builtin_bit_cast(bf16x8, o); } } }
#pragma unroll
        for (int ks = 0; ks < 2; ++ks)
#pragma unroll
            for (int e = 0; e < NET; ++e) { const bf16x8 bfr = *(const LAS bf16x8*)(lds + OFF_V + (16 * e + fr) * VS + ks * 64 + fq * 16);
#pragma unroll
                for (int a = 0; a < NDT; ++a) accC[a][e] = MFMA16(kt[a][ks], bfr, accC[a][e]); }
        if (!ML) {
#pragma unroll
            for (int a = 0; a < NDT; ++a) { const f32x4 ea = *(const LAS f32x4*)(scal + 16 * (NDT * w + a) + 4 * fq);
#pragma unroll
                for (int e = 0; e < NET; ++e) accC[a][e] = accC[a][e] * ea; } }
        LBAR();
#pragma unroll
        for (int a = 0; a < NDT; ++a)
#pragma unroll
            for (int e = 0; e < NET; ++e) { u32x2 wv; wv.x = pk2(accC[a][e][0], accC[a][e][1]); wv.y = pk2(accC[a][e][2], accC[a][e][3]);
                *(LAS u32x2*)(lds + OFF_C + (16 * e + fr) * QS + (16 * (NDT * w + a) + 4 * fq) * 2) = wv; }
        if (c + 1 < 32) STAGE_WRITE();
        LBAR();
    }
    if (ML) { float* Cp = p.out + O_CP + (size_t)(b * NH + h) * HD * HD; float* np = p.out + O_NP + (size_t)(b * NH + h) * HD;
#pragma unroll
        for (int a = 0; a < NDT; ++a) { const int d = 16 * (NDT * w + a) + 4 * fq;
#pragma unroll
            for (int e = 0; e < 4; ++e) *(f32x4*)(Cp + (size_t)(es * 64 + 16 * e + fr) * HD + d) = accC[a][e];
            if (es == 0 && fr == 0) *(f32x4*)(np + d) = accC[a][NET - 1]; }
    } else { float* Sp = p.out + O_SP + (size_t)(b * NH + h) * GDK * GDV;
#pragma unroll
        for (int a = 0; a < NDT; ++a)
#pragma unroll
            for (int e = 0; e < NET; ++e)
#pragma unroll
                for (int r = 0; r < 4; ++r) Sp[(size_t)(16 * (NDT * w + a) + 4 * fq + r) * GDV + es * 128 + 16 * e + fr] = accC[a][e][r]; }
#undef STAGE_LOAD
#undef STAGE_WRITE
    LBAR();
}
#define SBAR() __syncthreads()
__device__ __forceinline__ void sample_ml(const P& p, LAS unsigned char* lds, int seq, int h) {
    LAS float* qf = (LAS float*)lds; LAS float* kf = qf + 2048; LAS float* vf = kf + 2048; LAS float* n0s = vf + 2048; LAS float* sS = n0s + 256; LAS float* sc = sS + 64; LAS float* qn = sc + 40; LAS float* part = (LAS float*)(lds + 32768);
    int tid_ = threadIdx.x; asm volatile("" : "+v"(tid_));
    const int tid = tid_, w = __builtin_amdgcn_readfirstlane(tid >> 6), lane = tid & 63, fr = lane & 15, fq = lane >> 4;
    const size_t R0 = (size_t)T_P + (size_t)seq * 8, sh = (size_t)seq * NH + h;
    { const int t = tid >> 6, d4 = (tid & 63) * 4;
      const u32x2 qw = *(const u32x2*)(WSP(const bf16_t, A_Q) + (R0 + t) * D + h * 256 + d4), kw = *(const u32x2*)(WSP(const bf16_t, A_K) + (R0 + t) * D + h * 256 + d4);
      *(LAS f32x4*)(qf + t * 256 + d4) = (f32x4){bflo(qw.x), bfhi(qw.x), bflo(qw.y), bfhi(qw.y)}; *(LAS f32x4*)(kf + t * 256 + d4) = (f32x4){bflo(kw.x), bfhi(kw.x), bflo(kw.y), bfhi(kw.y)}; }
    if (tid < 256) { const u32x4 vw = *(const u32x4*)(WSP(const bf16_t, WS_VT) + (size_t)(h * 256 + tid) * T + R0);
        vf[0 * 256 + tid] = bflo(vw.x); vf[1 * 256 + tid] = bfhi(vw.x); vf[2 * 256 + tid] = bflo(vw.y); vf[3 * 256 + tid] = bfhi(vw.y); vf[4 * 256 + tid] = bflo(vw.z); vf[5 * 256 + tid] = bfhi(vw.z); vf[6 * 256 + tid] = bflo(vw.w); vf[7 * 256 + tid] = bfhi(vw.w);
        n0s[tid] = p.in[4][sh * HD + tid]; }
    if (tid < 40) sc[tid] = WSP(const float, M_SC)[(size_t)(tid >> 3) * SC_STRIDE + (size_t)h * T + R0 + (tid & 7)];
    SBAR();
    if (tid < 64) { const int t = tid >> 3, s = tid & 7; float dot = 0.f;
        for (int d = 0; d < 256; ++d) dot += qf[t * 256 + d] * kf[s * 256 + d];
        sS[tid] = (s <= t) ? dot * expf(sc[s] - sc[8 + t]) : 0.f; }
    else if (tid < 72) { const int t = tid - 64; float dot = 0.f; for (int d = 0; d < 256; ++d) dot += qf[t * 256 + d] * n0s[d]; qn[t] = dot; }
    SBAR();
    if (tid < 8) { float den = sc[16 + tid] * qn[tid]; for (int s = 0; s < 8; ++s) den += sS[tid * 8 + s]; WSP(float, M_DEN)[(R0 + tid) * 4 + h] = fmaxf(fabsf(den), sc[32 + tid]); }
    const int d0 = 32 * w + 8 * fq; const float dec = sc[16 + 7];
    float kr[8][8];
#pragma unroll
    for (int s = 0; s < 8; ++s) { const f32x4 k0 = *(const LAS f32x4*)(kf + s * 256 + d0), k1 = *(const LAS f32x4*)(kf + s * 256 + d0 + 4); const float ws_ = sc[24 + s];
        kr[s][0] = k0[0] * ws_; kr[s][1] = k0[1] * ws_; kr[s][2] = k0[2] * ws_; kr[s][3] = k0[3] * ws_; kr[s][4] = k1[0] * ws_; kr[s][5] = k1[1] * ws_; kr[s][6] = k1[2] * ws_; kr[s][7] = k1[3] * ws_; }
    bf16x8 qfrag; { u32x4 o = {0u, 0u, 0u, 0u}; if (fr < 8) { const f32x4 q0 = *(const LAS f32x4*)(qf + fr * 256 + d0), q1 = *(const LAS f32x4*)(qf + fr * 256 + d0 + 4);
        o.x = pk2(q0[0], q0[1]); o.y = pk2(q0[2], q0[3]); o.z = pk2(q1[0], q1[1]); o.w = pk2(q1[2], q1[3]); } qfrag = __builtin_bit_cast(bf16x8, o); }
    if (fr == 0) { float nn[8];
#pragma unroll
        for (int j = 0; j < 8; ++j) { float a = dec * n0s[d0 + j];
#pragma unroll
            for (int s = 0; s < 8; ++s) a += kr[s][j]; nn[j] = a; }
        float* no = p.out + O_NS + sh * HD + d0; *(f32x4*)no = (f32x4){nn[0], nn[1], nn[2], nn[3]}; *(f32x4*)(no + 4) = (f32x4){nn[4], nn[5], nn[6], nn[7]}; }
    const float* C0 = p.in[3] + sh * HD * HD; float* Cn = p.out + O_CS + sh * HD * HD;
#pragma unroll 4
    for (int strip = 0; strip < 16; ++strip) { const int e = 16 * strip + fr;
        const f32x4 c0 = *(const f32x4*)(C0 + (size_t)e * HD + d0), c1 = *(const f32x4*)(C0 + (size_t)e * HD + d0 + 4);
        float cn[8] = {c0[0] * dec, c0[1] * dec, c0[2] * dec, c0[3] * dec, c1[0] * dec, c1[1] * dec, c1[2] * dec, c1[3] * dec};
#pragma unroll
        for (int s = 0; s < 8; ++s) { const float vv = vf[s * 256 + e];
#pragma unroll
            for (int j = 0; j < 8; ++j) cn[j] += vv * kr[s][j]; }
        *(f32x4*)(Cn + (size_t)e * HD + d0) = (f32x4){cn[0], cn[1], cn[2], cn[3]}; *(f32x4*)(Cn + (size_t)e * HD + d0 + 4) = (f32x4){cn[4], cn[5], cn[6], cn[7]};
        u32x4 o; o.x = pk2(c0[0], c0[1]); o.y = pk2(c0[2], c0[3]); o.z = pk2(c1[0], c1[1]); o.w = pk2(c1[2], c1[3]);
        const f32x4 acc = MFMA16(__builtin_bit_cast(bf16x8, o), qfrag, ((f32x4){0.f, 0.f, 0.f, 0.f}));
        if (fr < 8) {
#pragma unroll
            for (int r = 0; r < 4; ++r) part[(size_t)(w * 256 + 16 * strip + 4 * fq + r) * 8 + fr] = acc[r]; } }
    SBAR();
    { const int t = tid >> 6, e4 = (tid & 63) * 4; float o4[4];
#pragma unroll
      for (int i = 0; i < 4; ++i) { float qc = 0.f;
#pragma unroll
          for (int ww = 0; ww < 8; ++ww) qc += part[(size_t)(ww * 256 + e4 + i) * 8 + t];
          float a = sc[16 + t] * qc;
#pragma unroll
          for (int s = 0; s < 8; ++s) a += sS[t * 8 + s] * vf[s * 256 + e4 + i];
          o4[i] = a; }
      u32x2 wv; wv.x = pk2(o4[0], o4[1]); wv.y = pk2(o4[2], o4[3]); *(u32x2*)(WSP(bf16_t, WS_HN) + (R0 + t) * D + h * 256 + e4) = wv; }
    SBAR();
}
__device__ __forceinline__ void sample_gla(const P& p, LAS unsigned char* lds, int seq, int h) {
    LAS float* qf = (LAS float*)lds; LAS float* kf = qf + 1024; LAS float* vf = kf + 1024; LAS float* eal = vf + 2048; LAS float* att = eal + 128; LAS float* part = (LAS float*)(lds + 32768);
    int tid_ = threadIdx.x; asm volatile("" : "+v"(tid_));
    const int tid = tid_, w = __builtin_amdgcn_readfirstlane(tid >> 6), lane = tid & 63;
    const size_t R0 = (size_t)T_P + (size_t)seq * 8, sh = (size_t)seq * NH + h;
    { const int t = tid >> 6, d2 = (tid & 63) * 2;
      const unsigned qw = *(const unsigned*)(WSP(const bf16_t, A_QT) + (R0 + t) * GKW + h * 128 + d2), kw = *(const unsigned*)(WSP(const bf16_t, G_KT) + (R0 + t) * GKW + h * 128 + d2);
      qf[t * 128 + d2] = bflo(qw); qf[t * 128 + d2 + 1] = bfhi(qw); kf[t * 128 + d2] = bflo(kw); kf[t * 128 + d2 + 1] = bfhi(kw); }
    if (tid < 256) { const u32x4 vw = *(const u32x4*)(WSP(const bf16_t, WS_VT) + (size_t)(1024 + h * 256 + tid) * T + R0);
        vf[0 * 256 + tid] = bflo(vw.x); vf[1 * 256 + tid] = bfhi(vw.x); vf[2 * 256 + tid] = bflo(vw.y); vf[3 * 256 + tid] = bfhi(vw.y); vf[4 * 256 + tid] = bflo(vw.z); vf[5 * 256 + tid] = bfhi(vw.z); vf[6 * 256 + tid] = bflo(vw.w); vf[7 * 256 + tid] = bfhi(vw.w); }
    else if (tid < 384) eal[tid - 256] = WSP(const float, M_EAL)[(size_t)(256 + seq) * GKW + h * 128 + (tid - 256)];
    SBAR();
    if (tid < 64) { const int t = tid >> 3, s = tid & 7; float dot = 0.f; for (int d = 0; d < 128; ++d) dot += qf[t * 128 + d] * kf[s * 128 + d]; att[tid] = (s <= t) ? dot : 0.f; }
    const int e4 = 4 * lane;
    f32x4 vr[8], ai[8];
#pragma unroll
    for (int s = 0; s < 8; ++s) { vr[s] = *(const LAS f32x4*)(vf + s * 256 + e4); ai[s] = (f32x4){0.f, 0.f, 0.f, 0.f}; }
    const float* S0 = p.in[6] + sh * GDK * GDV; float* Sn = p.out + O_SS + sh * GDK * GDV;
#pragma unroll 4
    for (int dd = 0; dd < 16; ++dd) { const int d = 16 * w + dd;
        const f32x4 s0 = *(const f32x4*)(S0 + (size_t)d * GDV + e4); f32x4 up = s0;
#pragma unroll
        for (int s = 0; s < 8; ++s) { up += vr[s] * kf[s * 128 + d]; ai[s] += s0 * qf[s * 128 + d]; }
        *(f32x4*)(Sn + (size_t)d * GDV + e4) = up * eal[d]; }
#pragma unroll
    for (int t = 0; t < 8; ++t) *(LAS f32x4*)(part + (size_t)(w * 8 + t) * 256 + e4) = ai[t];
    SBAR();
    { const int t = tid >> 6; f32x4 o = {0.f, 0.f, 0.f, 0.f};
#pragma unroll
      for (int ww = 0; ww < 8; ++ww) o += *(const LAS f32x4*)(part + (size_t)(ww * 8 + t) * 256 + e4);
#pragma unroll
      for (int s = 0; s < 8; ++s) o += *(const LAS f32x4*)(vf + s * 256 + e4) * att[t * 8 + s];
      u32x2 wv; wv.x = pk2(o[0], o[1]); wv.y = pk2(o[2], o[3]); *(u32x2*)(WSP(bf16_t, WS_XBF) + (R0 + t) * D + h * 256 + e4) = wv; }
    SBAR();
}
#ifndef MK_SCAN_PARTS
#define MK_SCAN_PARTS 3
#endif
__device__ __forceinline__ void p5_scan(const P& p, LAS unsigned char* lds, int bid, int G, unsigned* counter, int parts) {
    if (parts & 1) for (int it = bid; it < 192; it += G) {
        if (it < 128) scan_prompt<true>(p, lds, it >> 4, (it >> 2) & 3, it & 3);
        else { const int i = it - 128; scan_prompt<false>(p, lds, i >> 3, (i >> 1) & 3, i & 1); }
    }
    LAS int* slot = (LAS int*)(lds + 140 * 1024);
    if (parts & 2) for (;;) {
        if (threadIdx.x == 0) *slot = (int)atomicAdd(counter, 1u);
        SBAR();
        const int it = *slot;
        SBAR();
        if (it >= 1024) break;
        if (it < 512) sample_ml(p, lds, it >> 2, it & 3); else sample_gla(p, lds, (it - 512) >> 2, it & 3);
    }
}
__device__ __forceinline__ void p5b_norm(const P& p, int gw, int NGW, int lane) {
    const bf16_t* HN = WSP(const bf16_t, WS_HN); const bf16_t* OG = WSP(const bf16_t, WS_XBF); const bf16_t* SIGO = WSP(const bf16_t, S_SIGO); const bf16_t* SILUR = WSP(const bf16_t, S_SILUR);
    bf16_t* HM = WSP(bf16_t, A_Q); bf16_t* OGN = WSP(bf16_t, A_K); const float* DEN = WSP(const float, M_DEN);
    const int h = lane >> 4, c0 = h * 256 + (lane & 15) * 16;
    float gm[16], gg[16];
#pragma unroll
    for (int i = 0; i < 16; ++i) { gm[i] = p.in[17][c0 + i]; gg[i] = p.in[20][c0 + i]; }
#pragma unroll 2
    for (int row = gw; row < T; row += NGW) {
#pragma unroll
        for (int br = 0; br < 2; ++br) {
            const bf16_t* src = (br == 0 ? HN : OG) + (size_t)row * D + c0; const bf16_t* gsrc = (br == 0 ? SIGO : SILUR) + (size_t)row * D + c0;
            const u32x4 a = *(const u32x4*)src, b = *(const u32x4*)(src + 8), ga = *(const u32x4*)gsrc, gb = *(const u32x4*)(gsrc + 8);
            float v[16] = {bflo(a.x), bfhi(a.x), bflo(a.y), bfhi(a.y), bflo(a.z), bfhi(a.z), bflo(a.w), bfhi(a.w), bflo(b.x), bfhi(b.x), bflo(b.y), bfhi(b.y), bflo(b.z), bfhi(b.z), bflo(b.w), bfhi(b.w)};
            float gt[16] = {bflo(ga.x), bfhi(ga.x), bflo(ga.y), bfhi(ga.y), bflo(ga.z), bfhi(ga.z), bflo(ga.w), bfhi(ga.w), bflo(gb.x), bfhi(gb.x), bflo(gb.y), bfhi(gb.y), bflo(gb.z), bfhi(gb.z), bflo(gb.w), bfhi(gb.w)};
            float ss = 0.f;
#pragma unroll
            for (int i = 0; i < 16; ++i) ss += v[i] * v[i];
            ss += __shfl_xor(ss, 1); ss += __shfl_xor(ss, 2); ss += __shfl_xor(ss, 4); ss += __shfl_xor(ss, 8);
            float extra = EPS; if (br == 0) { const float dn = DEN[(size_t)row * 4 + h]; extra = EPS * dn * dn; }
            const float sc = 1.f / sqrtf(ss * (1.f / 256.f) + extra);
            unsigned o[8];
#pragma unroll
            for (int i = 0; i < 8; ++i) { const float g0 = br == 0 ? gm[2 * i] : gg[2 * i], g1 = br == 0 ? gm[2 * i + 1] : gg[2 * i + 1]; o[i] = pk2(gt[2 * i] * g0 * v[2 * i] * sc, gt[2 * i + 1] * g1 * v[2 * i + 1] * sc); }
            bf16_t* dst = (br == 0 ? HM : OGN) + (size_t)row * D + c0;
            *(u32x4*)dst = (u32x4){o[0], o[1], o[2], o[3]}; *(u32x4*)(dst + 8) = (u32x4){o[4], o[5], o[6], o[7]};
        }
    }
}
__device__ __forceinline__ void p10_final(const P& p, int gw, int NGW, int lane) {
    const f32x4* g4 = (const f32x4*)p.in[27] + lane; f32x4 g[4];
#pragma unroll
    for (int j = 0; j < 4; ++j) g[j] = g4[64 * j];
#pragma unroll 2
    for (int row = gw; row < T; row += NGW) {
        f32x4* xr = (f32x4*)(p.out + (size_t)row * D) + lane; f32x4 v[4]; float s = 0.f;
#pragma unroll
        for (int j = 0; j < 4; ++j) { v[j] = xr[64 * j]; s += (v[j].x * v[j].x + v[j].y * v[j].y) + (v[j].z * v[j].z + v[j].w * v[j].w); }
        const float rs = 1.f / sqrtf(wave_sum(s) * (1.f / D) + EPS);
#pragma unroll
        for (int j = 0; j < 4; ++j) xr[64 * j] = v[j] * rs * g[j];
    }
}
constexpr int LDS_BYTES = 147456;
constexpr int CW_CNT = 64;
constexpr int CW_BAR = 1024;
constexpr int CTL_ZERO_BYTES = 32768;
#ifndef MK_PH_LO
#define MK_PH_LO 0
#endif
#ifndef MK_PH_HI
#define MK_PH_HI 99
#endif
#ifndef MK_REP
#define MK_REP 0
#endif
__global__ void __launch_bounds__(NTHR, 2) mk_fwd(P p) {
    cg::grid_group grid = cg::this_grid();
    extern __shared__ __attribute__((aligned(16))) unsigned char lds_raw[];
    LAS unsigned char* lds = (LAS unsigned char*)lds_raw;
    const int bid = blockIdx.x, G = gridDim.x, NGW = G * NWAVES; const size_t gsz = (size_t)G * NTHR;
    if (threadIdx.x < 4) ((LAS unsigned*)(lds + 140 * 1024 + 16))[threadIdx.x] = 0u;
    __syncthreads();
    const XcdBarrier xbar = xcd_barrier_post((unsigned*)(p.ws + WS_CTL) + CW_BAR, (volatile LAS unsigned*)(lds + 140 * 1024 + 16));
#define GRID_BAR() xcd_barrier(xbar)
#define TIDX() int tid = threadIdx.x; asm volatile("" : "+v"(tid)); const int lane = tid & 63, wave = __builtin_amdgcn_readfirstlane(tid >> 6), gw = bid * NWAVES + wave; const size_t gtid = (size_t)bid * NTHR + tid; (void)lane; (void)gw; (void)gtid
    float* SSQ = WSP(float, M_SSQ); float* XRES = p.out;
    bf16_t* XBF = WSP(bf16_t, WS_XBF); bf16_t* ACT = WSP(bf16_t, WS_ACT);
    constexpr int NM = T / 256;
#define PH(k) (MK_PH_LO <= (k) && (k) <= MK_PH_HI)
#define PHASE_BEGIN(k) _Pragma("nounroll") for (int rep_ = 0; rep_ <= ((MK_REP >> (k)) & 1); ++rep_) { if (rep_) GRID_BAR(); if (PH(k)) {
#define PHASE_END } }
    PHASE_BEGIN(0) TIDX(); p0_prologue(p, lds, gw, NGW, wave, lane); PHASE_END
    grid.sync();
    PHASE_BEGIN(1) pg8::Gemm g{XBF, WSP(bf16_t, W_UP1), nullptr, nullptr, D, D, D, 0, 0}; pg8::Sched S; S.init(NM, 2 * FF / 256, 1, 0, 0, 0, G, bid);
        EpiUp E{SSQ, ACT}; pg8::gemm_phase(lds, g, S, E); PHASE_END
    GRID_BAR();
    PHASE_BEGIN(2) pg8::Gemm g{ACT, WSP(bf16_t, W_DN1), nullptr, nullptr, FF, FF, FF, 0, 0}; pg8::Sched S; S.init(NM, D / 256, 1, 0, 0, 0, G, bid);
        EpiRes<true> E{p.in[0], p.in[1] - (size_t)T_P * D, XRES, XBF, SSQ, 0.5f}; pg8::gemm_phase(lds, g, S, E); PHASE_END
    GRID_BAR();
    PHASE_BEGIN(3) const bf16_t* Wi = WSP(bf16_t, W_IN); pg8::Gemm g{XBF, Wi, Wi + (size_t)6400 * D, XBF, D, D, D, 0, 0}; pg8::Sched S; S.init(NM, 25, 1, 8, NM, 1, G, bid);
        EpiIn E{SSQ, DOP(bf16_t, DO_U), WSP(bf16_t, S_SIGO), DOP(bf16_t, DO_QG), DOP(bf16_t, DO_KG), WSP(bf16_t, S_SILUR), WSP(bf16_t, S_SIGA), WSP(bf16_t, S_SIGB), WSP(bf16_t, WS_VT), WSP(float, M_GATES)};
        pg8::gemm_phase(lds, g, S, E); PHASE_END
    GRID_BAR();
    PHASE_BEGIN(4) TIDX(); p4_gates(p, lds, bid, tid); p4_gla(p, bid, G, tid); { const int ncb = G > 32 ? G - 16 : G; if (bid < ncb) p4_conv(p, gtid, (size_t)ncb * NTHR); } PHASE_END
    GRID_BAR();
    PHASE_BEGIN(5) const bf16_t* Wqk = WSP(bf16_t, W_QK); const bf16_t* CH = DOP(bf16_t, DO_CH); pg8::Gemm g{CH, Wqk, Wqk + (size_t)256 * D, CH, D, D, 256, 256, 256}; pg8::Sched S; S.init(NM, 2, 4, 1, NM, 4, G, bid);
        EpiQK E{WSP(bf16_t, A_Q), WSP(bf16_t, A_K), WSP(bf16_t, WS_KT)}; pg8::gemm_phase(lds, g, S, E); PHASE_END
    GRID_BAR();
    PHASE_BEGIN(6) p5_scan(p, lds, bid, G, (unsigned*)(p.ws + WS_CTL) + CW_CNT + rep_, rep_ ? MK_SCAN_PARTS : 3); PHASE_END
    GRID_BAR();
    PHASE_BEGIN(7) TIDX(); p5b_norm(p, gw, NGW, lane); PHASE_END
    GRID_BAR();
    PHASE_BEGIN(8) pg8::Sched S; S.init(NM, D / 256, 1, 0, 0, 0, G, bid); float* YT = WSP(float, WS_VT); bf16_t* Y = WSP(bf16_t, WS_KT);
        { pg8::Gemm g{WSP(bf16_t, A_Q), WSP(bf16_t, W_PA), nullptr, nullptr, D, D, D, 0, 0}; EpiMerge<0> E{WSP(bf16_t, S_SIGA), YT, Y}; pg8::gemm_phase(lds, g, S, E); }
        { pg8::Gemm g{WSP(bf16_t, A_K), WSP(bf16_t, W_PB), nullptr, nullptr, D, D, D, 0, 0}; EpiMerge<1> E{WSP(bf16_t, S_SIGB), YT, Y}; pg8::gemm_phase(lds, g, S, E); } PHASE_END
    GRID_BAR();
    PHASE_BEGIN(9) pg8::Gemm g{WSP(bf16_t, WS_KT), WSP(bf16_t, W_O), nullptr, nullptr, D, D, D, 0, 0}; pg8::Sched S; S.init(NM, D / 256, 1, 0, 0, 0, G, bid);
        EpiRes<true> E{XRES, XRES, XRES, XBF, SSQ, 1.0f}; pg8::gemm_phase(lds, g, S, E); PHASE_END
    GRID_BAR();
    PHASE_BEGIN(10) pg8::Gemm g{XBF, WSP(bf16_t, W_UP2), nullptr, nullptr, D, D, D, 0, 0}; pg8::Sched S; S.init(NM, 2 * FF / 256, 1, 0, 0, 0, G, bid);
        EpiUp E{SSQ, ACT}; pg8::gemm_phase(lds, g, S, E); PHASE_END
    GRID_BAR();
    PHASE_BEGIN(11) pg8::Gemm g{ACT, WSP(bf16_t, W_DN2), nullptr, nullptr, FF, FF, FF, 0, 0}; pg8::Sched S; S.init(NM, D / 256, 1, 0, 0, 0, G, bid);
        EpiRes<false> E{XRES, XRES, XRES, XBF, SSQ, 0.5f}; pg8::gemm_phase(lds, g, S, E); PHASE_END
    GRID_BAR();
#ifdef MK_EXTRA_SYNCS
    for (int i_ = 0; i_ < MK_EXTRA_SYNCS; ++i_) GRID_BAR();
#endif
    PHASE_BEGIN(12) TIDX(); p10_final(p, gw, NGW, lane); PHASE_END
#undef PH
#undef TIDX
#undef PHASE_BEGIN
#undef PHASE_END
#undef GRID_BAR
}
}

static int mk_launch(void* const* d_in, const int* in_sizes, int n_in, void* d_out, int out_size, void* d_ws, size_t ws_size, hipStream_t stream) {
    static int grid = 0;
    if (grid == 0) {
        if (n_in != 28 || (size_t)out_size != mk::O_END || ws_size < mk::WS_END) { fprintf(stderr, "kernel_launch: built for 28 inputs, %zu outputs, >= %zu bytes of workspace; got n_in %d, out %d, ws %zu; nothing launched\n", (size_t)mk::O_END, (size_t)mk::WS_END, n_in, out_size, ws_size); grid = -1; return -1; }
        int dev = 0, cus = 0, per_cu = 0;
        if (hipGetDevice(&dev) != hipSuccess || hipDeviceGetAttribute(&cus, hipDeviceAttributeMultiprocessorCount, dev) != hipSuccess) { grid = -1; return -1; }
        if (hipFuncSetAttribute((const void*)mk::mk_fwd, hipFuncAttributeMaxDynamicSharedMemorySize, mk::LDS_BYTES) != hipSuccess) { fprintf(stderr, "kernel_launch: hipFuncSetAttribute failed\n"); grid = -1; return -1; }
        if (hipOccupancyMaxActiveBlocksPerMultiprocessor(&per_cu, (const void*)mk::mk_fwd, mk::NTHR, mk::LDS_BYTES) != hipSuccess || per_cu < 1) { fprintf(stderr, "kernel_launch: occupancy query reports %d blocks per CU\n", per_cu); grid = -1; (void)hipGetLastError(); return -1; }
        grid = cus;
    }
    if (grid < 0) return -1;
    if (hipMemsetAsync((char*)d_ws + mk::WS_CTL, 0, mk::CTL_ZERO_BYTES, stream) != hipSuccess) return -1;
    mk::P prm{}; for (int i = 0; i < 28; ++i) prm.in[i] = (const float*)d_in[i]; prm.out = (float*)d_out; prm.ws = (unsigned char*)d_ws;
    void* args[] = {&prm};
    const hipError_t e = hipLaunchCooperativeKernel((const void*)mk::mk_fwd, dim3(grid), dim3(mk::NTHR), args, mk::LDS_BYTES, stream);
    if (e != hipSuccess) { fprintf(stderr, "cooperative launch failed: %s (grid %d)\n", hipGetErrorString(e), grid); return -1; }
    return 0;
}
extern "C" void kernel_launch(void* const* d_in, const int* in_sizes, int n_in, void* d_out, int out_size, void* d_ws, size_t ws_size, hipStream_t stream) {
    (void)mk_launch(d_in, in_sizes, n_in, d_out, out_size, d_ws, ws_size, stream);
}
```

```cpp
#include <hip/hip_runtime.h>
#include <cstdio>
#include <cstdint>
#include <hip/hip_cooperative_groups.h>
namespace cg = cooperative_groups;
namespace mk {
#define LAS __attribute__((address_space(3)))
#define GAS __attribute__((address_space(1)))
typedef unsigned short bf16_t;
typedef short bf16x8 __attribute__((ext_vector_type(8)));
typedef float f32x4 __attribute__((ext_vector_type(4)));
typedef float f32x2 __attribute__((ext_vector_type(2)));
typedef unsigned u32x4 __attribute__((ext_vector_type(4)));
typedef unsigned u32x2 __attribute__((ext_vector_type(2)));

constexpr int D = 1024, FF = 2816, T_P = 16384, T_S = 1024, T = T_P + T_S, SEQ = 2048, NB = 8, DEC_B = 128, DEC_T = 8;
constexpr int NH = 4, HD = 256, GDK = 128, GDV = 256, GKW = 512, INW = 8216;
constexpr int NWAVES = 8, NTHR = 512;
constexpr float EPS = 1e-6f;
constexpr int NCH_P = T_P / 64;
constexpr int NGRP = T / 64;

__device__ __forceinline__ unsigned f2bf(float f) { unsigned u = __builtin_bit_cast(unsigned, f); return (u + 0x7fffu + ((u >> 16) & 1u)) >> 16; }
__device__ __forceinline__ unsigned pk2(float lo, float hi) { return f2bf(lo) | (f2bf(hi) << 16); }
__device__ __forceinline__ float bf2f(unsigned short b) { return __builtin_bit_cast(float, (unsigned)b << 16); }
__device__ __forceinline__ float bflo(unsigned w) { return __builtin_bit_cast(float, w << 16); }
__device__ __forceinline__ float bfhi(unsigned w) { return __builtin_bit_cast(float, w & 0xffff0000u); }
__device__ __forceinline__ float sigmoid_(float x) { return 1.f / (1.f + __expf(-x)); }
__device__ __forceinline__ float silu_(float x) { return x / (1.f + __expf(-x)); }
__device__ __forceinline__ float logsigmoid_(float x) { return fminf(x, 0.f) - log1pf(expf(-fabsf(x))); }
__device__ __forceinline__ float wave_sum(float v) {
#pragma unroll
    for (int o = 1; o < 64; o <<= 1) v += __shfl_xor(v, o);
    return v;
}

#define XB_TMO      128
#define XB_XCNT(j)  (256  + 64 * (j))
#define XB_XSUB(j)  (1280 + 64 * (j))
#define XB_XGEN(j)  (2304 + 64 * (j))
#define XB_TOP      3328
#define XB_TOPGEN   3392
#define XCD_BAR_WORDS 3456
#define XB_SPIN_CAP (1u << 18)
__device__ __forceinline__ unsigned xb_ld(unsigned* p)              { return __hip_atomic_load(p, __ATOMIC_RELAXED, __HIP_MEMORY_SCOPE_AGENT); }
__device__ __forceinline__ unsigned xb_add(unsigned* p, unsigned v) { return __hip_atomic_fetch_add(p, v, __ATOMIC_RELAXED, __HIP_MEMORY_SCOPE_AGENT); }
__device__ __forceinline__ unsigned xb_xcc_id() { return (unsigned)__builtin_amdgcn_s_getreg((3 << 11) | 20) & 0xFu; }
#define XB_SPIN(cond, bar) do { unsigned _sp = 0; while (cond) { __builtin_amdgcn_s_sleep(1); \
    if ((++_sp & 255u) == 0u) { if (xb_ld(&(bar)[XB_TMO])) break; if (_sp > XB_SPIN_CAP) { atomicAdd(&(bar)[XB_TMO], 1u); break; } } } } while (0)
struct XcdBarrier { unsigned* bar; unsigned x; volatile LAS unsigned* st; };
__device__ __forceinline__ XcdBarrier xcd_barrier_post(unsigned* bar, volatile LAS unsigned* st) {
    XcdBarrier b; b.bar = bar; b.x = xb_xcc_id(); b.st = st;
    if (threadIdx.x == 0) (void)xb_add(&bar[XB_XCNT(b.x)], 1u);
    return b;
}
__device__ __forceinline__ void xcd_barrier_complete(unsigned* bar, unsigned x, unsigned& nloc, unsigned& nx) {
    const unsigned G = gridDim.x * gridDim.y * gridDim.z;
    unsigned sum, cnt, mine, sp = 0u;
    for (;;) {
        sum = 0u; cnt = 0u; mine = 0u;
#pragma unroll
        for (unsigned j = 0; j < 16; ++j) { const unsigned c = xb_ld(&bar[XB_XCNT(j)]); sum += c; cnt += (c > 0u) ? 1u : 0u; mine = (j == x) ? c : mine; }
        if (sum == G) break;
        __builtin_amdgcn_s_sleep(1);
        if ((++sp & 255u) == 0u) { if (xb_ld(&bar[XB_TMO])) break; if (sp > XB_SPIN_CAP) { atomicAdd(&bar[XB_TMO], 1u); break; } }
    }
    nloc = mine > 0u ? mine : 1u; nx = cnt > 0u ? cnt : 1u;
}
__device__ __forceinline__ void xcd_barrier(const XcdBarrier& b) {
    asm volatile("s_waitcnt vmcnt(0)" ::: "memory");
    __syncthreads();
    if (threadIdx.x == 0) {
        unsigned* bar = b.bar;
        __builtin_amdgcn_s_waitcnt(0);
        unsigned nloc = b.st[0], nx = b.st[1];
        if (nloc == 0u) { xcd_barrier_complete(bar, b.x, nloc, nx); b.st[0] = nloc; b.st[1] = nx; }
        const unsigned old = xb_add(&bar[XB_XSUB(b.x)], 1u);
        const unsigned gen = old / nloc;
        if (old + 1u == (gen + 1u) * nloc) {
            __builtin_amdgcn_fence(__ATOMIC_RELEASE, "agent");
            asm volatile("s_waitcnt vmcnt(0)" ::: "memory");
            const unsigned og = xb_add(&bar[XB_TOP], 1u);
            const unsigned tg = og / nx;
            if (og + 1u == (tg + 1u) * nx) xb_add(&bar[XB_TOPGEN], 1u);
            else XB_SPIN(xb_ld(&bar[XB_TOPGEN]) == tg, bar);
            __builtin_amdgcn_fence(__ATOMIC_ACQUIRE, "agent");
            xb_add(&bar[XB_XGEN(b.x)], 1u);
            asm volatile("s_waitcnt vmcnt(0)" ::: "memory");
        } else {
            XB_SPIN(xb_ld(&bar[XB_XGEN(b.x)]) == gen, bar);
            __builtin_amdgcn_fence(__ATOMIC_ACQUIRE, "agent");
            asm volatile("s_waitcnt vmcnt(0)" ::: "memory");
        }
    }
    __syncthreads();
}

namespace pg8 {
constexpr int BM = 256, BK = 64, HALF = 128, HTB = HALF * BK * 2, STAGE_BYTES = 8 * HTB, NXCD = 8, WGM = 8;
__host__ __device__ __forceinline__ int lds_byte(int r, int c) { const int st = (r >> 4) * 2 + (c >> 5), rr = r & 15, cc = c & 31, ob = rr * 64 + cc * 2; return st * 1024 + (ob ^ (((ob >> 9) & 1) << 5)); }
__host__ __device__ __forceinline__ void stage_rc(int b, int& R, int& C) { const int st = b / 1024, sb = b % 1024, swz = sb ^ (((sb >> 9) & 1) << 5); R = (st >> 1) * 16 + swz / 64; C = (st & 1) * 32 + (swz % 64) / 2; }
__host__ __device__ __forceinline__ int perm32(int rho) { const int n = rho >> 4, i = rho & 15; return 8 * (i >> 2) + 4 * n + (i & 3); }

struct Unit { int pm, pn, seg, z; };
struct Gemm { const bf16_t* A0; const bf16_t* B0; const bf16_t* A1; const bf16_t* B1; int lda, ldb, K, zA, zB; };
struct Sched {
    int nM0, nN0, nM1, nN1, n0, ntot, G, c;
    __device__ void init(int nM0_, int nN0_, int nz0, int nM1_, int nN1_, int nz1, int G_, int c_) { nM0 = nM0_; nN0 = nN0_; nM1 = nM1_; nN1 = nN1_; n0 = nM0 * nN0 * nz0; ntot = n0 + nM1 * nN1 * nz1; G = G_; c = c_; }
    __device__ bool next(int i, Unit& u) const {
        int L = i * G + c; if (L >= ntot) return false;
        int nM = nM0, nN = nN0; u.seg = 0; if (L >= n0) { L -= n0; nM = nM1; nN = nN1; u.seg = 1; }
        const int nwg = nM * nN; u.z = L / nwg; int wgid = L - u.z * nwg;
        { const int q = nwg / NXCD, r = nwg % NXCD, xcd = wgid % NXCD, off = wgid / NXCD; wgid = (xcd < r ? xcd * (q + 1) : r * (q + 1) + (xcd - r) * q) + off; }
        const int nig = WGM * nN, gid = wgid / nig, fm = gid * WGM, gsz = (nM - fm) < WGM ? (nM - fm) : WGM;
        u.pm = fm + ((wgid % nig) % gsz); u.pn = (wgid % nig) / gsz; return true;
    }
};
template <class Epi>
__device__ __forceinline__ void gemm_phase(LAS unsigned char* lds, const Gemm g, const Sched& S, const Epi& E) {
    int tid_ = threadIdx.x; asm volatile("" : "+v"(tid_));
    const int tid = tid_, wid = __builtin_amdgcn_readfirstlane(tid >> 6), lane = tid & 63, wr = wid >> 2, wc = wid & 3, fr = lane & 15, fq = lane >> 4;
    int K_ = g.K; asm volatile("" : "+s"(K_));
    const int K = K_, nt = K / BK;
    unsigned voffA[2], voffB[2];
#pragma unroll
    for (int i = 0; i < 2; ++i) { int R, C; stage_rc(tid * 16 + i * 8192, R, C); const int Rb = (R & ~31) + perm32(R & 31);
        voffA[i] = (unsigned)(R * g.lda + C) * 2u; voffB[i] = (unsigned)(Rb * g.ldb + C) * 2u; }
    const size_t kstep = (size_t)(BK * 2);
    const size_t hstepA = (size_t)HALF * g.lda * 2, hstepB = (size_t)HALF * g.ldb * 2;
    const unsigned ldsw = (unsigned)wid * 1024u;
    const int aoff = lds_byte(wr * 64 + fr, fq * 8), boff = lds_byte(wc * 32 + fr, fq * 8);
#define PG8_SA(b, h) (((b) * 2 + (h)) * HTB)
#define PG8_SB(b, h) ((4 + (b) * 2 + (h)) * HTB)
#define PG8_STAGE(bufoff, gbase, voff) do { _Pragma("unroll") for (int _i = 0; _i < 2; ++_i) \
        __builtin_amdgcn_global_load_lds((const unsigned*)((const char*)(gbase) + (voff)[_i]), (LAS unsigned*)(lds + (bufoff) + ldsw + _i * 8192), 16, 0, 0); } while (0)
#define PG8_LDA(dst, b, h) do { _Pragma("unroll") for (int m = 0; m < 4; ++m) _Pragma("unroll") for (int k = 0; k < 2; ++k) dst[m][k] = *(const LAS bf16x8*)(lds + PG8_SA(b, h) + aoff + m * 2048 + k * 1024); } while (0)
#define PG8_LDB(dst, b, h) do { _Pragma("unroll") for (int n = 0; n < 2; ++n) _Pragma("unroll") for (int k = 0; k < 2; ++k) dst[n][k] = *(const LAS bf16x8*)(lds + PG8_SB(b, h) + boff + n * 2048 + k * 1024); } while (0)
#define PG8_MMA(ai, bj, At, Bt) do { __builtin_amdgcn_s_setprio(1); _Pragma("unroll") for (int m = 0; m < 4; ++m) _Pragma("unroll") for (int n = 0; n < 2; ++n) _Pragma("unroll") for (int k = 0; k < 2; ++k) \
        acc[ai][bj][m][n] = __builtin_amdgcn_mfma_f32_16x16x32_bf16(Bt[n][k], At[m][k], acc[ai][bj][m][n], 0, 0, 0); __builtin_amdgcn_s_setprio(0); } while (0)
#define PG8_WAIT_V(n) asm volatile("s_waitcnt vmcnt(" #n ")" ::: "memory")
#define PG8_WAIT_L(n) asm volatile("s_waitcnt lgkmcnt(" #n ")" ::: "memory")
#define PG8_BAR __builtin_amdgcn_s_barrier()
#define PG8_SCHED __builtin_amdgcn_sched_barrier(0)
#define PG8_ABASE(u) ((const char*)((u).seg ? g.A1 : g.A0) + ((size_t)(u).z * g.zA) * 2 + (size_t)(u).pm * 2 * hstepA)
#define PG8_BBASE(u) ((const char*)((u).seg ? g.B1 : g.B0) + ((size_t)(u).z * g.zB) * 2 + (size_t)(u).pn * 2 * hstepB)
    Unit cur, nxt; int ui = 0;
    if (!S.next(0, cur)) return;
    f32x4 acc[2][2][4][2];
#pragma unroll
    for (int a = 0; a < 2; ++a)
#pragma unroll
        for (int b = 0; b < 2; ++b)
#pragma unroll
            for (int m = 0; m < 4; ++m)
#pragma unroll
                for (int n = 0; n < 2; ++n) acc[a][b][m][n] = (f32x4){0.f, 0.f, 0.f, 0.f};
    bf16x8 At[4][2], B0[2][2], B1[2][2];
    const char* cA = PG8_ABASE(cur); const char* cB = PG8_BBASE(cur);
    PG8_STAGE(PG8_SB(0, 0), cB, voffB); PG8_STAGE(PG8_SB(0, 1), cB + hstepB, voffB); PG8_STAGE(PG8_SA(0, 0), cA, voffA); PG8_STAGE(PG8_SA(0, 1), cA + hstepA, voffA);
    if (wr == 1) PG8_BAR;
    PG8_WAIT_V(2); PG8_BAR;
    PG8_STAGE(PG8_SB(1, 0), cB + kstep, voffB); PG8_STAGE(PG8_SA(1, 0), cA + kstep, voffA); PG8_STAGE(PG8_SB(1, 1), cB + hstepB + kstep, voffB);
    PG8_WAIT_V(6); PG8_BAR;
    for (;;) {
        const bool has_next = S.next(ui + 1, nxt);
        const char* nA = has_next ? PG8_ABASE(nxt) : cA; const char* nB = has_next ? PG8_BBASE(nxt) : cB;
#ifndef MK_KLOOP_PASSES
#define MK_KLOOP_PASSES 1
#endif
        _Pragma("nounroll") for (int pass_ = 0; pass_ < MK_KLOOP_PASSES; ++pass_) {
        const bool lastpass_ = pass_ == MK_KLOOP_PASSES - 1;
        for (int t = 0; t < nt; t += 2) {
            const bool last = (t == nt - 2);
            const char* a1 = cA + (size_t)(t + 1) * kstep;
            const char* a2 = last ? (lastpass_ ? nA : cA) : cA + (size_t)(t + 2) * kstep; const char* b2 = last ? (lastpass_ ? nB : cB) : cB + (size_t)(t + 2) * kstep;
            const char* a3 = a2 + kstep; const char* b3 = b2 + kstep;
            PG8_LDB(B0, 0, 0); PG8_LDB(B1, 0, 1); PG8_SCHED; PG8_LDA(At, 0, 0); PG8_STAGE(PG8_SA(1, 1), a1 + hstepA, voffA);
            PG8_WAIT_V(8); PG8_WAIT_L(0); PG8_BAR; PG8_MMA(0, 0, At, B0); PG8_MMA(0, 1, At, B1); PG8_BAR; PG8_SCHED;
            PG8_LDA(At, 0, 1); PG8_STAGE(PG8_SB(0, 0), b2, voffB); PG8_STAGE(PG8_SB(0, 1), b2 + hstepB, voffB); PG8_STAGE(PG8_SA(0, 0), a2, voffA);
            PG8_WAIT_V(8); PG8_WAIT_L(0); PG8_BAR; PG8_MMA(1, 0, At, B0); PG8_MMA(1, 1, At, B1); PG8_BAR; PG8_SCHED;
            PG8_LDB(B0, 1, 0); PG8_LDB(B1, 1, 1); PG8_SCHED; PG8_LDA(At, 1, 0); PG8_STAGE(PG8_SA(0, 1), a2 + hstepA, voffA);
            PG8_WAIT_V(8); PG8_WAIT_L(0); PG8_BAR; PG8_MMA(0, 0, At, B0); PG8_MMA(0, 1, At, B1); PG8_BAR; PG8_SCHED;
            PG8_LDA(At, 1, 1); PG8_STAGE(PG8_SB(1, 0), b3, voffB); PG8_STAGE(PG8_SB(1, 1), b3 + hstepB, voffB); PG8_STAGE(PG8_SA(1, 0), a3, voffA);
            PG8_WAIT_V(8); PG8_WAIT_L(0); PG8_BAR; PG8_MMA(1, 0, At, B0); PG8_MMA(1, 1, At, B1); PG8_BAR; PG8_SCHED;
        }
        if (!lastpass_) {
#pragma unroll
            for (int a = 0; a < 2; ++a)
#pragma unroll
                for (int b = 0; b < 2; ++b)
#pragma unroll
                    for (int m = 0; m < 4; ++m)
#pragma unroll
                        for (int n = 0; n < 2; ++n) acc[a][b][m][n] = (f32x4){0.f, 0.f, 0.f, 0.f}; }
        }
        if (wr == 0) PG8_BAR;
        if constexpr (Epi::NEEDS_RS) {
            if (tid < 256) { const float* q_ = E.SSQ + (size_t)((cur.seg ? cur.pn : cur.pm) * 256 + tid) * 16; const f32x4 a_ = *(const f32x4*)q_, b_ = *(const f32x4*)(q_ + 4), c_ = *(const f32x4*)(q_ + 8), d_ = *(const f32x4*)(q_ + 12);
                const float s_ = ((a_.x + a_.y) + (a_.z + a_.w)) + ((b_.x + b_.y) + (b_.z + b_.w)) + ((c_.x + c_.y) + (c_.z + c_.w)) + ((d_.x + d_.y) + (d_.z + d_.w));
                ((LAS float*)(lds + STAGE_BYTES))[tid] = 1.f / sqrtf(s_ * (1.f / 1024.f) + 1e-6f); }
            PG8_WAIT_L(0); PG8_BAR; asm volatile("" ::: "memory");
        }
        E(acc, cur, wr, wc, fr, fq, (const LAS float*)(lds + STAGE_BYTES));
        if (!has_next) break;
#pragma unroll
        for (int a = 0; a < 2; ++a)
#pragma unroll
            for (int b = 0; b < 2; ++b)
#pragma unroll
                for (int m = 0; m < 4; ++m)
#pragma unroll
                    for (int n = 0; n < 2; ++n) acc[a][b][m][n] = (f32x4){0.f, 0.f, 0.f, 0.f};
        cur = nxt; cA = nA; cB = nB; ++ui;
        if (wr == 1) PG8_BAR;
    }
    PG8_WAIT_V(0);
    PG8_BAR;
#undef PG8_SA
#undef PG8_SB
#undef PG8_STAGE
#undef PG8_LDA
#undef PG8_LDB
#undef PG8_MMA
#undef PG8_WAIT_V
#undef PG8_WAIT_L
#undef PG8_BAR
#undef PG8_SCHED
#undef PG8_ABASE
#undef PG8_BBASE
}
}
constexpr size_t MiB = 1u << 20;
constexpr size_t SZ_TD2 = (size_t)T * D * 2;
constexpr size_t WS_CTL = 0;
constexpr size_t WS_W = 1 * MiB;
constexpr size_t W_UP1 = WS_W, W_DN1 = W_UP1 + (size_t)2 * FF * D * 2, W_IN = W_DN1 + (size_t)D * FF * 2;
constexpr int NIN = 8448;
constexpr size_t W_QK = W_IN + (size_t)NIN * D * 2, W_PA = W_QK + (size_t)512 * D * 2, W_PB = W_PA + (size_t)D * D * 2, W_O = W_PB + (size_t)D * D * 2;
constexpr size_t W_UP2 = W_O + (size_t)D * D * 2, W_DN2 = W_UP2 + (size_t)2 * FF * D * 2, W_END = W_DN2 + (size_t)D * FF * 2;
static_assert(W_END <= 61 * MiB, "weights");
constexpr size_t WS_XBF = 61 * MiB;
constexpr size_t WS_MISC = WS_XBF + SZ_TD2;
constexpr size_t M_SSQ = WS_MISC;
constexpr size_t M_GATES = M_SSQ + (size_t)T * 16 * 4;
constexpr size_t M_SC = M_GATES + (size_t)T * 32 * 4;
constexpr size_t M_EAL = M_SC + (size_t)5 * NH * T * 4;
constexpr size_t M_DEN = M_EAL + (size_t)384 * GKW * 4;
constexpr size_t M_END = M_DEN + (size_t)T * 4 * 4;
static_assert(M_END <= WS_MISC + 6 * MiB, "misc");
constexpr size_t WS_ACT = WS_MISC + 6 * MiB;
constexpr size_t A_Q = WS_ACT, A_K = A_Q + SZ_TD2, A_QT = A_K + SZ_TD2;
constexpr size_t WS_SIG = WS_ACT + 94 * MiB;
constexpr size_t S_SIGO = WS_SIG, S_SILUR = S_SIGO + SZ_TD2, S_SIGA = S_SILUR + SZ_TD2, S_SIGB = S_SIGA + SZ_TD2;
constexpr size_t WS_VT = WS_SIG + 4 * SZ_TD2;
constexpr size_t WS_KT = WS_VT + 2 * SZ_TD2;
constexpr size_t WS_G = WS_KT + SZ_TD2;
constexpr size_t G_KT = WS_G, G_KTT = WS_G + SZ_TD2 / 2;
constexpr size_t WS_HN = WS_G + SZ_TD2;
constexpr size_t WS_END = WS_HN + SZ_TD2;
static_assert(A_QT + SZ_TD2 / 2 <= WS_SIG && WS_END <= 502 * MiB, "ws map");
constexpr size_t O_YP = 0, O_YS = 16777216, O_CONVP = 17825792, O_CP = 17850368, O_NP = 19947520, O_MP = 19955712, O_SP = 19955744, O_CONVS = 21004320, O_CS = 21397536, O_NS = 54951968, O_MS = 55083040, O_SS = 55083552, O_END = 71860768;
constexpr size_t DO_OG = 0;
constexpr size_t DO_U = O_CS * 4, DO_QG = DO_U + SZ_TD2, DO_KG = DO_QG + SZ_TD2 / 2, DO_CH = DO_KG + SZ_TD2 / 2;
static_assert(DO_CH + SZ_TD2 <= O_NS * 4, "d_out temporaries");

struct P {
    const float* in[28]; float* out; unsigned char* ws;
};
#define WSP(T_, off) ((T_*)(p.ws + (off)))
#define DOP(T_, off) ((T_*)((unsigned char*)p.out + (off)))

__device__ __forceinline__ int win_src(int n) {
    if (n < 1024) return n;
    if (n < 2048) return 2048 + (n - 1024);
    if (n < 2560) return 3080 + (n - 2048);
    if (n < 3072) return 3592 + (n - 2560);
    if (n < 4096) return 5128 + (n - 3072);
    if (n < 5120) return 6168 + (n - 4096);
    if (n < 6144) return 7192 + (n - 5120);
    if (n < 6400) { const int j = n - 6144; return j < 8 ? 3072 + j : (j < 24 ? 6152 + (j - 8) : -1); }
    if (n < 7424) return 1024 + (n - 6400);
    return 4104 + (n - 7424);
}
__device__ __forceinline__ int up_src(int n) { const int t = n >> 8, r = n & 255; return (r >> 7) * FF + t * 128 + (r & 127); }
template <int MAP>
__device__ __forceinline__ void p0_item(const float* W, int K, int N, const float* gk, float scale, bf16_t* WT, int dst_row0, int ndst, LAS float* scr, int item, int lane) {
    const int nblk = ndst / 32, kb = item / nblk, nb = item % nblk, k0 = 64 * kb, n0 = 32 * nb;
    const int nn = n0 + (lane & 31); const int src = MAP == 0 ? nn : (MAP == 1 ? up_src(nn) : win_src(nn));
    float v[32];
#pragma unroll
    for (int i = 0; i < 32; ++i) { const int kk = 2 * i + (lane >> 5); v[i] = src >= 0 ? W[(size_t)(k0 + kk) * N + src] : 0.f; }
#pragma unroll
    for (int i = 0; i < 32; ++i) scr[(2 * i + (lane >> 5)) * 33 + (lane & 31)] = v[i];
    asm volatile("s_waitcnt lgkmcnt(0)" ::: "memory");
    const int c = lane & 7;
    f32x4 g0 = {scale, scale, scale, scale}, g1 = g0;
    if (gk) { g0 = *(const f32x4*)(gk + k0 + 8 * c) * scale; g1 = *(const f32x4*)(gk + k0 + 8 * c + 4) * scale; }
#pragma unroll
    for (int j = 0; j < 4; ++j) { const int n = (lane >> 3) + 8 * j; const LAS float* s = scr + (8 * c) * 33 + n;
        u32x4 o; o.x = pk2(s[0 * 33] * g0[0], s[1 * 33] * g0[1]); o.y = pk2(s[2 * 33] * g0[2], s[3 * 33] * g0[3]); o.z = pk2(s[4 * 33] * g1[0], s[5 * 33] * g1[1]); o.w = pk2(s[6 * 33] * g1[2], s[7 * 33] * g1[3]);
        *(u32x4*)(WT + (size_t)(dst_row0 + n0 + n) * K + k0 + 8 * c) = o; }
    asm volatile("s_waitcnt lgkmcnt(0)" ::: "memory");
}
__device__ __forceinline__ void p0_prologue(const P& p, LAS unsigned char* lds, int gw, int NGW, int wave, int lane) {
    LAS float* scr = (LAS float*)(lds + wave * 16384);
    constexpr int I_UP = (D / 64) * (2 * FF / 32), I_DN = (FF / 64) * (D / 32), I_IN = (D / 64) * (NIN / 32), I_QK = (D / 64) * (256 / 32), I_SQ = (D / 64) * (D / 32);
    constexpr int NITEMS = 2 * I_UP + 2 * I_DN + I_IN + 2 * I_QK + 3 * I_SQ;
    for (int it = gw; it < NITEMS; it += NGW) {
        int r = it;
        if (r < I_IN) { p0_item<2>(p.in[11], D, INW, p.in[10], 1.f, WSP(bf16_t, W_IN), 0, NIN, scr, r, lane); continue; } r -= I_IN;
        if (r < I_UP) { p0_item<1>(p.in[8], D, 2 * FF, p.in[7], 1.f, WSP(bf16_t, W_UP1), 0, 2 * FF, scr, r, lane); continue; } r -= I_UP;
        if (r < I_UP) { p0_item<1>(p.in[25], D, 2 * FF, p.in[24], 1.f, WSP(bf16_t, W_UP2), 0, 2 * FF, scr, r, lane); continue; } r -= I_UP;
        if (r < I_DN) { p0_item<0>(p.in[9], FF, D, nullptr, 1.f, WSP(bf16_t, W_DN1), 0, D, scr, r, lane); continue; } r -= I_DN;
        if (r < I_DN) { p0_item<0>(p.in[26], FF, D, nullptr, 1.f, WSP(bf16_t, W_DN2), 0, D, scr, r, lane); continue; } r -= I_DN;
        if (r < I_QK) { p0_item<0>(p.in[14], D, 256, nullptr, 1.f, WSP(bf16_t, W_QK), 0, 256, scr, r, lane); continue; } r -= I_QK;
        if (r < I_QK) { p0_item<0>(p.in[15], D, 256, nullptr, 0.0625f, WSP(bf16_t, W_QK), 256, 256, scr, r, lane); continue; } r -= I_QK;
        if (r < I_SQ) { p0_item<0>(p.in[21], D, D, nullptr, 1.f, WSP(bf16_t, W_PA), 0, D, scr, r, lane); continue; } r -= I_SQ;
        if (r < I_SQ) { p0_item<0>(p.in[22], D, D, nullptr, 1.f, WSP(bf16_t, W_PB), 0, D, scr, r, lane); continue; } r -= I_SQ;
        p0_item<0>(p.in[23], D, D, nullptr, 1.f, WSP(bf16_t, W_O), 0, D, scr, r, lane);
    }
    bf16_t* XB = WSP(bf16_t, WS_XBF); float* SSQ = WSP(float, M_SSQ);
    for (int m0 = 2 * gw; m0 < T; m0 += 2 * NGW) {
        f32x4 v[2][4];
#pragma unroll
        for (int r = 0; r < 2; ++r) { const int m = m0 + r; const float* xrow = m < T_P ? p.in[0] + (size_t)m * D : p.in[1] + (size_t)(m - T_P) * D; const f32x4* xr = (const f32x4*)xrow + lane;
#pragma unroll
            for (int j = 0; j < 4; ++j) v[r][j] = xr[64 * j]; }
#pragma unroll
        for (int r = 0; r < 2; ++r) { const int m = m0 + r; float s = 0.f;
#pragma unroll
            for (int j = 0; j < 4; ++j) s += (v[r][j].x * v[r][j].x + v[r][j].y * v[r][j].y) + (v[r][j].z * v[r][j].z + v[r][j].w * v[r][j].w);
            s = wave_sum(s);
            u32x2* o8 = (u32x2*)(XB + (size_t)m * D) + lane;
#pragma unroll
            for (int j = 0; j < 4; ++j) { u32x2 w; w.x = pk2(v[r][j].x, v[r][j].y); w.y = pk2(v[r][j].z, v[r][j].w); o8[64 * j] = w; }
            if (lane < 16) SSQ[(size_t)m * 16 + lane] = lane == 0 ? s : 0.f; }
    }
}
__device__ __forceinline__ float row_rs(const float* SSQ, int row) {
    const f32x4* q = (const f32x4*)(SSQ + (size_t)row * 16); const f32x4 a = q[0], b = q[1], c = q[2], d = q[3];
    const float s = ((a.x + a.y) + (a.z + a.w)) + ((b.x + b.y) + (b.z + b.w)) + ((c.x + c.y) + (c.z + c.w)) + ((d.x + d.y) + (d.z + d.w));
    return 1.f / sqrtf(s * (1.f / D) + EPS);
}

typedef pg8::Unit Unit;
#define EPI_ARGS const f32x4 (&acc)[2][2][4][2], const Unit& u, int wr, int wc, int fr, int fq, const LAS float* rst
struct EpiUp { static constexpr bool NEEDS_RS = true; const float* SSQ; bf16_t* ACT;
    __device__ __forceinline__ void operator()(EPI_ARGS) const {
        const int row0 = u.pm * 256 + wr * 64 + fr, col0 = u.pn * 128 + wc * 32 + 8 * fq;
#pragma unroll
        for (int ai = 0; ai < 2; ++ai)
#pragma unroll
            for (int m = 0; m < 4; ++m) { const int row = row0 + ai * 128 + m * 16; const float rs = rst[wr * 64 + fr + ai * 128 + m * 16]; u32x4 w; unsigned* wp = (unsigned*)&w;
#pragma unroll
                for (int n = 0; n < 2; ++n) { const f32x4 a = acc[ai][0][m][n] * rs, g = acc[ai][1][m][n] * rs;
                    wp[2 * n] = pk2(silu_(g[0]) * a[0], silu_(g[1]) * a[1]); wp[2 * n + 1] = pk2(silu_(g[2]) * a[2], silu_(g[3]) * a[3]); }
                *(u32x4*)(ACT + (size_t)row * FF + col0) = w; }
    }
};
template <int MODE> struct EpiRes { static constexpr bool NEEDS_RS = false; bf16_t* XB; float* XO; float* SSQ; float alpha;
    __device__ __forceinline__ void operator()(EPI_ARGS) const {
        const int row0 = u.pm * 256 + wr * 64 + fr;
#pragma unroll
        for (int ai = 0; ai < 2; ++ai)
#pragma unroll
            for (int m = 0; m < 4; ++m) { const int row = row0 + ai * 128 + m * 16; float ss = 0.f;
#pragma unroll
                for (int bj = 0; bj < 2; ++bj) { const int col = u.pn * 256 + bj * 128 + wc * 32 + 8 * fq; const size_t off = (size_t)row * D + col;
                    const u32x4 xw = *(const u32x4*)(XB + off);
                    const f32x4 x0 = {bflo(xw.x), bfhi(xw.x), bflo(xw.y), bfhi(xw.y)}, x1 = {bflo(xw.z), bfhi(xw.z), bflo(xw.w), bfhi(xw.w)};
                    const f32x4 y0 = x0 + acc[ai][bj][m][0] * alpha, y1 = x1 + acc[ai][bj][m][1] * alpha;
                    if (MODE == 0) { ss += (y0[0] * y0[0] + y0[1] * y0[1]) + (y0[2] * y0[2] + y0[3] * y0[3]) + (y1[0] * y1[0] + y1[1] * y1[1]) + (y1[2] * y1[2] + y1[3] * y1[3]);
                        u32x4 w; w.x = pk2(y0[0], y0[1]); w.y = pk2(y0[2], y0[3]); w.z = pk2(y1[0], y1[1]); w.w = pk2(y1[2], y1[3]); *(u32x4*)(XB + off) = w; }
                    else { *(f32x4*)(XO + off) = y0; *(f32x4*)(XO + off + 4) = y1; } }
                if (MODE == 0) { ss += __shfl_xor(ss, 16); ss += __shfl_xor(ss, 32); if (fq == 0) SSQ[(size_t)row * 16 + u.pn * 4 + wc] = ss; } }
    }
};
struct EpiIn { static constexpr bool NEEDS_RS = true; const float* SSQ; bf16_t *U, *SIGO, *QG, *KG, *SILUR, *SIGA, *SIGB, *VT; float* GATES;
    __device__ __forceinline__ void operator()(EPI_ARGS) const {
        if (u.seg == 0) {
            const int row0 = u.pm * 256 + wr * 64 + fr; const int pn = u.pn;
            bf16_t* dst; int ld, cb, act;
            if (pn < 4) { dst = U; ld = D; cb = pn * 256; act = 0; } else if (pn < 8) { dst = SIGO; ld = D; cb = (pn - 4) * 256; act = 1; }
            else if (pn < 10) { dst = QG; ld = GKW; cb = (pn - 8) * 256; act = 0; } else if (pn < 12) { dst = KG; ld = GKW; cb = (pn - 10) * 256; act = 0; }
            else if (pn < 16) { dst = SILUR; ld = D; cb = (pn - 12) * 256; act = 2; } else if (pn < 20) { dst = SIGA; ld = D; cb = (pn - 16) * 256; act = 1; }
            else { dst = SIGB; ld = D; cb = (pn - 20) * 256; act = 1; }
#pragma unroll
            for (int ai = 0; ai < 2; ++ai)
#pragma unroll
                for (int m = 0; m < 4; ++m) { const int row = row0 + ai * 128 + m * 16; const float rs = rst[wr * 64 + fr + ai * 128 + m * 16];
                    if (pn == 24) { if (wc == 0) { *(f32x4*)(GATES + (size_t)row * 32 + 8 * fq) = acc[ai][0][m][0] * rs; *(f32x4*)(GATES + (size_t)row * 32 + 8 * fq + 4) = acc[ai][0][m][1] * rs; } continue; }
#pragma unroll
                    for (int bj = 0; bj < 2; ++bj) { f32x4 v0 = acc[ai][bj][m][0] * rs, v1 = acc[ai][bj][m][1] * rs;
                        if (act == 1) { for (int i = 0; i < 4; ++i) { v0[i] = sigmoid_(v0[i]); v1[i] = sigmoid_(v1[i]); } }
                        else if (act == 2) { for (int i = 0; i < 4; ++i) { v0[i] = silu_(v0[i]); v1[i] = silu_(v1[i]); } }
                        u32x4 w; w.x = pk2(v0[0], v0[1]); w.y = pk2(v0[2], v0[3]); w.z = pk2(v1[0], v1[1]); w.w = pk2(v1[2], v1[3]);
                        *(u32x4*)(dst + (size_t)row * ld + cb + bj * 128 + wc * 32 + 8 * fq) = w; } }
        } else {
            const int vrow0 = u.pm * 256 + wr * 64 + fr;
            float rs[2][8];
#pragma unroll
            for (int bj = 0; bj < 2; ++bj)
#pragma unroll
                for (int j = 0; j < 8; ++j) rs[bj][j] = rst[bj * 128 + wc * 32 + 8 * fq + j];
#pragma unroll
            for (int ai = 0; ai < 2; ++ai)
#pragma unroll
                for (int m = 0; m < 4; ++m) { const int vr = vrow0 + ai * 128 + m * 16;
#pragma unroll
                    for (int bj = 0; bj < 2; ++bj) { const f32x4 a0 = acc[ai][bj][m][0], a1 = acc[ai][bj][m][1]; u32x4 w;
                        w.x = pk2(a0[0] * rs[bj][0], a0[1] * rs[bj][1]); w.y = pk2(a0[2] * rs[bj][2], a0[3] * rs[bj][3]); w.z = pk2(a1[0] * rs[bj][4], a1[1] * rs[bj][5]); w.w = pk2(a1[2] * rs[bj][6], a1[3] * rs[bj][7]);
                        *(u32x4*)(VT + (size_t)vr * T + u.pn * 256 + bj * 128 + wc * 32 + 8 * fq) = w; } }
        }
    }
};
struct EpiQK { static constexpr bool NEEDS_RS = false; bf16_t *Q, *K, *KT;
    __device__ __forceinline__ void operator()(EPI_ARGS) const {
        const int row0 = u.pm * 256 + wr * 64 + fr;
#pragma unroll
        for (int ai = 0; ai < 2; ++ai)
#pragma unroll
            for (int m = 0; m < 4; ++m) { const int row = row0 + ai * 128 + m * 16;
#pragma unroll
                for (int bj = 0; bj < 2; ++bj) { const f32x4 v0 = acc[ai][bj][m][0], v1 = acc[ai][bj][m][1]; const int cc = bj * 128 + wc * 32 + 8 * fq;
                    u32x4 w; w.x = pk2(v0[0], v0[1]); w.y = pk2(v0[2], v0[3]); w.z = pk2(v1[0], v1[1]); w.w = pk2(v1[2], v1[3]);
                    if (u.seg == 0) *(u32x4*)((u.pn == 0 ? Q : K) + (size_t)row * D + u.z * 256 + cc) = w;
                    else *(u32x4*)(KT + (size_t)(u.z * 256 + row) * T + u.pn * 256 + cc) = w; } }
    }
};
template <int MODE> struct EpiMerge { static constexpr bool NEEDS_RS = false; const bf16_t* G; float* YT; bf16_t* Y;
    __device__ __forceinline__ void operator()(EPI_ARGS) const {
        const int row0 = u.pm * 256 + wr * 64 + fr;
#pragma unroll
        for (int ai = 0; ai < 2; ++ai)
#pragma unroll
            for (int m = 0; m < 4; ++m) { const int row = row0 + ai * 128 + m * 16;
#pragma unroll
                for (int bj = 0; bj < 2; ++bj) { const size_t off = (size_t)row * D + u.pn * 256 + bj * 128 + wc * 32 + 8 * fq;
                    const u32x4 gw = *(const u32x4*)(G + off);
                    f32x4 g0 = {bflo(gw.x), bfhi(gw.x), bflo(gw.y), bfhi(gw.y)}, g1 = {bflo(gw.z), bfhi(gw.z), bflo(gw.w), bfhi(gw.w)};
                    f32x4 y0 = g0 * acc[ai][bj][m][0], y1 = g1 * acc[ai][bj][m][1];
                    if (MODE == 0) { *(f32x4*)(YT + off) = y0; *(f32x4*)(YT + off + 4) = y1; }
                    else { y0 += *(const f32x4*)(YT + off); y1 += *(const f32x4*)(YT + off + 4);
                        u32x4 w; w.x = pk2(y0[0], y0[1]); w.y = pk2(y0[2], y0[3]); w.z = pk2(y1[0], y1[1]); w.w = pk2(y1[2], y1[3]); *(u32x4*)(Y + off) = w; } } }
    }
};
constexpr size_t SC_STRIDE = (size_t)NH * T;
__device__ __forceinline__ void p4_conv(const P& p, size_t gtid, size_t gsz) {
    const bf16_t* U = DOP(const bf16_t, DO_U); bf16_t* CH = DOP(bf16_t, DO_CH);
    const float* cw = p.in[12]; const float* cb = p.in[13]; const float* stc = p.in[2];
    const int c8 = (int)(gtid & 127) * 8; const int rstep = (int)(gsz >> 7);
    float wt[4][8], bs[8];
#pragma unroll
    for (int j = 0; j < 4; ++j) { const f32x4 w0 = *(const f32x4*)(cw + j * D + c8), w1 = *(const f32x4*)(cw + j * D + c8 + 4); wt[j][0] = w0[0]; wt[j][1] = w0[1]; wt[j][2] = w0[2]; wt[j][3] = w0[3]; wt[j][4] = w1[0]; wt[j][5] = w1[1]; wt[j][6] = w1[2]; wt[j][7] = w1[3]; }
    { const f32x4 b0 = *(const f32x4*)(cb + c8), b1 = *(const f32x4*)(cb + c8 + 4); bs[0] = b0[0]; bs[1] = b0[1]; bs[2] = b0[2]; bs[3] = b0[3]; bs[4] = b1[0]; bs[5] = b1[1]; bs[6] = b1[2]; bs[7] = b1[3]; }
#pragma unroll 2
    for (int row = (int)(gtid >> 7); row < T; row += rstep) {
        int t, Tl, seq; if (row < T_P) { t = row & (SEQ - 1); Tl = SEQ; seq = row >> 11; } else { t = (row - T_P) & 7; Tl = DEC_T; seq = (row - T_P) >> 3; }
        float a[8];
#pragma unroll
        for (int i = 0; i < 8; ++i) a[i] = bs[i];
        u32x4 ucur = {0u, 0u, 0u, 0u};
#pragma unroll
        for (int j = 0; j < 4; ++j) { const int tt = t - 3 + j; float uv[8];
            if (tt >= 0) { const u32x4 w = *(const u32x4*)(U + (size_t)(row - 3 + j) * D + c8); if (j == 3) ucur = w;
                uv[0] = bflo(w.x); uv[1] = bfhi(w.x); uv[2] = bflo(w.y); uv[3] = bfhi(w.y); uv[4] = bflo(w.z); uv[5] = bfhi(w.z); uv[6] = bflo(w.w); uv[7] = bfhi(w.w); }
            else if (row >= T_P) { const float* s = stc + ((size_t)seq * 3 + (3 + tt)) * D + c8; const f32x4 s0 = *(const f32x4*)s, s1 = *(const f32x4*)(s + 4);
                uv[0] = s0[0]; uv[1] = s0[1]; uv[2] = s0[2]; uv[3] = s0[3]; uv[4] = s1[0]; uv[5] = s1[1]; uv[6] = s1[2]; uv[7] = s1[3]; }
            else {
#pragma unroll
                for (int i = 0; i < 8; ++i) uv[i] = 0.f; }
#pragma unroll
            for (int i = 0; i < 8; ++i) a[i] += uv[i] * wt[j][i]; }
        u32x4 o; o.x = pk2(silu_(a[0]), silu_(a[1])); o.y = pk2(silu_(a[2]), silu_(a[3])); o.z = pk2(silu_(a[4]), silu_(a[5])); o.w = pk2(silu_(a[6]), silu_(a[7]));
        *(u32x4*)(CH + (size_t)row * D + c8) = o;
        if (t >= Tl - 3) { float* co = (row < T_P ? p.out + O_CONVP : p.out + O_CONVS) + ((size_t)seq * 3 + (t - (Tl - 3))) * D + c8;
            *(f32x4*)co = (f32x4){bflo(ucur.x), bfhi(ucur.x), bflo(ucur.y), bfhi(ucur.y)}; *(f32x4*)(co + 4) = (f32x4){bflo(ucur.z), bfhi(ucur.z), bflo(ucur.w), bfhi(ucur.w)}; }
    }
}
__device__ __forceinline__ void p4_gates(const P& p, LAS unsigned char* lds, int bid, int tid) {
    const float* GATES = WSP(const float, M_GATES); float* SC = WSP(float, M_SC); const float* bif = p.in[16];
    const int lane = tid & 63, w = __builtin_amdgcn_readfirstlane(tid >> 6);
    if (bid < 32) {
        const int b = bid >> 2, h = bid & 3; LAS float* sum = (LAS float*)lds; LAS float* mp = sum + 64;
        const float bi = bif[h], bfg = bif[NH + h]; float a[4], bb[4], cm[4];
#pragma unroll
        for (int j = 0; j < 4; ++j) { const int c = 4 * w + j, row = b * SEQ + c * 64 + lane;
            const float gi = GATES[(size_t)row * 32 + h] + bi, gf = GATES[(size_t)row * 32 + NH + h] + bfg;
            float x = logsigmoid_(gf);
#pragma unroll
            for (int o = 1; o < 64; o <<= 1) { const float y = __shfl_up(x, o, 64); if (lane >= o) x += y; }
            float m = gi - x; a[j] = m;
#pragma unroll
            for (int o = 1; o < 64; o <<= 1) { const float y = __shfl_up(m, o, 64); if (lane >= o) m = fmaxf(m, y); }
            bb[j] = x; cm[j] = m; if (lane == 63) { sum[2 * c] = x; sum[2 * c + 1] = m; } }
        __syncthreads();
        if (tid == 0) { float m = 0.f; for (int c = 0; c < 32; ++c) { mp[c] = m; m = sum[2 * c] + fmaxf(m, sum[2 * c + 1]); } p.out[O_MP + (size_t)b * NH + h] = m; }
        __syncthreads();
#pragma unroll
        for (int j = 0; j < 4; ++j) { const int c = 4 * w + j, row = b * SEQ + c * 64 + lane; const float mprev = mp[c];
            const float Mt = fmaxf(mprev, cm[j]), mt = bb[j] + Mt, ML = __shfl(Mt, 63, 64); const size_t o = (size_t)h * T + row;
            SC[o] = a[j]; SC[SC_STRIDE + o] = Mt; SC[2 * SC_STRIDE + o] = expf(mprev - Mt); SC[3 * SC_STRIDE + o] = expf(a[j] - ML); SC[4 * SC_STRIDE + o] = expf(-mt); }
        __syncthreads();
    } else if (bid < 40) {
        const int job = (bid - 32) * 8 + w, h = job & 3, li = lane & 7, seq = (job >> 2) * 8 + (lane >> 3), row = T_P + seq * 8 + li;
        const float mprev = p.in[5][seq * NH + h];
        const float gi = GATES[(size_t)row * 32 + h] + bif[h], gf = GATES[(size_t)row * 32 + NH + h] + bif[NH + h];
        float b = logsigmoid_(gf);
#pragma unroll
        for (int o = 1; o < 8; o <<= 1) { const float x = __shfl_up(b, o, 8); if (li >= o) b += x; }
        const float a = gi - b; float cm = a;
#pragma unroll
        for (int o = 1; o < 8; o <<= 1) { const float x = __shfl_up(cm, o, 8); if (li >= o) cm = fmaxf(cm, x); }
        const float Mt = fmaxf(mprev, cm), mt = b + Mt, ML = __shfl(Mt, 7, 8), bL = __shfl(b, 7, 8); const size_t o = (size_t)h * T + row;
        SC[o] = a; SC[SC_STRIDE + o] = Mt; SC[2 * SC_STRIDE + o] = expf(mprev - Mt); SC[3 * SC_STRIDE + o] = expf(a - ML); SC[4 * SC_STRIDE + o] = expf(-mt);
        if (li == 7) p.out[O_MS + (size_t)seq * NH + h] = bL + ML;
    }
}
__device__ __forceinline__ void p4_gla(const P& p, int bid, int G, int tid) {
    const float* GATES = WSP(const float, M_GATES); const bf16_t* QG = DOP(const bf16_t, DO_QG); const bf16_t* KG = DOP(const bf16_t, DO_KG);
    bf16_t* QT = WSP(bf16_t, A_QT); bf16_t* KTn = WSP(bf16_t, G_KT); bf16_t* KTT = WSP(bf16_t, G_KTT); float* EAL = WSP(float, M_EAL);
    const int c = tid;
    float w2[16];
#pragma unroll
    for (int r = 0; r < 16; ++r) w2[r] = p.in[18][r * GKW + c];
    const float ba = p.in[19][c];
    for (int g = G - 1 - bid; g < NGRP; g += G) {
        const bool smp = g >= NCH_P; float A = 0.f;
        for (int t8 = 0; t8 < 8; ++t8) {
            unsigned kp[4] = {0u, 0u, 0u, 0u}; float eA = 1.f;
            if (smp) A = 0.f;
#pragma unroll
            for (int j = 0; j < 8; ++j) {
                const int row = g * 64 + t8 * 8 + j;
                const f32x4* ag = (const f32x4*)(GATES + (size_t)row * 32 + 8); float s = ba;
#pragma unroll
                for (int r4 = 0; r4 < 4; ++r4) { const f32x4 a4 = ag[r4]; s += a4[0] * w2[4 * r4] + a4[1] * w2[4 * r4 + 1] + a4[2] * w2[4 * r4 + 2] + a4[3] * w2[4 * r4 + 3]; }
                A += (fminf(s, 0.f) - __logf(1.f + __expf(-fabsf(s)))) * 0.0625f;
                const float q = bf2f(QG[(size_t)row * GKW + c]), k = bf2f(KG[(size_t)row * GKW + c]);
                eA = __expf(A); const float kt = k * __expf(-A);
                QT[(size_t)row * GKW + c] = (bf16_t)f2bf(q * 0.08838834764831845f * eA);
                const unsigned kb = f2bf(kt); KTn[(size_t)row * GKW + c] = (bf16_t)kb;
                if (j & 1) kp[j >> 1] |= kb << 16; else kp[j >> 1] = kb;
            }
            { u32x4 w = {kp[0], kp[1], kp[2], kp[3]}; *(u32x4*)(KTT + (size_t)c * T + g * 64 + t8 * 8) = w; }
            if (smp) EAL[(size_t)(256 + (g - NCH_P) * 8 + t8) * GKW + c] = eA;
            else if (t8 == 7) EAL[(size_t)g * GKW + c] = eA;
        }
    }
}

#define MFMA16(a, b, c) __builtin_amdgcn_mfma_f32_16x16x32_bf16(a, b, c, 0, 0, 0)
#define LBAR() do { asm volatile("s_waitcnt lgkmcnt(0)" ::: "memory"); __builtin_amdgcn_s_barrier(); asm volatile("" ::: "memory"); } while (0)
template <bool ML>
__device__ __forceinline__ void scan_prompt(const P& p, LAS unsigned char* lds, int b, int h, int es) {
    constexpr int DK = ML ? 256 : 128, ES = ML ? 64 : 128, NE = ML ? 80 : 128, NET = NE / 16, NDT = DK / 128  , KS = DK / 32;
    constexpr int QS = DK * 2 + 16, VS = 144;
    constexpr int OFF_Q = 0, OFF_K = OFF_Q + 64 * QS, OFF_V = OFF_K + 64 * QS, OFF_S = OFF_V + NE * VS, OFF_C = OFF_S + 64 * VS, OFF_SC = OFF_C + NE * QS;
    static_assert(OFF_SC + 1280 <= 140 * 1024, "scan LDS");
    constexpr int NT = NET * 4, TPW = (NT + 7) / 8;
    constexpr int QPT = 64 * (DK / 8) / NTHR, VPT = ES * 8 / NTHR;
    int tid_ = threadIdx.x; asm volatile("" : "+v"(tid_));
    const int tid = tid_, w = __builtin_amdgcn_readfirstlane(tid >> 6), lane = tid & 63, fr = lane & 15, fq = lane >> 4;
    const size_t row0 = (size_t)b * SEQ;
    const bf16_t* Qg = ML ? WSP(const bf16_t, A_Q) + row0 * D + h * 256 : WSP(const bf16_t, A_QT) + row0 * GKW + h * 128;
    const bf16_t* Kg = ML ? WSP(const bf16_t, A_K) + row0 * D + h * 256 : WSP(const bf16_t, G_KT) + row0 * GKW + h * 128;
    constexpr int LDQ = ML ? D : GKW;
    const bf16_t* VTg = WSP(const bf16_t, WS_VT) + (size_t)((ML ? 0 : 1024) + h * 256 + es * ES) * T + row0;
    const bf16_t* KTg = (ML ? WSP(const bf16_t, WS_KT) + (size_t)(h * 256) * T : WSP(const bf16_t, G_KTT) + (size_t)(h * 128) * T) + row0;
    const float* SC = WSP(const float, M_SC) + (size_t)h * T + row0;
    const float* EALg = WSP(const float, M_EAL) + (size_t)(b * 32) * GKW + h * 128;
    bf16_t* OUT = ML ? WSP(bf16_t, WS_HN) : DOP(bf16_t, DO_OG);
    LAS float* scal = (LAS float*)(lds + OFF_SC);
    for (int i = tid; i < NE * QS / 4; i += NTHR) ((LAS unsigned*)(lds + OFF_C))[i] = 0u;
    if (ML) for (int i = tid; i < 16 * VS / 4; i += NTHR) ((LAS unsigned*)(lds + OFF_V + ES * VS))[i] = (i < VS / 4) ? 0x3f803f80u : 0u;
    f32x4 accC[NDT][NET];
#pragma unroll
    for (int a = 0; a < NDT; ++a)
#pragma unroll
        for (int e = 0; e < NET; ++e) accC[a][e] = (f32x4){0.f, 0.f, 0.f, 0.f};
    u32x4 sq[QPT], sk[QPT], sv[VPT]; float ssc = 0.f;
#define STAGE_LOAD(c_) do { const size_t r0_ = (size_t)(c_) * 64; \
        _Pragma("unroll") for (int j = 0; j < QPT; ++j) { const int i = tid + NTHR * j, rr = i / (DK / 8), cc = i % (DK / 8); sq[j] = *(const u32x4*)(Qg + (r0_ + rr) * LDQ + cc * 8); sk[j] = *(const u32x4*)(Kg + (r0_ + rr) * LDQ + cc * 8); } \
        _Pragma("unroll") for (int j = 0; j < VPT; ++j) { const int i = tid + NTHR * j, rr = i >> 3, cc = i & 7; sv[j] = *(const u32x4*)(VTg + (size_t)rr * T + r0_ + cc * 8); } \
        if (ML) { if (tid < 320) ssc = SC[(size_t)((tid >> 6) == 3 ? 4 : ((tid >> 6) == 4 ? 3 : (tid >> 6))) * SC_STRIDE + r0_ + (tid & 63)]; } else if (tid < 128) ssc = EALg[(size_t)(c_) * GKW + tid]; } while (0)
#define STAGE_WRITE() do { \
        _Pragma("unroll") for (int j = 0; j < QPT; ++j) { const int i = tid + NTHR * j, rr = i / (DK / 8), cc = i % (DK / 8); *(LAS u32x4*)(lds + OFF_Q + rr * QS + cc * 16) = sq[j]; *(LAS u32x4*)(lds + OFF_K + rr * QS + cc * 16) = sk[j]; } \
        _Pragma("unroll") for (int j = 0; j < VPT; ++j) { const int i = tid + NTHR * j, rr = i >> 3, cc = i & 7; *(LAS u32x4*)(lds + OFF_V + rr * VS + cc * 16) = sv[j]; } \
        if (tid < (ML ? 320 : 128)) scal[tid] = ssc; } while (0)
    STAGE_LOAD(0); STAGE_WRITE(); LBAR();
    for (int c = 0; c < 32; ++c) {
        const size_t r0 = (size_t)c * 64;
        if (c + 1 < 32) STAGE_LOAD(c + 1);
        bf16x8 kt[NDT][2];
#pragma unroll
        for (int a = 0; a < NDT; ++a)
#pragma unroll
            for (int ks = 0; ks < 2; ++ks) kt[a][ks] = *(const bf16x8*)(KTg + (size_t)(16 * (NDT * w + a) + fr) * T + r0 + ks * 32 + 8 * fq);
        const int st = w & 3, tt0 = 2 * (w >> 2);
        f32x4 accS[2] = {(f32x4){0.f, 0.f, 0.f, 0.f}, (f32x4){0.f, 0.f, 0.f, 0.f}};
#pragma unroll
        for (int ks = 0; ks < KS; ++ks) { const bf16x8 af = *(const LAS bf16x8*)(lds + OFF_K + (16 * st + fr) * QS + ks * 64 + fq * 16);
#pragma unroll
            for (int j = 0; j < 2; ++j) { const bf16x8 bfr = *(const LAS bf16x8*)(lds + OFF_Q + (16 * (tt0 + j) + fr) * QS + ks * 64 + fq * 16); accS[j] = MFMA16(af, bfr, accS[j]); } }
#pragma unroll
        for (int j = 0; j < 2; ++j) { const int t = 16 * (tt0 + j) + fr, s0 = 16 * st + 4 * fq; float v[4];
#pragma unroll
            for (int r = 0; r < 4; ++r) { const int s = s0 + r; float x = accS[j][r]; if (ML) x *= __expf(scal[s] - scal[64 + t]); v[r] = (s <= t) ? x : 0.f; }
            u32x2 wv; wv.x = pk2(v[0], v[1]); wv.y = pk2(v[2], v[3]); *(LAS u32x2*)(lds + OFF_S + t * VS + s0 * 2) = wv; }
        f32x4 accO[TPW];
#pragma unroll
        for (int j = 0; j < TPW; ++j) { accO[j] = (f32x4){0.f, 0.f, 0.f, 0.f}; const int id = w + 8 * j;
            if (id < NT) { const int et = id >> 2, tt = id & 3;
#pragma unroll
                for (int ks = 0; ks < KS; ++ks) { const bf16x8 af = *(const LAS bf16x8*)(lds + OFF_C + (16 * et + fr) * QS + ks * 64 + fq * 16), bfr = *(const LAS bf16x8*)(lds + OFF_Q + (16 * tt + fr) * QS + ks * 64 + fq * 16);
                    accO[j] = MFMA16(af, bfr, accO[j]); } } }
        LBAR();
#pragma unroll
        for (int j = 0; j < TPW; ++j) { const int id = w + 8 * j;
            if (id < NT) { const int et = id >> 2, tt = id & 3, t = 16 * tt + fr;
                if (ML) accO[j] = accO[j] * scal[128 + t];
#pragma unroll
                for (int ks = 0; ks < 2; ++ks) { const bf16x8 af = *(const LAS bf16x8*)(lds + OFF_V + (16 * et + fr) * VS + ks * 64 + fq * 16), bfr = *(const LAS bf16x8*)(lds + OFF_S + t * VS + ks * 64 + fq * 16);
                    accO[j] = MFMA16(af, bfr, accO[j]); }
                const size_t grow = row0 + r0 + t;
                if (!ML || et < 4) { u32x2 wv; wv.x = pk2(accO[j][0], accO[j][1]); wv.y = pk2(accO[j][2], accO[j][3]); *(u32x2*)(OUT + grow * D + h * 256 + es * ES + 16 * et + 4 * fq) = wv; }
                else if (es == 0 && fq == 0) WSP(float, M_DEN)[grow * 4 + h] = fmaxf(fabsf(accO[j][0]), scal[192 + t]); } }
        if (ML) { const float dec = scal[128 + 63];
#pragma unroll
            for (int a = 0; a < NDT; ++a)
#pragma unroll
                for (int e = 0; e < NET; ++e) accC[a][e] = accC[a][e] * dec;
#pragma unroll
            for (int ks = 0; ks < 2; ++ks) { const f32x4 w0 = *(const LAS f32x4*)(scal + 256 + ks * 32 + 8 * fq), w1 = *(const LAS f32x4*)(scal + 256 + ks * 32 + 8 * fq + 4);
#pragma unroll
                for (int a = 0; a < NDT; ++a) { const u32x4 kw = __builtin_bit_cast(u32x4, kt[a][ks]); u32x4 o;
                    o.x = pk2(bflo(kw.x) * w0[0], bfhi(kw.x) * w0[1]); o.y = pk2(bflo(kw.y) * w0[2], bfhi(kw.y) * w0[3]); o.z = pk2(bflo(kw.z) * w1[0], bfhi(kw.z) * w1[1]); o.w = pk2(bflo(kw.w) * w1[2], bfhi(kw.w) * w1[3]);
                    kt[a][ks] = __builtin_bit_cast(bf16x8, o); } } }
#pragma unroll
        for (int ks = 0; ks < 2; ++ks)
#pragma unroll
            for (int e = 0; e < NET; ++e) { const bf16x8 bfr = *(const LAS bf16x8*)(lds + OFF_V + (16 * e + fr) * VS + ks * 64 + fq * 16);
#pragma unroll
                for (int a = 0; a < NDT; ++a) accC[a][e] = MFMA16(kt[a][ks], bfr, accC[a][e]); }
        if (!ML) {
#pragma unroll
            for (int a = 0; a < NDT; ++a) { const f32x4 ea = *(const LAS f32x4*)(scal + 16 * (NDT * w + a) + 4 * fq);
#pragma unroll
                for (int e = 0; e < NET; ++e) accC[a][e] = accC[a][e] * ea; } }
        LBAR();
#pragma unroll
        for (int a = 0; a < NDT; ++a)
#pragma unroll
            for (int e = 0; e < NET; ++e) { u32x2 wv; wv.x = pk2(accC[a][e][0], accC[a][e][1]); wv.y = pk2(accC[a][e][2], accC[a][e][3]);
                *(LAS u32x2*)(lds + OFF_C + (16 * e + fr) * QS + (16 * (NDT * w + a) + 4 * fq) * 2) = wv; }
        if (c + 1 < 32) STAGE_WRITE();
        LBAR();
    }
    if (ML) { float* Cp = p.out + O_CP + (size_t)(b * NH + h) * HD * HD; float* np = p.out + O_NP + (size_t)(b * NH + h) * HD;
#pragma unroll
        for (int a = 0; a < NDT; ++a) { const int d = 16 * (NDT * w + a) + 4 * fq;
#pragma unroll
            for (int e = 0; e < 4; ++e) *(f32x4*)(Cp + (size_t)(es * 64 + 16 * e + fr) * HD + d) = accC[a][e];
            if (es == 0 && fr == 0) *(f32x4*)(np + d) = accC[a][NET - 1]; }
    } else { float* Sp = p.out + O_SP + (size_t)(b * NH + h) * GDK * GDV;
#pragma unroll
        for (int a = 0; a < NDT; ++a)
#pragma unroll
            for (int e = 0; e < NET; ++e)
#pragma unroll
                for (int r = 0; r < 4; ++r) Sp[(size_t)(16 * (NDT * w + a) + 4 * fq + r) * GDV + es * 128 + 16 * e + fr] = accC[a][e][r]; }
#undef STAGE_LOAD
#undef STAGE_WRITE
    LBAR();
}
#define SBAR() __syncthreads()
__device__ __forceinline__ void sample_ml(const P& p, LAS unsigned char* lds, int seq, int h) {
    LAS float* qf = (LAS float*)lds; LAS float* kf = qf + 2048; LAS float* vf = kf + 2048; LAS float* n0s = vf + 2048; LAS float* sS = n0s + 256; LAS float* sc = sS + 64; LAS float* qn = sc + 40; LAS float* part = (LAS float*)(lds + 32768);
    int tid_ = threadIdx.x; asm volatile("" : "+v"(tid_));
    const int tid = tid_, w = __builtin_amdgcn_readfirstlane(tid >> 6), lane = tid & 63, fr = lane & 15, fq = lane >> 4;
    const size_t R0 = (size_t)T_P + (size_t)seq * 8, sh = (size_t)seq * NH + h;
    { const int t = tid >> 6, d4 = (tid & 63) * 4;
      const u32x2 qw = *(const u32x2*)(WSP(const bf16_t, A_Q) + (R0 + t) * D + h * 256 + d4), kw = *(const u32x2*)(WSP(const bf16_t, A_K) + (R0 + t) * D + h * 256 + d4);
      *(LAS f32x4*)(qf + t * 256 + d4) = (f32x4){bflo(qw.x), bfhi(qw.x), bflo(qw.y), bfhi(qw.y)}; *(LAS f32x4*)(kf + t * 256 + d4) = (f32x4){bflo(kw.x), bfhi(kw.x), bflo(kw.y), bfhi(kw.y)}; }
    if (tid < 256) { const u32x4 vw = *(const u32x4*)(WSP(const bf16_t, WS_VT) + (size_t)(h * 256 + tid) * T + R0);
        vf[0 * 256 + tid] = bflo(vw.x); vf[1 * 256 + tid] = bfhi(vw.x); vf[2 * 256 + tid] = bflo(vw.y); vf[3 * 256 + tid] = bfhi(vw.y); vf[4 * 256 + tid] = bflo(vw.z); vf[5 * 256 + tid] = bfhi(vw.z); vf[6 * 256 + tid] = bflo(vw.w); vf[7 * 256 + tid] = bfhi(vw.w);
        n0s[tid] = p.in[4][sh * HD + tid]; }
    if (tid < 40) sc[tid] = WSP(const float, M_SC)[(size_t)(tid >> 3) * SC_STRIDE + (size_t)h * T + R0 + (tid & 7)];
    SBAR();
    if (tid < 64) { const int t = tid >> 3, s = tid & 7; float dot = 0.f;
        for (int d = 0; d < 256; ++d) dot += qf[t * 256 + d] * kf[s * 256 + d];
        sS[tid] = (s <= t) ? dot * expf(sc[s] - sc[8 + t]) : 0.f; }
    else if (tid < 72) { const int t = tid - 64; float dot = 0.f; for (int d = 0; d < 256; ++d) dot += qf[t * 256 + d] * n0s[d]; qn[t] = dot; }
    SBAR();
    if (tid < 8) { float den = sc[16 + tid] * qn[tid]; for (int s = 0; s < 8; ++s) den += sS[tid * 8 + s]; WSP(float, M_DEN)[(R0 + tid) * 4 + h] = fmaxf(fabsf(den), sc[32 + tid]); }
    const int d0 = 32 * w + 8 * fq; const float dec = sc[16 + 7];
    float kr[8][8];
#pragma unroll
    for (int s = 0; s < 8; ++s) { const f32x4 k0 = *(const LAS f32x4*)(kf + s * 256 + d0), k1 = *(const LAS f32x4*)(kf + s * 256 + d0 + 4); const float ws_ = sc[24 + s];
        kr[s][0] = k0[0] * ws_; kr[s][1] = k0[1] * ws_; kr[s][2] = k0[2] * ws_; kr[s][3] = k0[3] * ws_; kr[s][4] = k1[0] * ws_; kr[s][5] = k1[1] * ws_; kr[s][6] = k1[2] * ws_; kr[s][7] = k1[3] * ws_; }
    bf16x8 qfrag; { u32x4 o = {0u, 0u, 0u, 0u}; if (fr < 8) { const f32x4 q0 = *(const LAS f32x4*)(qf + fr * 256 + d0), q1 = *(const LAS f32x4*)(qf + fr * 256 + d0 + 4);
        o.x = pk2(q0[0], q0[1]); o.y = pk2(q0[2], q0[3]); o.z = pk2(q1[0], q1[1]); o.w = pk2(q1[2], q1[3]); } qfrag = __builtin_bit_cast(bf16x8, o); }
    if (fr == 0) { float nn[8];
#pragma unroll
        for (int j = 0; j < 8; ++j) { float a = dec * n0s[d0 + j];
#pragma unroll
            for (int s = 0; s < 8; ++s) a += kr[s][j]; nn[j] = a; }
        float* no = p.out + O_NS + sh * HD + d0; *(f32x4*)no = (f32x4){nn[0], nn[1], nn[2], nn[3]}; *(f32x4*)(no + 4) = (f32x4){nn[4], nn[5], nn[6], nn[7]}; }
    const float* C0 = p.in[3] + sh * HD * HD; float* Cn = p.out + O_CS + sh * HD * HD;
#pragma unroll 4
    for (int strip = 0; strip < 16; ++strip) { const int e = 16 * strip + fr;
        const f32x4 c0 = *(const f32x4*)(C0 + (size_t)e * HD + d0), c1 = *(const f32x4*)(C0 + (size_t)e * HD + d0 + 4);
        float cn[8] = {c0[0] * dec, c0[1] * dec, c0[2] * dec, c0[3] * dec, c1[0] * dec, c1[1] * dec, c1[2] * dec, c1[3] * dec};
#pragma unroll
        for (int s = 0; s < 8; ++s) { const float vv = vf[s * 256 + e];
#pragma unroll
            for (int j = 0; j < 8; ++j) cn[j] += vv * kr[s][j]; }
        *(f32x4*)(Cn + (size_t)e * HD + d0) = (f32x4){cn[0], cn[1], cn[2], cn[3]}; *(f32x4*)(Cn + (size_t)e * HD + d0 + 4) = (f32x4){cn[4], cn[5], cn[6], cn[7]};
        u32x4 o; o.x = pk2(c0[0], c0[1]); o.y = pk2(c0[2], c0[3]); o.z = pk2(c1[0], c1[1]); o.w = pk2(c1[2], c1[3]);
        const f32x4 acc = MFMA16(__builtin_bit_cast(bf16x8, o), qfrag, ((f32x4){0.f, 0.f, 0.f, 0.f}));
        if (fr < 8) {
#pragma unroll
            for (int r = 0; r < 4; ++r) part[(size_t)(w * 256 + 16 * strip + 4 * fq + r) * 8 + fr] = acc[r]; } }
    SBAR();
    { const int t = tid >> 6, e4 = (tid & 63) * 4; float o4[4];
#pragma unroll
      for (int i = 0; i < 4; ++i) { float qc = 0.f;
#pragma unroll
          for (int ww = 0; ww < 8; ++ww) qc += part[(size_t)(ww * 256 + e4 + i) * 8 + t];
          float a = sc[16 + t] * qc;
#pragma unroll
          for (int s = 0; s < 8; ++s) a += sS[t * 8 + s] * vf[s * 256 + e4 + i];
          o4[i] = a; }
      u32x2 wv; wv.x = pk2(o4[0], o4[1]); wv.y = pk2(o4[2], o4[3]); *(u32x2*)(WSP(bf16_t, WS_HN) + (R0 + t) * D + h * 256 + e4) = wv; }
    SBAR();
}
__device__ __forceinline__ void sample_gla(const P& p, LAS unsigned char* lds, int seq, int h) {
    LAS float* qf = (LAS float*)lds; LAS float* kf = qf + 1024; LAS float* vf = kf + 1024; LAS float* eal = vf + 2048; LAS float* att = eal + 128; LAS float* part = (LAS float*)(lds + 32768);
    int tid_ = threadIdx.x; asm volatile("" : "+v"(tid_));
    const int tid = tid_, w = __builtin_amdgcn_readfirstlane(tid >> 6), lane = tid & 63;
    const size_t R0 = (size_t)T_P + (size_t)seq * 8, sh = (size_t)seq * NH + h;
    { const int t = tid >> 6, d2 = (tid & 63) * 2;
      const unsigned qw = *(const unsigned*)(WSP(const bf16_t, A_QT) + (R0 + t) * GKW + h * 128 + d2), kw = *(const unsigned*)(WSP(const bf16_t, G_KT) + (R0 + t) * GKW + h * 128 + d2);
      qf[t * 128 + d2] = bflo(qw); qf[t * 128 + d2 + 1] = bfhi(qw); kf[t * 128 + d2] = bflo(kw); kf[t * 128 + d2 + 1] = bfhi(kw); }
    if (tid < 256) { const u32x4 vw = *(const u32x4*)(WSP(const bf16_t, WS_VT) + (size_t)(1024 + h * 256 + tid) * T + R0);
        vf[0 * 256 + tid] = bflo(vw.x); vf[1 * 256 + tid] = bfhi(vw.x); vf[2 * 256 + tid] = bflo(vw.y); vf[3 * 256 + tid] = bfhi(vw.y); vf[4 * 256 + tid] = bflo(vw.z); vf[5 * 256 + tid] = bfhi(vw.z); vf[6 * 256 + tid] = bflo(vw.w); vf[7 * 256 + tid] = bfhi(vw.w); }
    else if (tid < 384) eal[tid - 256] = WSP(const float, M_EAL)[(size_t)(256 + seq) * GKW + h * 128 + (tid - 256)];
    SBAR();
    if (tid < 64) { const int t = tid >> 3, s = tid & 7; float dot = 0.f; for (int d = 0; d < 128; ++d) dot += qf[t * 128 + d] * kf[s * 128 + d]; att[tid] = (s <= t) ? dot : 0.f; }
    const int e4 = 4 * lane;
    f32x4 vr[8], ai[8];
#pragma unroll
    for (int s = 0; s < 8; ++s) { vr[s] = *(const LAS f32x4*)(vf + s * 256 + e4); ai[s] = (f32x4){0.f, 0.f, 0.f, 0.f}; }
    const float* S0 = p.in[6] + sh * GDK * GDV; float* Sn = p.out + O_SS + sh * GDK * GDV;
#pragma unroll 4
    for (int dd = 0; dd < 16; ++dd) { const int d = 16 * w + dd;
        const f32x4 s0 = *(const f32x4*)(S0 + (size_t)d * GDV + e4); f32x4 up = s0;
#pragma unroll
        for (int s = 0; s < 8; ++s) { up += vr[s] * kf[s * 128 + d]; ai[s] += s0 * qf[s * 128 + d]; }
        *(f32x4*)(Sn + (size_t)d * GDV + e4) = up * eal[d]; }
#pragma unroll
    for (int t = 0; t < 8; ++t) *(LAS f32x4*)(part + (size_t)(w * 8 + t) * 256 + e4) = ai[t];
    SBAR();
    { const int t = tid >> 6; f32x4 o = {0.f, 0.f, 0.f, 0.f};
#pragma unroll
      for (int ww = 0; ww < 8; ++ww) o += *(const LAS f32x4*)(part + (size_t)(ww * 8 + t) * 256 + e4);
#pragma unroll
      for (int s = 0; s < 8; ++s) o += *(const LAS f32x4*)(vf + s * 256 + e4) * att[t * 8 + s];
      u32x2 wv; wv.x = pk2(o[0], o[1]); wv.y = pk2(o[2], o[3]); *(u32x2*)(DOP(bf16_t, DO_OG) + (R0 + t) * D + h * 256 + e4) = wv; }
    SBAR();
}
#ifndef MK_SCAN_PARTS
#define MK_SCAN_PARTS 3
#endif
__device__ __forceinline__ void p5_scan(const P& p, LAS unsigned char* lds, int bid, int G, unsigned* counter, int parts) {
    if (parts & 1) for (int it = bid; it < 192; it += G) {
        if (it < 128) scan_prompt<true>(p, lds, it >> 4, (it >> 2) & 3, it & 3);
        else { const int i = it - 128; scan_prompt<false>(p, lds, i >> 3, (i >> 1) & 3, i & 1); }
    }
    LAS int* slot = (LAS int*)(lds + 140 * 1024);
    if (parts & 2) for (;;) {
        if (threadIdx.x == 0) *slot = (int)atomicAdd(counter, 1u);
        SBAR();
        const int it = *slot;
        SBAR();
        if (it >= 1024) break;
        if (it < 512) sample_ml(p, lds, it >> 2, it & 3); else sample_gla(p, lds, (it - 512) >> 2, it & 3);
    }
}
__device__ __forceinline__ void p5b_norm(const P& p, int gw, int NGW, int lane) {
    const bf16_t* HN = WSP(const bf16_t, WS_HN); const bf16_t* OG = DOP(const bf16_t, DO_OG); const bf16_t* SIGO = WSP(const bf16_t, S_SIGO); const bf16_t* SILUR = WSP(const bf16_t, S_SILUR);
    bf16_t* HM = WSP(bf16_t, A_Q); bf16_t* OGN = WSP(bf16_t, A_K); const float* DEN = WSP(const float, M_DEN);
    const int h = lane >> 4, c0 = h * 256 + (lane & 15) * 16;
    float gm[16], gg[16];
#pragma unroll
    for (int i = 0; i < 16; ++i) { gm[i] = p.in[17][c0 + i]; gg[i] = p.in[20][c0 + i]; }
#pragma unroll 2
    for (int row = gw; row < T; row += NGW) {
#pragma unroll
        for (int br = 0; br < 2; ++br) {
            const bf16_t* src = (br == 0 ? HN : OG) + (size_t)row * D + c0; const bf16_t* gsrc = (br == 0 ? SIGO : SILUR) + (size_t)row * D + c0;
            const u32x4 a = *(const u32x4*)src, b = *(const u32x4*)(src + 8), ga = *(const u32x4*)gsrc, gb = *(const u32x4*)(gsrc + 8);
            float v[16] = {bflo(a.x), bfhi(a.x), bflo(a.y), bfhi(a.y), bflo(a.z), bfhi(a.z), bflo(a.w), bfhi(a.w), bflo(b.x), bfhi(b.x), bflo(b.y), bfhi(b.y), bflo(b.z), bfhi(b.z), bflo(b.w), bfhi(b.w)};
            float gt[16] = {bflo(ga.x), bfhi(ga.x), bflo(ga.y), bfhi(ga.y), bflo(ga.z), bfhi(ga.z), bflo(ga.w), bfhi(ga.w), bflo(gb.x), bfhi(gb.x), bflo(gb.y), bfhi(gb.y), bflo(gb.z), bfhi(gb.z), bflo(gb.w), bfhi(gb.w)};
            float ss = 0.f;
#pragma unroll
            for (int i = 0; i < 16; ++i) ss += v[i] * v[i];
            ss += __shfl_xor(ss, 1); ss += __shfl_xor(ss, 2); ss += __shfl_xor(ss, 4); ss += __shfl_xor(ss, 8);
            float extra = EPS; if (br == 0) { const float dn = DEN[(size_t)row * 4 + h]; extra = EPS * dn * dn; }
            const float sc = 1.f / sqrtf(ss * (1.f / 256.f) + extra);
            unsigned o[8];
#pragma unroll
            for (int i = 0; i < 8; ++i) { const float g0 = br == 0 ? gm[2 * i] : gg[2 * i], g1 = br == 0 ? gm[2 * i + 1] : gg[2 * i + 1]; o[i] = pk2(gt[2 * i] * g0 * v[2 * i] * sc, gt[2 * i + 1] * g1 * v[2 * i + 1] * sc); }
            bf16_t* dst = (br == 0 ? HM : OGN) + (size_t)row * D + c0;
            *(u32x4*)dst = (u32x4){o[0], o[1], o[2], o[3]}; *(u32x4*)(dst + 8) = (u32x4){o[4], o[5], o[6], o[7]};
        }
    }
}
__device__ __forceinline__ void p10_final(const P& p, int gw, int NGW, int lane) {
    const f32x4* g4 = (const f32x4*)p.in[27] + lane; f32x4 g[4];
#pragma unroll
    for (int j = 0; j < 4; ++j) g[j] = g4[64 * j];
#pragma unroll 2
    for (int row = gw; row < T; row += NGW) {
        f32x4* xr = (f32x4*)(p.out + (size_t)row * D) + lane; f32x4 v[4]; float s = 0.f;
#pragma unroll
        for (int j = 0; j < 4; ++j) { v[j] = xr[64 * j]; s += (v[j].x * v[j].x + v[j].y * v[j].y) + (v[j].z * v[j].z + v[j].w * v[j].w); }
        const float rs = 1.f / sqrtf(wave_sum(s) * (1.f / D) + EPS);
#pragma unroll
        for (int j = 0; j < 4; ++j) xr[64 * j] = v[j] * rs * g[j];
    }
}
constexpr int LDS_BYTES = 147456;
constexpr int CW_CNT = 64;
constexpr int CW_BAR = 1024;
constexpr int CTL_ZERO_BYTES = 32768;
#ifndef MK_PH_LO
#define MK_PH_LO 0
#endif
#ifndef MK_PH_HI
#define MK_PH_HI 99
#endif
#ifndef MK_REP
#define MK_REP 0
#endif
__global__ void __launch_bounds__(NTHR, 2) mk_fwd(P p) {
    cg::grid_group grid = cg::this_grid();
    extern __shared__ __attribute__((aligned(16))) unsigned char lds_raw[];
    LAS unsigned char* lds = (LAS unsigned char*)lds_raw;
    const int bid = blockIdx.x, G = gridDim.x, NGW = G * NWAVES; const size_t gsz = (size_t)G * NTHR;
    if (threadIdx.x < 4) ((LAS unsigned*)(lds + 140 * 1024 + 16))[threadIdx.x] = 0u;
    __syncthreads();
    const XcdBarrier xbar = xcd_barrier_post((unsigned*)(p.ws + WS_CTL) + CW_BAR, (volatile LAS unsigned*)(lds + 140 * 1024 + 16));
#define GRID_BAR() xcd_barrier(xbar)
#define TIDX() int tid = threadIdx.x; asm volatile("" : "+v"(tid)); const int lane = tid & 63, wave = __builtin_amdgcn_readfirstlane(tid >> 6), gw = bid * NWAVES + wave; const size_t gtid = (size_t)bid * NTHR + tid; (void)lane; (void)gw; (void)gtid
    float* SSQ = WSP(float, M_SSQ); float* XRES = p.out;
    bf16_t* XBF = WSP(bf16_t, WS_XBF); bf16_t* ACT = WSP(bf16_t, WS_ACT);
    constexpr int NM = T / 256;
#define PH(k) (MK_PH_LO <= (k) && (k) <= MK_PH_HI)
#define PHASE_BEGIN(k) _Pragma("nounroll") for (int rep_ = 0; rep_ <= ((MK_REP >> (k)) & 1); ++rep_) { if (rep_) GRID_BAR(); if (PH(k)) {
#define PHASE_END } }
    PHASE_BEGIN(0) TIDX(); p0_prologue(p, lds, gw, NGW, wave, lane); PHASE_END
    grid.sync();
    PHASE_BEGIN(1) pg8::Gemm g{XBF, WSP(bf16_t, W_UP1), nullptr, nullptr, D, D, D, 0, 0}; pg8::Sched S; S.init(NM, 2 * FF / 256, 1, 0, 0, 0, G, bid);
        EpiUp E{SSQ, ACT}; pg8::gemm_phase(lds, g, S, E); PHASE_END
    GRID_BAR();
    PHASE_BEGIN(2) pg8::Gemm g{ACT, WSP(bf16_t, W_DN1), nullptr, nullptr, FF, FF, FF, 0, 0}; pg8::Sched S; S.init(NM, D / 256, 1, 0, 0, 0, G, bid);
        EpiRes<0> E{XBF, XRES, SSQ, 0.5f}; pg8::gemm_phase(lds, g, S, E); PHASE_END
    GRID_BAR();
    PHASE_BEGIN(3) const bf16_t* Wi = WSP(bf16_t, W_IN); pg8::Gemm g{XBF, Wi, Wi + (size_t)6400 * D, XBF, D, D, D, 0, 0}; pg8::Sched S; S.init(NM, 25, 1, 8, NM, 1, G, bid);
        EpiIn E{SSQ, DOP(bf16_t, DO_U), WSP(bf16_t, S_SIGO), DOP(bf16_t, DO_QG), DOP(bf16_t, DO_KG), WSP(bf16_t, S_SILUR), WSP(bf16_t, S_SIGA), WSP(bf16_t, S_SIGB), WSP(bf16_t, WS_VT), WSP(float, M_GATES)};
        pg8::gemm_phase(lds, g, S, E); PHASE_END
    GRID_BAR();
    PHASE_BEGIN(4) TIDX(); p4_gates(p, lds, bid, tid); p4_gla(p, bid, G, tid); { const int ncb = G > 32 ? G - 16 : G; if (bid < ncb) p4_conv(p, gtid, (size_t)ncb * NTHR); } PHASE_END
    GRID_BAR();
    PHASE_BEGIN(5) const bf16_t* Wqk = WSP(bf16_t, W_QK); const bf16_t* CH = DOP(bf16_t, DO_CH); pg8::Gemm g{CH, Wqk, Wqk + (size_t)256 * D, CH, D, D, 256, 256, 256}; pg8::Sched S; S.init(NM, 2, 4, 1, NM, 4, G, bid);
        EpiQK E{WSP(bf16_t, A_Q), WSP(bf16_t, A_K), WSP(bf16_t, WS_KT)}; pg8::gemm_phase(lds, g, S, E); PHASE_END
    GRID_BAR();
    PHASE_BEGIN(6) p5_scan(p, lds, bid, G, (unsigned*)(p.ws + WS_CTL) + CW_CNT + rep_, rep_ ? MK_SCAN_PARTS : 3); PHASE_END
    GRID_BAR();
    PHASE_BEGIN(7) TIDX(); p5b_norm(p, gw, NGW, lane); PHASE_END
    GRID_BAR();
    PHASE_BEGIN(8) pg8::Sched S; S.init(NM, D / 256, 1, 0, 0, 0, G, bid); float* YT = WSP(float, WS_VT); bf16_t* Y = WSP(bf16_t, WS_KT);
        { pg8::Gemm g{WSP(bf16_t, A_Q), WSP(bf16_t, W_PA), nullptr, nullptr, D, D, D, 0, 0}; EpiMerge<0> E{WSP(bf16_t, S_SIGA), YT, Y}; pg8::gemm_phase(lds, g, S, E); }
        { pg8::Gemm g{WSP(bf16_t, A_K), WSP(bf16_t, W_PB), nullptr, nullptr, D, D, D, 0, 0}; EpiMerge<1> E{WSP(bf16_t, S_SIGB), YT, Y}; pg8::gemm_phase(lds, g, S, E); } PHASE_END
    GRID_BAR();
    PHASE_BEGIN(9) pg8::Gemm g{WSP(bf16_t, WS_KT), WSP(bf16_t, W_O), nullptr, nullptr, D, D, D, 0, 0}; pg8::Sched S; S.init(NM, D / 256, 1, 0, 0, 0, G, bid);
        EpiRes<0> E{XBF, XRES, SSQ, 1.0f}; pg8::gemm_phase(lds, g, S, E); PHASE_END
    GRID_BAR();
    PHASE_BEGIN(10) pg8::Gemm g{XBF, WSP(bf16_t, W_UP2), nullptr, nullptr, D, D, D, 0, 0}; pg8::Sched S; S.init(NM, 2 * FF / 256, 1, 0, 0, 0, G, bid);
        EpiUp E{SSQ, ACT}; pg8::gemm_phase(lds, g, S, E); PHASE_END
    GRID_BAR();
    PHASE_BEGIN(11) pg8::Gemm g{ACT, WSP(bf16_t, W_DN2), nullptr, nullptr, FF, FF, FF, 0, 0}; pg8::Sched S; S.init(NM, D / 256, 1, 0, 0, 0, G, bid);
        EpiRes<1> E{XBF, XRES, SSQ, 0.5f}; pg8::gemm_phase(lds, g, S, E); PHASE_END
    GRID_BAR();
#ifdef MK_EXTRA_SYNCS
    for (int i_ = 0; i_ < MK_EXTRA_SYNCS; ++i_) GRID_BAR();
#endif
    PHASE_BEGIN(12) TIDX(); p10_final(p, gw, NGW, lane); PHASE_END
#undef PH
#undef TIDX
#undef PHASE_BEGIN
#undef PHASE_END
#undef GRID_BAR
}
}

static int mk_launch(void* const* d_in, const int* in_sizes, int n_in, void* d_out, int out_size, void* d_ws, size_t ws_size, hipStream_t stream) {
    static int grid = 0;
    if (grid == 0) {
        if (n_in != 28 || (size_t)out_size != mk::O_END || ws_size < mk::WS_END) { fprintf(stderr, "kernel_launch: built for 28 inputs, %zu outputs, >= %zu bytes of workspace; got n_in %d, out %d, ws %zu; nothing launched\n", (size_t)mk::O_END, (size_t)mk::WS_END, n_in, out_size, ws_size); grid = -1; return -1; }
        int dev = 0, cus = 0, per_cu = 0;
        if (hipGetDevice(&dev) != hipSuccess || hipDeviceGetAttribute(&cus, hipDeviceAttributeMultiprocessorCount, dev) != hipSuccess) { grid = -1; return -1; }
        if (hipFuncSetAttribute((const void*)mk::mk_fwd, hipFuncAttributeMaxDynamicSharedMemorySize, mk::LDS_BYTES) != hipSuccess) { fprintf(stderr, "kernel_launch: hipFuncSetAttribute failed\n"); grid = -1; return -1; }
        if (hipOccupancyMaxActiveBlocksPerMultiprocessor(&per_cu, (const void*)mk::mk_fwd, mk::NTHR, mk::LDS_BYTES) != hipSuccess || per_cu < 1) { fprintf(stderr, "kernel_launch: occupancy query reports %d blocks per CU\n", per_cu); grid = -1; (void)hipGetLastError(); return -1; }
        grid = cus;
    }
    if (grid < 0) return -1;
    if (hipMemsetAsync((char*)d_ws + mk::WS_CTL, 0, mk::CTL_ZERO_BYTES, stream) != hipSuccess) return -1;
    mk::P prm{}; for (int i = 0; i < 28; ++i) prm.in[i] = (const float*)d_in[i]; prm.out = (float*)d_out; prm.ws = (unsigned char*)d_ws;
    void* args[] = {&prm};
    const hipError_t e = hipLaunchCooperativeKernel((const void*)mk::mk_fwd, dim3(grid), dim3(mk::NTHR), args, mk::LDS_BYTES, stream);
    if (e != hipSuccess) { fprintf(stderr, "cooperative launch failed: %s (grid %d)\n", hipGetErrorString(e), grid); return -1; }
    return 0;
}
extern "C" void kernel_launch(void* const* d_in, const int* in_sizes, int n_in, void* d_out, int out_size, void* d_ws, size_t ws_size, hipStream_t stream) {
    (void)mk_launch(d_in, in_sizes, n_in, d_out, out_size, d_ws, ws_size, stream);
}
```

```cpp
#include <hip/hip_runtime.h>
#include <cstdio>
#include <cstdint>
#include <hip/hip_cooperative_groups.h>
namespace cg = cooperative_groups;
namespace mk {
#define LAS __attribute__((address_space(3)))
#define GAS __attribute__((address_space(1)))
typedef unsigned short bf16_t;
typedef short bf16x8 __attribute__((ext_vector_type(8)));
typedef float f32x4 __attribute__((ext_vector_type(4)));
typedef float f32x2 __attribute__((ext_vector_type(2)));
typedef unsigned u32x4 __attribute__((ext_vector_type(4)));
typedef unsigned u32x2 __attribute__((ext_vector_type(2)));

constexpr int D = 1024, FF = 2816, T_P = 16384, T_S = 1024, T = T_P + T_S, SEQ = 2048, NB = 8, DEC_B = 128, DEC_T = 8;
constexpr int NH = 4, HD = 256, GDK = 128, GDV = 256, GKW = 512, INW = 8216;
constexpr int NWAVES = 8, NTHR = 512;
constexpr float EPS = 1e-6f;
constexpr int NCH_P = T_P / 64;
constexpr int NGRP = T / 64;

__device__ __forceinline__ unsigned f2bf(float f) { unsigned u = __builtin_bit_cast(unsigned, f); return (u + 0x7fffu + ((u >> 16) & 1u)) >> 16; }
typedef __bf16 bf16x2n __attribute__((ext_vector_type(2)));
__device__ __forceinline__ unsigned pk2(float lo, float hi) { const f32x2 v = {lo, hi}; return __builtin_bit_cast(unsigned, __builtin_convertvector(v, bf16x2n)); }
__device__ __forceinline__ float bf2f(unsigned short b) { return __builtin_bit_cast(float, (unsigned)b << 16); }
__device__ __forceinline__ float bflo(unsigned w) { return __builtin_bit_cast(float, w << 16); }
__device__ __forceinline__ float bfhi(unsigned w) { return __builtin_bit_cast(float, w & 0xffff0000u); }
__device__ __forceinline__ float sigmoid_(float x) { return 1.f / (1.f + __expf(-x)); }
__device__ __forceinline__ float silu_(float x) { return x / (1.f + __expf(-x)); }
__device__ __forceinline__ float logsigmoid_(float x) { return fminf(x, 0.f) - log1pf(expf(-fabsf(x))); }
__device__ __forceinline__ float wave_sum(float v) {
#pragma unroll
    for (int o = 1; o < 64; o <<= 1) v += __shfl_xor(v, o);
    return v;
}

#define XB_TMO      128
#define XB_XCNT(j)  (256  + 64 * (j))
#define XB_XSUB(j)  (1280 + 64 * (j))
#define XB_XGEN(j)  (2304 + 64 * (j))
#define XB_TOP      3328
#define XB_TOPGEN   3392
#define XCD_BAR_WORDS 3456
#define XB_SPIN_CAP (1u << 18)
__device__ __forceinline__ unsigned xb_ld(unsigned* p)              { return __hip_atomic_load(p, __ATOMIC_RELAXED, __HIP_MEMORY_SCOPE_AGENT); }
__device__ __forceinline__ unsigned xb_add(unsigned* p, unsigned v) { return __hip_atomic_fetch_add(p, v, __ATOMIC_RELAXED, __HIP_MEMORY_SCOPE_AGENT); }
__device__ __forceinline__ unsigned xb_xcc_id() { return (unsigned)__builtin_amdgcn_s_getreg((3 << 11) | 20) & 0xFu; }
#define XB_SPIN(cond, bar) do { unsigned _sp = 0; while (cond) { __builtin_amdgcn_s_sleep(1); \
    if ((++_sp & 255u) == 0u) { if (xb_ld(&(bar)[XB_TMO])) break; if (_sp > XB_SPIN_CAP) { atomicAdd(&(bar)[XB_TMO], 1u); break; } } } } while (0)
struct XcdBarrier { unsigned* bar; unsigned x; volatile LAS unsigned* st; };
__device__ __forceinline__ XcdBarrier xcd_barrier_post(unsigned* bar, volatile LAS unsigned* st) {
    XcdBarrier b; b.bar = bar; b.x = xb_xcc_id(); b.st = st;
    if (threadIdx.x == 0) (void)xb_add(&bar[XB_XCNT(b.x)], 1u);
    return b;
}
__device__ __forceinline__ void xcd_barrier_complete(unsigned* bar, unsigned x, unsigned& nloc, unsigned& nx) {
    const unsigned G = gridDim.x * gridDim.y * gridDim.z;
    unsigned sum, cnt, mine, sp = 0u;
    for (;;) {
        sum = 0u; cnt = 0u; mine = 0u;
#pragma unroll
        for (unsigned j = 0; j < 16; ++j) { const unsigned c = xb_ld(&bar[XB_XCNT(j)]); sum += c; cnt += (c > 0u) ? 1u : 0u; mine = (j == x) ? c : mine; }
        if (sum == G) break;
        __builtin_amdgcn_s_sleep(1);
        if ((++sp & 255u) == 0u) { if (xb_ld(&bar[XB_TMO])) break; if (sp > XB_SPIN_CAP) { atomicAdd(&bar[XB_TMO], 1u); break; } }
    }
    nloc = mine > 0u ? mine : 1u; nx = cnt > 0u ? cnt : 1u;
}
__device__ __forceinline__ void xcd_barrier(const XcdBarrier& b) {
    asm volatile("s_waitcnt vmcnt(0)" ::: "memory");
    __syncthreads();
    if (threadIdx.x == 0) {
        unsigned* bar = b.bar;
        __builtin_amdgcn_s_waitcnt(0);
        unsigned nloc = b.st[0], nx = b.st[1];
        if (nloc == 0u) { xcd_barrier_complete(bar, b.x, nloc, nx); b.st[0] = nloc; b.st[1] = nx; }
        const unsigned old = xb_add(&bar[XB_XSUB(b.x)], 1u);
        const unsigned gen = old / nloc;
        if (old + 1u == (gen + 1u) * nloc) {
            __builtin_amdgcn_fence(__ATOMIC_RELEASE, "agent");
            asm volatile("s_waitcnt vmcnt(0)" ::: "memory");
            const unsigned og = xb_add(&bar[XB_TOP], 1u);
            const unsigned tg = og / nx;
            if (og + 1u == (tg + 1u) * nx) xb_add(&bar[XB_TOPGEN], 1u);
            else XB_SPIN(xb_ld(&bar[XB_TOPGEN]) == tg, bar);
            __builtin_amdgcn_fence(__ATOMIC_ACQUIRE, "agent");
            xb_add(&bar[XB_XGEN(b.x)], 1u);
            asm volatile("s_waitcnt vmcnt(0)" ::: "memory");
        } else {
            XB_SPIN(xb_ld(&bar[XB_XGEN(b.x)]) == gen, bar);
            __builtin_amdgcn_fence(__ATOMIC_ACQUIRE, "agent");
            asm volatile("s_waitcnt vmcnt(0)" ::: "memory");
        }
    }
    __syncthreads();
}

namespace pg8 {
constexpr int BM = 256, BK = 64, HALF = 128, HTB = HALF * BK * 2, STAGE_BYTES = 8 * HTB, NXCD = 8, WGM = 8;
__host__ __device__ __forceinline__ int lds_byte(int r, int c) { const int st = (r >> 4) * 2 + (c >> 5), rr = r & 15, cc = c & 31, ob = rr * 64 + cc * 2; return st * 1024 + (ob ^ (((ob >> 9) & 1) << 5)); }
__host__ __device__ __forceinline__ void stage_rc(int b, int& R, int& C) { const int st = b / 1024, sb = b % 1024, swz = sb ^ (((sb >> 9) & 1) << 5); R = (st >> 1) * 16 + swz / 64; C = (st & 1) * 32 + (swz % 64) / 2; }
__host__ __device__ __forceinline__ int perm32(int rho) { const int n = rho >> 4, i = rho & 15; return 8 * (i >> 2) + 4 * n + (i & 3); }

struct Unit { int pm, pn, seg, z; };
struct Gemm { const bf16_t* A0; const bf16_t* B0; const bf16_t* A1; const bf16_t* B1; int lda, ldb, K, zA, zB; };
struct Sched {
    int nM0, nN0, nM1, nN1, n0, ntot, G, c;
    __device__ void init(int nM0_, int nN0_, int nz0, int nM1_, int nN1_, int nz1, int G_, int c_) { nM0 = nM0_; nN0 = nN0_; nM1 = nM1_; nN1 = nN1_; n0 = nM0 * nN0 * nz0; ntot = n0 + nM1 * nN1 * nz1; G = G_; c = c_; }
    __device__ bool next(int i, Unit& u) const {
        int L = i * G + c; if (L >= ntot) return false;
        int nM = nM0, nN = nN0; u.seg = 0; if (L >= n0) { L -= n0; nM = nM1; nN = nN1; u.seg = 1; }
        const int nwg = nM * nN; u.z = L / nwg; int wgid = L - u.z * nwg;
        { const int q = nwg / NXCD, r = nwg % NXCD, xcd = wgid % NXCD, off = wgid / NXCD; wgid = (xcd < r ? xcd * (q + 1) : r * (q + 1) + (xcd - r) * q) + off; }
        const int nig = WGM * nN, gid = wgid / nig, fm = gid * WGM, gsz = (nM - fm) < WGM ? (nM - fm) : WGM;
        u.pm = fm + ((wgid % nig) % gsz); u.pn = (wgid % nig) / gsz; return true;
    }
};
template <class Epi>
__device__ __forceinline__ void gemm_phase(LAS unsigned char* lds, const Gemm g, const Sched& S, const Epi& E) {
    int tid_ = threadIdx.x; asm volatile("" : "+v"(tid_));
    const int tid = tid_, wid = __builtin_amdgcn_readfirstlane(tid >> 6), lane = tid & 63, wr = wid >> 2, wc = wid & 3, fr = lane & 15, fq = lane >> 4;
    int K_ = g.K; asm volatile("" : "+s"(K_));
    const int K = K_, nt = K / BK;
    unsigned voffA[2], voffB[2];
#pragma unroll
    for (int i = 0; i < 2; ++i) { int R, C; stage_rc(tid * 16 + i * 8192, R, C); const int Rb = (R & ~31) + perm32(R & 31);
        voffA[i] = (unsigned)(R * g.lda + C) * 2u; voffB[i] = (unsigned)(Rb * g.ldb + C) * 2u; }
    const size_t kstep = (size_t)(BK * 2);
    const size_t hstepA = (size_t)HALF * g.lda * 2, hstepB = (size_t)HALF * g.ldb * 2;
    const unsigned ldsw = (unsigned)wid * 1024u;
    const int aoff = lds_byte(wr * 64 + fr, fq * 8), boff = lds_byte(wc * 32 + fr, fq * 8);
#define PG8_SA(b, h) (((b) * 2 + (h)) * HTB)
#define PG8_SB(b, h) ((4 + (b) * 2 + (h)) * HTB)
#define PG8_STAGE(bufoff, gbase, voff) do { _Pragma("unroll") for (int _i = 0; _i < 2; ++_i) \
        __builtin_amdgcn_global_load_lds((const unsigned*)((const char*)(gbase) + (voff)[_i]), (LAS unsigned*)(lds + (bufoff) + ldsw + _i * 8192), 16, 0, 0); } while (0)
#define PG8_LDA(dst, b, h) do { _Pragma("unroll") for (int m = 0; m < 4; ++m) _Pragma("unroll") for (int k = 0; k < 2; ++k) dst[m][k] = *(const LAS bf16x8*)(lds + PG8_SA(b, h) + aoff + m * 2048 + k * 1024); } while (0)
#define PG8_LDB(dst, b, h) do { _Pragma("unroll") for (int n = 0; n < 2; ++n) _Pragma("unroll") for (int k = 0; k < 2; ++k) dst[n][k] = *(const LAS bf16x8*)(lds + PG8_SB(b, h) + boff + n * 2048 + k * 1024); } while (0)
#define PG8_MMA(ai, bj, At, Bt) do { __builtin_amdgcn_s_setprio(1); _Pragma("unroll") for (int m = 0; m < 4; ++m) _Pragma("unroll") for (int n = 0; n < 2; ++n) _Pragma("unroll") for (int k = 0; k < 2; ++k) \
        acc[ai][bj][m][n] = __builtin_amdgcn_mfma_f32_16x16x32_bf16(Bt[n][k], At[m][k], acc[ai][bj][m][n], 0, 0, 0); __builtin_amdgcn_s_setprio(0); } while (0)
#define PG8_WAIT_V(n) asm volatile("s_waitcnt vmcnt(" #n ")" ::: "memory")
#define PG8_WAIT_L(n) asm volatile("s_waitcnt lgkmcnt(" #n ")" ::: "memory")
#define PG8_BAR __builtin_amdgcn_s_barrier()
#define PG8_SCHED __builtin_amdgcn_sched_barrier(0)
#define PG8_ABASE(u) ((const char*)((u).seg ? g.A1 : g.A0) + ((size_t)(u).z * g.zA) * 2 + (size_t)(u).pm * 2 * hstepA)
#define PG8_BBASE(u) ((const char*)((u).seg ? g.B1 : g.B0) + ((size_t)(u).z * g.zB) * 2 + (size_t)(u).pn * 2 * hstepB)
    Unit cur, nxt; int ui = 0;
    if (!S.next(0, cur)) return;
    f32x4 acc[2][2][4][2];
#pragma unroll
    for (int a = 0; a < 2; ++a)
#pragma unroll
        for (int b = 0; b < 2; ++b)
#pragma unroll
            for (int m = 0; m < 4; ++m)
#pragma unroll
                for (int n = 0; n < 2; ++n) acc[a][b][m][n] = (f32x4){0.f, 0.f, 0.f, 0.f};
    bf16x8 At[4][2], B0[2][2], B1[2][2];
    const char* cA = PG8_ABASE(cur); const char* cB = PG8_BBASE(cur);
    PG8_STAGE(PG8_SB(0, 0), cB, voffB); PG8_STAGE(PG8_SB(0, 1), cB + hstepB, voffB); PG8_STAGE(PG8_SA(0, 0), cA, voffA); PG8_STAGE(PG8_SA(0, 1), cA + hstepA, voffA);
    if (wr == 1) PG8_BAR;
    PG8_WAIT_V(2); PG8_BAR;
    PG8_STAGE(PG8_SB(1, 0), cB + kstep, voffB); PG8_STAGE(PG8_SA(1, 0), cA + kstep, voffA); PG8_STAGE(PG8_SB(1, 1), cB + hstepB + kstep, voffB);
    PG8_WAIT_V(6); PG8_BAR;
    for (;;) {
        const bool has_next = S.next(ui + 1, nxt);
        const char* nA = has_next ? PG8_ABASE(nxt) : cA; const char* nB = has_next ? PG8_BBASE(nxt) : cB;
#ifndef MK_KLOOP_PASSES
#define MK_KLOOP_PASSES 1
#endif
        _Pragma("nounroll") for (int pass_ = 0; pass_ < MK_KLOOP_PASSES; ++pass_) {
        const bool lastpass_ = pass_ == MK_KLOOP_PASSES - 1;
        for (int t = 0; t < nt; t += 2) {
            if constexpr (Epi::MID_HOOK) { if (t == (nt >> 1)) E.mid(acc, cur, wr, wc, fr, fq); }
            const bool last = (t == nt - 2);
            const char* a1 = cA + (size_t)(t + 1) * kstep;
            const char* a2 = last ? (lastpass_ ? nA : cA) : cA + (size_t)(t + 2) * kstep; const char* b2 = last ? (lastpass_ ? nB : cB) : cB + (size_t)(t + 2) * kstep;
            const char* a3 = a2 + kstep; const char* b3 = b2 + kstep;
            PG8_LDB(B0, 0, 0); PG8_LDB(B1, 0, 1); PG8_SCHED; PG8_LDA(At, 0, 0); PG8_STAGE(PG8_SA(1, 1), a1 + hstepA, voffA);
            PG8_WAIT_V(8); PG8_WAIT_L(0); PG8_BAR; PG8_MMA(0, 0, At, B0); PG8_MMA(0, 1, At, B1); PG8_BAR; PG8_SCHED;
            PG8_LDA(At, 0, 1); PG8_STAGE(PG8_SB(0, 0), b2, voffB); PG8_STAGE(PG8_SB(0, 1), b2 + hstepB, voffB); PG8_STAGE(PG8_SA(0, 0), a2, voffA);
            PG8_WAIT_V(8); PG8_WAIT_L(0); PG8_BAR; PG8_MMA(1, 0, At, B0); PG8_MMA(1, 1, At, B1); PG8_BAR; PG8_SCHED;
            PG8_LDB(B0, 1, 0); PG8_LDB(B1, 1, 1); PG8_SCHED; PG8_LDA(At, 1, 0); PG8_STAGE(PG8_SA(0, 1), a2 + hstepA, voffA);
            PG8_WAIT_V(8); PG8_WAIT_L(0); PG8_BAR; PG8_MMA(0, 0, At, B0); PG8_MMA(0, 1, At, B1); PG8_BAR; PG8_SCHED;
            PG8_LDA(At, 1, 1); PG8_STAGE(PG8_SB(1, 0), b3, voffB); PG8_STAGE(PG8_SB(1, 1), b3 + hstepB, voffB); PG8_STAGE(PG8_SA(1, 0), a3, voffA);
            PG8_WAIT_V(8); PG8_WAIT_L(0); PG8_BAR; PG8_MMA(1, 0, At, B0); PG8_MMA(1, 1, At, B1); PG8_BAR; PG8_SCHED;
        }
        if (!lastpass_) {
#pragma unroll
            for (int a = 0; a < 2; ++a)
#pragma unroll
                for (int b = 0; b < 2; ++b)
#pragma unroll
                    for (int m = 0; m < 4; ++m)
#pragma unroll
                        for (int n = 0; n < 2; ++n) acc[a][b][m][n] = (f32x4){0.f, 0.f, 0.f, 0.f}; }
        }
        if (wr == 0) PG8_BAR;
        if constexpr (Epi::NEEDS_RS) {
            if (tid < 256) { const float* q_ = E.SSQ + (size_t)((cur.seg ? cur.pn : cur.pm) * 256 + tid) * 16; const f32x4 a_ = *(const f32x4*)q_, b_ = *(const f32x4*)(q_ + 4), c_ = *(const f32x4*)(q_ + 8), d_ = *(const f32x4*)(q_ + 12);
                const float s_ = ((a_.x + a_.y) + (a_.z + a_.w)) + ((b_.x + b_.y) + (b_.z + b_.w)) + ((c_.x + c_.y) + (c_.z + c_.w)) + ((d_.x + d_.y) + (d_.z + d_.w));
                ((LAS float*)(lds + STAGE_BYTES))[tid] = 1.f / sqrtf(s_ * (1.f / 1024.f) + 1e-6f); }
            PG8_WAIT_L(0); PG8_BAR; asm volatile("" ::: "memory");
        }
        E(acc, cur, wr, wc, fr, fq, (const LAS float*)(lds + STAGE_BYTES));
        if (!has_next) break;
#pragma unroll
        for (int a = 0; a < 2; ++a)
#pragma unroll
            for (int b = 0; b < 2; ++b)
#pragma unroll
                for (int m = 0; m < 4; ++m)
#pragma unroll
                    for (int n = 0; n < 2; ++n) acc[a][b][m][n] = (f32x4){0.f, 0.f, 0.f, 0.f};
        cur = nxt; cA = nA; cB = nB; ++ui;
        if (wr == 1) PG8_BAR;
    }
    PG8_WAIT_V(0);
    PG8_BAR;
#undef PG8_SA
#undef PG8_SB
#undef PG8_STAGE
#undef PG8_LDA
#undef PG8_LDB
#undef PG8_MMA
#undef PG8_WAIT_V
#undef PG8_WAIT_L
#undef PG8_BAR
#undef PG8_SCHED
#undef PG8_ABASE
#undef PG8_BBASE
}
}
constexpr size_t MiB = 1u << 20;
constexpr size_t SZ_TD2 = (size_t)T * D * 2;
constexpr size_t WS_CTL = 0;
constexpr size_t WS_W = 1 * MiB;
constexpr size_t W_UP1 = WS_W, W_DN1 = W_UP1 + (size_t)2 * FF * D * 2, W_IN = W_DN1 + (size_t)D * FF * 2;
constexpr int NIN = 8448;
constexpr size_t W_QK = W_IN + (size_t)NIN * D * 2, W_PA = W_QK + (size_t)512 * D * 2, W_PB = W_PA + (size_t)D * D * 2, W_O = W_PB + (size_t)D * D * 2;
constexpr size_t W_UP2 = W_O + (size_t)D * D * 2, W_DN2 = W_UP2 + (size_t)2 * FF * D * 2, W_END = W_DN2 + (size_t)D * FF * 2;
static_assert(W_END <= 61 * MiB, "weights");
constexpr size_t WS_XBF = 61 * MiB;
constexpr size_t WS_MISC = WS_XBF + SZ_TD2;
constexpr size_t M_SSQ = WS_MISC;
constexpr size_t M_GATES = M_SSQ + (size_t)T * 16 * 4;
constexpr size_t M_SC = M_GATES + (size_t)T * 32 * 4;
constexpr size_t M_EAL = M_SC + (size_t)5 * NH * T * 4;
constexpr size_t M_DEN = M_EAL + (size_t)384 * GKW * 4;
constexpr size_t M_END = M_DEN + (size_t)T * 4 * 4;
static_assert(M_END <= WS_MISC + 6 * MiB, "misc");
constexpr size_t WS_ACT = WS_MISC + 6 * MiB;
constexpr size_t A_Q = WS_ACT, A_K = A_Q + SZ_TD2, A_QT = A_K + SZ_TD2;
constexpr size_t WS_SIG = WS_ACT + 94 * MiB;
constexpr size_t S_SIGO = WS_SIG, S_SILUR = S_SIGO + SZ_TD2, S_SIGA = S_SILUR + SZ_TD2, S_SIGB = S_SIGA + SZ_TD2;
constexpr size_t WS_VT = WS_SIG + 4 * SZ_TD2;
constexpr size_t WS_KT = WS_VT + 2 * SZ_TD2;
constexpr size_t WS_G = WS_KT + SZ_TD2;
constexpr size_t G_KT = WS_G, G_KTT = WS_G + SZ_TD2 / 2;
constexpr size_t WS_HN = WS_G + SZ_TD2;
constexpr size_t WS_END = WS_HN + SZ_TD2;
static_assert(A_QT + SZ_TD2 / 2 <= WS_SIG && WS_END <= 502 * MiB, "ws map");
constexpr size_t O_YP = 0, O_YS = 16777216, O_CONVP = 17825792, O_CP = 17850368, O_NP = 19947520, O_MP = 19955712, O_SP = 19955744, O_CONVS = 21004320, O_CS = 21397536, O_NS = 54951968, O_MS = 55083040, O_SS = 55083552, O_END = 71860768;
constexpr size_t DO_OG = 0;
constexpr size_t DO_U = O_CS * 4, DO_QG = DO_U + SZ_TD2, DO_KG = DO_QG + SZ_TD2 / 2, DO_CH = DO_KG + SZ_TD2 / 2;
static_assert(DO_CH + SZ_TD2 <= O_NS * 4, "d_out temporaries");

struct P {
    const float* in[28]; float* out; unsigned char* ws;
};
#define WSP(T_, off) ((T_*)(p.ws + (off)))
#define DOP(T_, off) ((T_*)((unsigned char*)p.out + (off)))

__device__ __forceinline__ int win_src(int n) {
    if (n < 1024) return n;
    if (n < 2048) return 2048 + (n - 1024);
    if (n < 2560) return 3080 + (n - 2048);
    if (n < 3072) return 3592 + (n - 2560);
    if (n < 4096) return 5128 + (n - 3072);
    if (n < 5120) return 6168 + (n - 4096);
    if (n < 6144) return 7192 + (n - 5120);
    if (n < 6400) { const int j = n - 6144; return j < 8 ? 3072 + j : (j < 24 ? 6152 + (j - 8) : -1); }
    if (n < 7424) return 1024 + (n - 6400);
    return 4104 + (n - 7424);
}
__device__ __forceinline__ int up_src(int n) { const int t = n >> 8, r = n & 255; return (r >> 7) * FF + t * 128 + (r & 127); }
template <int MAP>
__device__ __forceinline__ void p0_item(const float* W, int K, int N, const float* gk, float scale, bf16_t* WT, int dst_row0, int ndst, LAS float* scr, int item, int lane, int ldw = 0, int kd0 = 0) {
    if (ldw == 0) ldw = K;
    const int nblk = ndst / 32, kb = item / nblk, nb = item % nblk, k0 = 64 * kb, n0 = 32 * nb;
    const int nn = n0 + (lane & 31); const int src = MAP == 0 ? nn : (MAP == 1 ? up_src(nn) : win_src(nn));
    float v[32];
#pragma unroll
    for (int i = 0; i < 32; ++i) { const int kk = 2 * i + (lane >> 5); v[i] = src >= 0 ? W[(size_t)(k0 + kk) * N + src] : 0.f; }
#pragma unroll
    for (int i = 0; i < 32; ++i) scr[(2 * i + (lane >> 5)) * 33 + (lane & 31)] = v[i];
    asm volatile("s_waitcnt lgkmcnt(0)" ::: "memory");
    const int c = lane & 7;
    f32x4 g0 = {scale, scale, scale, scale}, g1 = g0;
    if (gk) { g0 = *(const f32x4*)(gk + k0 + 8 * c) * scale; g1 = *(const f32x4*)(gk + k0 + 8 * c + 4) * scale; }
#pragma unroll
    for (int j = 0; j < 4; ++j) { const int n = (lane >> 3) + 8 * j; const LAS float* s = scr + (8 * c) * 33 + n;
        u32x4 o; o.x = pk2(s[0 * 33] * g0[0], s[1 * 33] * g0[1]); o.y = pk2(s[2 * 33] * g0[2], s[3 * 33] * g0[3]); o.z = pk2(s[4 * 33] * g1[0], s[5 * 33] * g1[1]); o.w = pk2(s[6 * 33] * g1[2], s[7 * 33] * g1[3]);
        *(u32x4*)(WT + (size_t)(dst_row0 + n0 + n) * ldw + kd0 + k0 + 8 * c) = o; }
    asm volatile("s_waitcnt lgkmcnt(0)" ::: "memory");
}
__device__ __forceinline__ void p0_prologue(const P& p, LAS unsigned char* lds, int gw, int NGW, int wave, int lane) {
    LAS float* scr = (LAS float*)(lds + wave * 16384);
    constexpr int I_UP = (D / 64) * (2 * FF / 32), I_DN = (FF / 64) * (D / 32), I_IN = (D / 64) * (NIN / 32), I_QK = (D / 64) * (256 / 32), I_SQ = (D / 64) * (D / 32);
    constexpr int NITEMS = 2 * I_UP + 2 * I_DN + I_IN + 2 * I_QK + 3 * I_SQ;
    for (int it = gw; it < NITEMS; it += NGW) {
        int r = it;
        if (r < I_IN) { p0_item<2>(p.in[11], D, INW, p.in[10], 1.f, WSP(bf16_t, W_IN), 0, NIN, scr, r, lane); continue; } r -= I_IN;
        if (r < I_UP) { p0_item<1>(p.in[8], D, 2 * FF, p.in[7], 1.f, WSP(bf16_t, W_UP1), 0, 2 * FF, scr, r, lane); continue; } r -= I_UP;
        if (r < I_UP) { p0_item<1>(p.in[25], D, 2 * FF, p.in[24], 1.f, WSP(bf16_t, W_UP2), 0, 2 * FF, scr, r, lane); continue; } r -= I_UP;
        if (r < I_DN) { p0_item<0>(p.in[9], FF, D, nullptr, 1.f, WSP(bf16_t, W_DN1), 0, D, scr, r, lane); continue; } r -= I_DN;
        if (r < I_DN) { p0_item<0>(p.in[26], FF, D, nullptr, 1.f, WSP(bf16_t, W_DN2), 0, D, scr, r, lane); continue; } r -= I_DN;
        if (r < I_QK) { p0_item<0>(p.in[14], D, 256, nullptr, 1.f, WSP(bf16_t, W_QK), 0, 256, scr, r, lane); continue; } r -= I_QK;
        if (r < I_QK) { p0_item<0>(p.in[15], D, 256, nullptr, 0.0625f, WSP(bf16_t, W_QK), 256, 256, scr, r, lane); continue; } r -= I_QK;
        if (r < I_SQ) { p0_item<0>(p.in[21], D, D, nullptr, 1.f, WSP(bf16_t, W_PA), 0, D, scr, r, lane, 2 * D, 0); continue; } r -= I_SQ;
        if (r < I_SQ) { p0_item<0>(p.in[22], D, D, nullptr, 1.f, WSP(bf16_t, W_PA), 0, D, scr, r, lane, 2 * D, D); continue; } r -= I_SQ;
        p0_item<0>(p.in[23], D, D, nullptr, 1.f, WSP(bf16_t, W_O), 0, D, scr, r, lane);
    }
    bf16_t* XB = WSP(bf16_t, WS_XBF); float* SSQ = WSP(float, M_SSQ);
    for (int m0 = 2 * gw; m0 < T; m0 += 2 * NGW) {
        f32x4 v[2][4];
#pragma unroll
        for (int r = 0; r < 2; ++r) { const int m = m0 + r; const float* xrow = m < T_P ? p.in[0] + (size_t)m * D : p.in[1] + (size_t)(m - T_P) * D; const f32x4* xr = (const f32x4*)xrow + lane;
#pragma unroll
            for (int j = 0; j < 4; ++j) v[r][j] = xr[64 * j]; }
#pragma unroll
        for (int r = 0; r < 2; ++r) { const int m = m0 + r; float s = 0.f;
#pragma unroll
            for (int j = 0; j < 4; ++j) s += (v[r][j].x * v[r][j].x + v[r][j].y * v[r][j].y) + (v[r][j].z * v[r][j].z + v[r][j].w * v[r][j].w);
            s = wave_sum(s);
            u32x2* o8 = (u32x2*)(XB + (size_t)m * D) + lane;
#pragma unroll
            for (int j = 0; j < 4; ++j) { u32x2 w; w.x = pk2(v[r][j].x, v[r][j].y); w.y = pk2(v[r][j].z, v[r][j].w); o8[64 * j] = w; }
            if (lane < 16) SSQ[(size_t)m * 16 + lane] = lane == 0 ? s : 0.f; }
    }
}
__device__ __forceinline__ float row_rs(const float* SSQ, int row) {
    const f32x4* q = (const f32x4*)(SSQ + (size_t)row * 16); const f32x4 a = q[0], b = q[1], c = q[2], d = q[3];
    const float s = ((a.x + a.y) + (a.z + a.w)) + ((b.x + b.y) + (b.z + b.w)) + ((c.x + c.y) + (c.z + c.w)) + ((d.x + d.y) + (d.z + d.w));
    return 1.f / sqrtf(s * (1.f / D) + EPS);
}

typedef pg8::Unit Unit;
#define EPI_ARGS const f32x4 (&acc)[2][2][4][2], const Unit& u, int wr, int wc, int fr, int fq, const LAS float* rst
struct EpiUp { static constexpr bool NEEDS_RS = true; static constexpr bool MID_HOOK = false; const float* SSQ; bf16_t* ACT;
    __device__ __forceinline__ void operator()(EPI_ARGS) const {
        const int row0 = u.pm * 256 + wr * 64 + fr, col0 = u.pn * 128 + wc * 32 + 8 * fq;
#pragma unroll
        for (int ai = 0; ai < 2; ++ai)
#pragma unroll
            for (int m = 0; m < 4; ++m) { const int row = row0 + ai * 128 + m * 16; const float rs = rst[wr * 64 + fr + ai * 128 + m * 16]; u32x4 w; unsigned* wp = (unsigned*)&w;
#pragma unroll
                for (int n = 0; n < 2; ++n) { const f32x4 a = acc[ai][0][m][n] * rs, g = acc[ai][1][m][n] * rs;
                    wp[2 * n] = pk2(silu_(g[0]) * a[0], silu_(g[1]) * a[1]); wp[2 * n + 1] = pk2(silu_(g[2]) * a[2], silu_(g[3]) * a[3]); }
                *(u32x4*)(ACT + (size_t)row * FF + col0) = w; }
    }
};
template <int MODE> struct EpiRes { static constexpr bool NEEDS_RS = false; static constexpr bool MID_HOOK = false; bf16_t* XB; float* XO; float* SSQ; float alpha;
    __device__ __forceinline__ void operator()(EPI_ARGS) const {
        const int row0 = u.pm * 256 + wr * 64 + fr;
#pragma unroll
        for (int ai = 0; ai < 2; ++ai)
#pragma unroll
            for (int m = 0; m < 4; ++m) { const int row = row0 + ai * 128 + m * 16; float ss = 0.f;
#pragma unroll
                for (int bj = 0; bj < 2; ++bj) { const int col = u.pn * 256 + bj * 128 + wc * 32 + 8 * fq; const size_t off = (size_t)row * D + col;
                    const u32x4 xw = *(const u32x4*)(XB + off);
                    const f32x4 x0 = {bflo(xw.x), bfhi(xw.x), bflo(xw.y), bfhi(xw.y)}, x1 = {bflo(xw.z), bfhi(xw.z), bflo(xw.w), bfhi(xw.w)};
                    const f32x4 y0 = x0 + acc[ai][bj][m][0] * alpha, y1 = x1 + acc[ai][bj][m][1] * alpha;
                    if (MODE == 0) { ss += (y0[0] * y0[0] + y0[1] * y0[1]) + (y0[2] * y0[2] + y0[3] * y0[3]) + (y1[0] * y1[0] + y1[1] * y1[1]) + (y1[2] * y1[2] + y1[3] * y1[3]);
                        u32x4 w; w.x = pk2(y0[0], y0[1]); w.y = pk2(y0[2], y0[3]); w.z = pk2(y1[0], y1[1]); w.w = pk2(y1[2], y1[3]); *(u32x4*)(XB + off) = w; }
                    else { *(f32x4*)(XO + off) = y0; *(f32x4*)(XO + off + 4) = y1; } }
                if (MODE == 0) { ss += __shfl_xor(ss, 16); ss += __shfl_xor(ss, 32); if (fq == 0) SSQ[(size_t)row * 16 + u.pn * 4 + wc] = ss; } }
    }
};
struct EpiIn { static constexpr bool NEEDS_RS = true; static constexpr bool MID_HOOK = false; const float* SSQ; bf16_t *U, *SIGO, *QG, *KG, *SILUR, *SIGA, *SIGB, *VT; float* GATES;
    __device__ __forceinline__ void operator()(EPI_ARGS) const {
        if (u.seg == 0) {
            const int row0 = u.pm * 256 + wr * 64 + fr; const int pn = u.pn;
            bf16_t* dst; int ld, cb, act;
            if (pn < 4) { dst = U; ld = D; cb = pn * 256; act = 0; } else if (pn < 8) { dst = SIGO; ld = D; cb = (pn - 4) * 256; act = 1; }
            else if (pn < 10) { dst = QG; ld = GKW; cb = (pn - 8) * 256; act = 0; } else if (pn < 12) { dst = KG; ld = GKW; cb = (pn - 10) * 256; act = 0; }
            else if (pn < 16) { dst = SILUR; ld = D; cb = (pn - 12) * 256; act = 2; } else if (pn < 20) { dst = SIGA; ld = D; cb = (pn - 16) * 256; act = 1; }
            else { dst = SIGB; ld = D; cb = (pn - 20) * 256; act = 1; }
#pragma unroll
            for (int ai = 0; ai < 2; ++ai)
#pragma unroll
                for (int m = 0; m < 4; ++m) { const int row = row0 + ai * 128 + m * 16; const float rs = rst[wr * 64 + fr + ai * 128 + m * 16];
                    if (pn == 24) { if (wc == 0) { *(f32x4*)(GATES + (size_t)row * 32 + 8 * fq) = acc[ai][0][m][0] * rs; *(f32x4*)(GATES + (size_t)row * 32 + 8 * fq + 4) = acc[ai][0][m][1] * rs; } continue; }
#pragma unroll
                    for (int bj = 0; bj < 2; ++bj) { f32x4 v0 = acc[ai][bj][m][0] * rs, v1 = acc[ai][bj][m][1] * rs;
                        if (act == 1) { for (int i = 0; i < 4; ++i) { v0[i] = sigmoid_(v0[i]); v1[i] = sigmoid_(v1[i]); } }
                        else if (act == 2) { for (int i = 0; i < 4; ++i) { v0[i] = silu_(v0[i]); v1[i] = silu_(v1[i]); } }
                        u32x4 w; w.x = pk2(v0[0], v0[1]); w.y = pk2(v0[2], v0[3]); w.z = pk2(v1[0], v1[1]); w.w = pk2(v1[2], v1[3]);
                        *(u32x4*)(dst + (size_t)row * ld + cb + bj * 128 + wc * 32 + 8 * fq) = w; } }
        } else {
            const int vrow0 = u.pm * 256 + wr * 64 + fr;
            float rs[2][8];
#pragma unroll
            for (int bj = 0; bj < 2; ++bj)
#pragma unroll
                for (int j = 0; j < 8; ++j) rs[bj][j] = rst[bj * 128 + wc * 32 + 8 * fq + j];
#pragma unroll
            for (int ai = 0; ai < 2; ++ai)
#pragma unroll
                for (int m = 0; m < 4; ++m) { const int vr = vrow0 + ai * 128 + m * 16;
#pragma unroll
                    for (int bj = 0; bj < 2; ++bj) { const f32x4 a0 = acc[ai][bj][m][0], a1 = acc[ai][bj][m][1]; u32x4 w;
                        w.x = pk2(a0[0] * rs[bj][0], a0[1] * rs[bj][1]); w.y = pk2(a0[2] * rs[bj][2], a0[3] * rs[bj][3]); w.z = pk2(a1[0] * rs[bj][4], a1[1] * rs[bj][5]); w.w = pk2(a1[2] * rs[bj][6], a1[3] * rs[bj][7]);
                        *(u32x4*)(VT + (size_t)vr * T + u.pn * 256 + bj * 128 + wc * 32 + 8 * fq) = w; } }
        }
    }
};
struct EpiQK { static constexpr bool NEEDS_RS = false; static constexpr bool MID_HOOK = false; bf16_t *Q, *K, *KT;
    __device__ __forceinline__ void operator()(EPI_ARGS) const {
        const int row0 = u.pm * 256 + wr * 64 + fr;
#pragma unroll
        for (int ai = 0; ai < 2; ++ai)
#pragma unroll
            for (int m = 0; m < 4; ++m) { const int row = row0 + ai * 128 + m * 16;
#pragma unroll
                for (int bj = 0; bj < 2; ++bj) { const f32x4 v0 = acc[ai][bj][m][0], v1 = acc[ai][bj][m][1]; const int cc = bj * 128 + wc * 32 + 8 * fq;
                    u32x4 w; w.x = pk2(v0[0], v0[1]); w.y = pk2(v0[2], v0[3]); w.z = pk2(v1[0], v1[1]); w.w = pk2(v1[2], v1[3]);
                    if (u.seg == 0) *(u32x4*)((u.pn == 0 ? Q : K) + (size_t)row * D + u.z * 256 + cc) = w;
                    else *(u32x4*)(KT + (size_t)(u.z * 256 + row) * T + u.pn * 256 + cc) = w; } }
    }
};
struct EpiMerge { static constexpr bool NEEDS_RS = false; static constexpr bool MID_HOOK = true; const bf16_t* GA; const bf16_t* GB; bf16_t* Y;
    __device__ __forceinline__ void mid(f32x4 (&acc)[2][2][4][2], const Unit& u, int wr, int wc, int fr, int fq) const {
        int row0 = u.pm * 256 + wr * 64 + fr; asm volatile("" : "+v"(row0));
#pragma unroll
        for (int ai = 0; ai < 2; ++ai)
#pragma unroll
            for (int m = 0; m < 4; ++m) { const int row = row0 + ai * 128 + m * 16;
#pragma unroll
                for (int bj = 0; bj < 2; ++bj) { const size_t off = (size_t)row * D + u.pn * 256 + bj * 128 + wc * 32 + 8 * fq;
                    const u32x4 a = *(const u32x4*)(GA + off), b = *(const u32x4*)(GB + off);
#define RAT(x, y) ((x) * __builtin_amdgcn_rcpf(fmaxf((y), 1e-30f)))
                    const f32x4 r0 = {RAT(bflo(a.x), bflo(b.x)), RAT(bfhi(a.x), bfhi(b.x)), RAT(bflo(a.y), bflo(b.y)), RAT(bfhi(a.y), bfhi(b.y))};
                    const f32x4 r1 = {RAT(bflo(a.z), bflo(b.z)), RAT(bfhi(a.z), bfhi(b.z)), RAT(bflo(a.w), bflo(b.w)), RAT(bfhi(a.w), bfhi(b.w))};
#undef RAT
                    acc[ai][bj][m][0] = acc[ai][bj][m][0] * r0; acc[ai][bj][m][1] = acc[ai][bj][m][1] * r1; }
                asm volatile("" ::: "memory"); }
    }
    __device__ __forceinline__ void operator()(EPI_ARGS) const {
        const int row0 = u.pm * 256 + wr * 64 + fr;
#pragma unroll
        for (int ai = 0; ai < 2; ++ai)
#pragma unroll
            for (int m = 0; m < 4; ++m) { const int row = row0 + ai * 128 + m * 16;
#pragma unroll
                for (int bj = 0; bj < 2; ++bj) { const size_t off = (size_t)row * D + u.pn * 256 + bj * 128 + wc * 32 + 8 * fq;
                    const u32x4 b = *(const u32x4*)(GB + off);
                    const f32x4 y0 = acc[ai][bj][m][0] * (f32x4){fmaxf(bflo(b.x), 1e-30f), fmaxf(bfhi(b.x), 1e-30f), fmaxf(bflo(b.y), 1e-30f), fmaxf(bfhi(b.y), 1e-30f)};
                    const f32x4 y1 = acc[ai][bj][m][1] * (f32x4){fmaxf(bflo(b.z), 1e-30f), fmaxf(bfhi(b.z), 1e-30f), fmaxf(bflo(b.w), 1e-30f), fmaxf(bfhi(b.w), 1e-30f)};
                    u32x4 w; w.x = pk2(y0[0], y0[1]); w.y = pk2(y0[2], y0[3]); w.z = pk2(y1[0], y1[1]); w.w = pk2(y1[2], y1[3]); *(u32x4*)(Y + off) = w; } }
    }
};
constexpr size_t SC_STRIDE = (size_t)NH * T;
__device__ __forceinline__ void p4_conv(const P& p, size_t gtid, size_t gsz) {
    const bf16_t* U = DOP(const bf16_t, DO_U); bf16_t* CH = DOP(bf16_t, DO_CH);
    const float* cw = p.in[12]; const float* cb = p.in[13]; const float* stc = p.in[2];
    const int c8 = (int)(gtid & 127) * 8; const int rstep = (int)(gsz >> 7);
    float wt[4][8], bs[8];
#pragma unroll
    for (int j = 0; j < 4; ++j) { const f32x4 w0 = *(const f32x4*)(cw + j * D + c8), w1 = *(const f32x4*)(cw + j * D + c8 + 4); wt[j][0] = w0[0]; wt[j][1] = w0[1]; wt[j][2] = w0[2]; wt[j][3] = w0[3]; wt[j][4] = w1[0]; wt[j][5] = w1[1]; wt[j][6] = w1[2]; wt[j][7] = w1[3]; }
    { const f32x4 b0 = *(const f32x4*)(cb + c8), b1 = *(const f32x4*)(cb + c8 + 4); bs[0] = b0[0]; bs[1] = b0[1]; bs[2] = b0[2]; bs[3] = b0[3]; bs[4] = b1[0]; bs[5] = b1[1]; bs[6] = b1[2]; bs[7] = b1[3]; }
#pragma unroll 2
    for (int row = (int)(gtid >> 7); row < T; row += rstep) {
        int t, Tl, seq; if (row < T_P) { t = row & (SEQ - 1); Tl = SEQ; seq = row >> 11; } else { t = (row - T_P) & 7; Tl = DEC_T; seq = (row - T_P) >> 3; }
        float a[8];
#pragma unroll
        for (int i = 0; i < 8; ++i) a[i] = bs[i];
        u32x4 ucur = {0u, 0u, 0u, 0u};
#pragma unroll
        for (int j = 0; j < 4; ++j) { const int tt = t - 3 + j; float uv[8];
            if (tt >= 0) { const u32x4 w = *(const u32x4*)(U + (size_t)(row - 3 + j) * D + c8); if (j == 3) ucur = w;
                uv[0] = bflo(w.x); uv[1] = bfhi(w.x); uv[2] = bflo(w.y); uv[3] = bfhi(w.y); uv[4] = bflo(w.z); uv[5] = bfhi(w.z); uv[6] = bflo(w.w); uv[7] = bfhi(w.w); }
            else if (row >= T_P) { const float* s = stc + ((size_t)seq * 3 + (3 + tt)) * D + c8; const f32x4 s0 = *(const f32x4*)s, s1 = *(const f32x4*)(s + 4);
                uv[0] = s0[0]; uv[1] = s0[1]; uv[2] = s0[2]; uv[3] = s0[3]; uv[4] = s1[0]; uv[5] = s1[1]; uv[6] = s1[2]; uv[7] = s1[3]; }
            else {
#pragma unroll
                for (int i = 0; i < 8; ++i) uv[i] = 0.f; }
#pragma unroll
            for (int i = 0; i < 8; ++i) a[i] += uv[i] * wt[j][i]; }
        u32x4 o; o.x = pk2(silu_(a[0]), silu_(a[1])); o.y = pk2(silu_(a[2]), silu_(a[3])); o.z = pk2(silu_(a[4]), silu_(a[5])); o.w = pk2(silu_(a[6]), silu_(a[7]));
        *(u32x4*)(CH + (size_t)row * D + c8) = o;
        if (t >= Tl - 3) { float* co = (row < T_P ? p.out + O_CONVP : p.out + O_CONVS) + ((size_t)seq * 3 + (t - (Tl - 3))) * D + c8;
            *(f32x4*)co = (f32x4){bflo(ucur.x), bfhi(ucur.x), bflo(ucur.y), bfhi(ucur.y)}; *(f32x4*)(co + 4) = (f32x4){bflo(ucur.z), bfhi(ucur.z), bflo(ucur.w), bfhi(ucur.w)}; }
    }
}
__device__ __forceinline__ void p4_gates(const P& p, LAS unsigned char* lds, int bid, int tid) {
    const float* GATES = WSP(const float, M_GATES); float* SC = WSP(float, M_SC); const float* bif = p.in[16];
    const int lane = tid & 63, w = __builtin_amdgcn_readfirstlane(tid >> 6);
    if (bid < 32) {
        const int b = bid >> 2, h = bid & 3; LAS float* sum = (LAS float*)lds; LAS float* mp = sum + 64;
        const float bi = bif[h], bfg = bif[NH + h]; float a[4], bb[4], cm[4];
#pragma unroll
        for (int j = 0; j < 4; ++j) { const int c = 4 * w + j, row = b * SEQ + c * 64 + lane;
            const float gi = GATES[(size_t)row * 32 + h] + bi, gf = GATES[(size_t)row * 32 + NH + h] + bfg;
            float x = logsigmoid_(gf);
#pragma unroll
            for (int o = 1; o < 64; o <<= 1) { const float y = __shfl_up(x, o, 64); if (lane >= o) x += y; }
            float m = gi - x; a[j] = m;
#pragma unroll
            for (int o = 1; o < 64; o <<= 1) { const float y = __shfl_up(m, o, 64); if (lane >= o) m = fmaxf(m, y); }
            bb[j] = x; cm[j] = m; if (lane == 63) { sum[2 * c] = x; sum[2 * c + 1] = m; } }
        __syncthreads();
        if (tid == 0) { float m = 0.f; for (int c = 0; c < 32; ++c) { mp[c] = m; m = sum[2 * c] + fmaxf(m, sum[2 * c + 1]); } p.out[O_MP + (size_t)b * NH + h] = m; }
        __syncthreads();
#pragma unroll
        for (int j = 0; j < 4; ++j) { const int c = 4 * w + j, row = b * SEQ + c * 64 + lane; const float mprev = mp[c];
            const float Mt = fmaxf(mprev, cm[j]), mt = bb[j] + Mt, ML = __shfl(Mt, 63, 64); const size_t o = (size_t)h * T + row;
            SC[o] = a[j]; SC[SC_STRIDE + o] = Mt; SC[2 * SC_STRIDE + o] = expf(mprev - Mt); SC[3 * SC_STRIDE + o] = expf(a[j] - ML); SC[4 * SC_STRIDE + o] = expf(-mt); }
        __syncthreads();
    } else if (bid < 40) {
        const int job = (bid - 32) * 8 + w, h = job & 3, li = lane & 7, seq = (job >> 2) * 8 + (lane >> 3), row = T_P + seq * 8 + li;
        const float mprev = p.in[5][seq * NH + h];
        const float gi = GATES[(size_t)row * 32 + h] + bif[h], gf = GATES[(size_t)row * 32 + NH + h] + bif[NH + h];
        float b = logsigmoid_(gf);
#pragma unroll
        for (int o = 1; o < 8; o <<= 1) { const float x = __shfl_up(b, o, 8); if (li >= o) b += x; }
        const float a = gi - b; float cm = a;
#pragma unroll
        for (int o = 1; o < 8; o <<= 1) { const float x = __shfl_up(cm, o, 8); if (li >= o) cm = fmaxf(cm, x); }
        const float Mt = fmaxf(mprev, cm), mt = b + Mt, ML = __shfl(Mt, 7, 8), bL = __shfl(b, 7, 8); const size_t o = (size_t)h * T + row;
        SC[o] = a; SC[SC_STRIDE + o] = Mt; SC[2 * SC_STRIDE + o] = expf(mprev - Mt); SC[3 * SC_STRIDE + o] = expf(a - ML); SC[4 * SC_STRIDE + o] = expf(-mt);
        if (li == 7) p.out[O_MS + (size_t)seq * NH + h] = bL + ML;
    }
}
__device__ __forceinline__ void p4_gla(const P& p, int bid, int G, int tid) {
    const float* GATES = WSP(const float, M_GATES); const bf16_t* QG = DOP(const bf16_t, DO_QG); const bf16_t* KG = DOP(const bf16_t, DO_KG);
    bf16_t* QT = WSP(bf16_t, A_QT); bf16_t* KTn = WSP(bf16_t, G_KT); bf16_t* KTT = WSP(bf16_t, G_KTT); float* EAL = WSP(float, M_EAL);
    const int c = tid;
    float w2[16];
#pragma unroll
    for (int r = 0; r < 16; ++r) w2[r] = p.in[18][r * GKW + c];
    const float ba = p.in[19][c];
    for (int g = G - 1 - bid; g < NGRP; g += G) {
        const bool smp = g >= NCH_P; float A = 0.f;
        for (int t8 = 0; t8 < 8; ++t8) {
            unsigned kp[4] = {0u, 0u, 0u, 0u}; float eA = 1.f;
            if (smp) A = 0.f;
#pragma unroll
            for (int j = 0; j < 8; ++j) {
                const int row = g * 64 + t8 * 8 + j;
                const f32x4* ag = (const f32x4*)(GATES + (size_t)row * 32 + 8); float s = ba;
#pragma unroll
                for (int r4 = 0; r4 < 4; ++r4) { const f32x4 a4 = ag[r4]; s += a4[0] * w2[4 * r4] + a4[1] * w2[4 * r4 + 1] + a4[2] * w2[4 * r4 + 2] + a4[3] * w2[4 * r4 + 3]; }
                A += (fminf(s, 0.f) - __logf(1.f + __expf(-fabsf(s)))) * 0.0625f;
                const float q = bf2f(QG[(size_t)row * GKW + c]), k = bf2f(KG[(size_t)row * GKW + c]);
                eA = __expf(A); const float kt = k * __expf(-A);
                QT[(size_t)row * GKW + c] = (bf16_t)f2bf(q * 0.08838834764831845f * eA);
                const unsigned kb = f2bf(kt); KTn[(size_t)row * GKW + c] = (bf16_t)kb;
                if (j & 1) kp[j >> 1] |= kb << 16; else kp[j >> 1] = kb;
            }
            { u32x4 w = {kp[0], kp[1], kp[2], kp[3]}; *(u32x4*)(KTT + (size_t)c * T + g * 64 + t8 * 8) = w; }
            if (smp) EAL[(size_t)(256 + (g - NCH_P) * 8 + t8) * GKW + c] = eA;
            else if (t8 == 7) EAL[(size_t)g * GKW + c] = eA;
        }
    }
}

#define MFMA16(a, b, c) __builtin_amdgcn_mfma_f32_16x16x32_bf16(a, b, c, 0, 0, 0)
#define LBAR() do { asm volatile("s_waitcnt lgkmcnt(0)" ::: "memory"); __builtin_amdgcn_s_barrier(); asm volatile("" ::: "memory"); } while (0)
template <bool ML>
__device__ __forceinline__ void scan_prompt(const P& p, LAS unsigned char* lds, int b, int h, int es) {
    constexpr int DK = ML ? 256 : 128, ES = ML ? 64 : 128, NE = ML ? 80 : 128, NET = NE / 16, NDT = DK / 128  , KS = DK / 32;
    constexpr int QS = DK * 2 + 32, VS = 160;
    constexpr int OFF_Q = 0, OFF_K = OFF_Q + 64 * QS, OFF_V = OFF_K + 64 * QS, OFF_S = OFF_V + NE * VS, OFF_C = OFF_S + 64 * VS, OFF_SC = OFF_C + NE * QS;
    static_assert(OFF_SC + 1280 <= 140 * 1024, "scan LDS");
    constexpr int TPW = ML ? 3 : 4;
    constexpr int QPT = 64 * (DK / 8) / NTHR, VPT = ES * 8 / NTHR;
    int tid_ = threadIdx.x; asm volatile("" : "+v"(tid_));
    const int tid = tid_, w = __builtin_amdgcn_readfirstlane(tid >> 6), lane = tid & 63, fr = lane & 15, fq = lane >> 4;
    const size_t row0 = (size_t)b * SEQ;
    const bf16_t* Qg = ML ? WSP(const bf16_t, A_Q) + row0 * D + h * 256 : WSP(const bf16_t, A_QT) + row0 * GKW + h * 128;
    const bf16_t* Kg = ML ? WSP(const bf16_t, A_K) + row0 * D + h * 256 : WSP(const bf16_t, G_KT) + row0 * GKW + h * 128;
    constexpr int LDQ = ML ? D : GKW;
    const bf16_t* VTg = WSP(const bf16_t, WS_VT) + (size_t)((ML ? 0 : 1024) + h * 256 + es * ES) * T + row0;
    const bf16_t* KTg = (ML ? WSP(const bf16_t, WS_KT) + (size_t)(h * 256) * T : WSP(const bf16_t, G_KTT) + (size_t)(h * 128) * T) + row0;
    const float* SC = WSP(const float, M_SC) + (size_t)h * T + row0;
    const float* EALg = WSP(const float, M_EAL) + (size_t)(b * 32) * GKW + h * 128;
    bf16_t* OUT = ML ? WSP(bf16_t, WS_HN) : DOP(bf16_t, DO_OG);
    LAS float* scal = (LAS float*)(lds + OFF_SC);
    for (int i = tid; i < NE * QS / 4; i += NTHR) ((LAS unsigned*)(lds + OFF_C))[i] = 0u;
    for (int i = tid; i < 64 * VS / 4; i += NTHR) ((LAS unsigned*)(lds + OFF_S))[i] = 0u;
    if (ML) for (int i = tid; i < 16 * VS / 4; i += NTHR) ((LAS unsigned*)(lds + OFF_V + ES * VS))[i] = (i < VS / 4) ? 0x3f803f80u : 0u;
    f32x4 accC[NDT][NET];
#pragma unroll
    for (int a = 0; a < NDT; ++a)
#pragma unroll
        for (int e = 0; e < NET; ++e) accC[a][e] = (f32x4){0.f, 0.f, 0.f, 0.f};
    u32x4 sq[QPT], sk[QPT], sv[VPT]; float ssc = 0.f;
#define STAGE_LOAD(c_) do { const size_t r0_ = (size_t)(c_) * 64; \
        _Pragma("unroll") for (int j = 0; j < QPT; ++j) { const int i = tid + NTHR * j, rr = i / (DK / 8), cc = i % (DK / 8); sq[j] = *(const u32x4*)(Qg + (r0_ + rr) * LDQ + cc * 8); sk[j] = *(const u32x4*)(Kg + (r0_ + rr) * LDQ + cc * 8); } \
        _Pragma("unroll") for (int j = 0; j < VPT; ++j) { const int i = tid + NTHR * j, rr = i >> 3, cc = i & 7; sv[j] = *(const u32x4*)(VTg + (size_t)rr * T + r0_ + cc * 8); } \
        if (ML) { if (tid < 320) ssc = SC[(size_t)((tid >> 6) == 3 ? 4 : ((tid >> 6) == 4 ? 3 : (tid >> 6))) * SC_STRIDE + r0_ + (tid & 63)]; } else if (tid < 128) ssc = EALg[(size_t)(c_) * GKW + tid]; } while (0)
#define STAGE_WRITE() do { \
        _Pragma("unroll") for (int j = 0; j < QPT; ++j) { const int i = tid + NTHR * j, rr = i / (DK / 8), cc = i % (DK / 8); *(LAS u32x4*)(lds + OFF_Q + rr * QS + cc * 16) = sq[j]; *(LAS u32x4*)(lds + OFF_K + rr * QS + cc * 16) = sk[j]; } \
        _Pragma("unroll") for (int j = 0; j < VPT; ++j) { const int i = tid + NTHR * j, rr = i >> 3, cc = i & 7; *(LAS u32x4*)(lds + OFF_V + rr * VS + cc * 16) = sv[j]; } \
        if (tid < (ML ? 320 : 128)) scal[tid] = ssc; } while (0)
    STAGE_LOAD(0); STAGE_WRITE(); LBAR();
    for (int c = 0; c < 32; ++c) {
        const size_t r0 = (size_t)c * 64;
        if (c + 1 < 32) STAGE_LOAD(c + 1);
        bf16x8 kt[NDT][2];
#pragma unroll
        for (int a = 0; a < NDT; ++a)
#pragma unroll
            for (int ks = 0; ks < 2; ++ks) kt[a][ks] = *(const bf16x8*)(KTg + (size_t)(16 * (NDT * w + a) + fr) * T + r0 + ks * 32 + 8 * fq);
        if (w < 6) {
            const int st = w < 2 ? 0 : (w == 2 ? 1 : (w == 3 ? 2 : (w == 4 ? 1 : 3))), tt0 = w == 0 ? 0 : (w == 2 ? 1 : (w >= 4 ? 3 : 2)); const int ntl = w < 4 ? 2 : 1;
            f32x4 accS[2] = {(f32x4){0.f, 0.f, 0.f, 0.f}, (f32x4){0.f, 0.f, 0.f, 0.f}};
#pragma unroll
            for (int ks = 0; ks < KS; ++ks) { const bf16x8 af = *(const LAS bf16x8*)(lds + OFF_K + (16 * st + fr) * QS + ks * 64 + fq * 16);
                { const bf16x8 bfr = *(const LAS bf16x8*)(lds + OFF_Q + (16 * tt0 + fr) * QS + ks * 64 + fq * 16); accS[0] = MFMA16(af, bfr, accS[0]); }
                if (ntl == 2) { const bf16x8 bfr = *(const LAS bf16x8*)(lds + OFF_Q + (16 * (tt0 + 1) + fr) * QS + ks * 64 + fq * 16); accS[1] = MFMA16(af, bfr, accS[1]); } }
#pragma unroll
            for (int j = 0; j < 2; ++j) if (j < ntl) { const int t = 16 * (tt0 + j) + fr, s0 = 16 * st + 4 * fq; float v[4];
#pragma unroll
                for (int r = 0; r < 4; ++r) { const int s = s0 + r; float x = accS[j][r]; if (ML) x *= __expf(scal[s] - scal[64 + t]); v[r] = (s <= t) ? x : 0.f; }
                u32x2 wv; wv.x = pk2(v[0], v[1]); wv.y = pk2(v[2], v[3]); *(LAS u32x2*)(lds + OFF_S + t * VS + s0 * 2) = wv; }
        }
        const int ttq = ML ? (w & 3) : (w & 3), et0 = ML ? (w < 4 ? 3 : 0) : 4 * (w >> 2), ntq = ML ? (w < 4 ? 2 : 3) : 4;
        f32x4 accO[TPW];
#pragma unroll
        for (int j = 0; j < TPW; ++j) accO[j] = (f32x4){0.f, 0.f, 0.f, 0.f};
#pragma unroll
        for (int ks = 0; ks < KS; ++ks) { const bf16x8 bfr = *(const LAS bf16x8*)(lds + OFF_Q + (16 * ttq + fr) * QS + ks * 64 + fq * 16);
#pragma unroll
            for (int j = 0; j < TPW; ++j) if (j < ntq) { const bf16x8 af = *(const LAS bf16x8*)(lds + OFF_C + (16 * (et0 + j) + fr) * QS + ks * 64 + fq * 16); accO[j] = MFMA16(af, bfr, accO[j]); } }
        LBAR();
        { const int t = 16 * ttq + fr; const size_t grow = row0 + r0 + t; const int nks = ttq < 2 ? 1 : 2;
#pragma unroll
          for (int j = 0; j < TPW; ++j) if (j < ntq) { const int et = et0 + j;
                if (ML) accO[j] = accO[j] * scal[128 + t];
#pragma unroll
                for (int ks = 0; ks < 2; ++ks) if (ks < nks) { const bf16x8 af = *(const LAS bf16x8*)(lds + OFF_V + (16 * et + fr) * VS + ks * 64 + fq * 16), bfr = *(const LAS bf16x8*)(lds + OFF_S + t * VS + ks * 64 + fq * 16);
                    accO[j] = MFMA16(af, bfr, accO[j]); }
                if (!ML || et < 4) { u32x2 wv; wv.x = pk2(accO[j][0], accO[j][1]); wv.y = pk2(accO[j][2], accO[j][3]); *(u32x2*)(OUT + grow * D + h * 256 + es * ES + 16 * et + 4 * fq) = wv; }
                else if (es == 0 && fq == 0) WSP(float, M_DEN)[grow * 4 + h] = fmaxf(fabsf(accO[j][0]), scal[192 + t]); } }
        if (ML) { const float dec = scal[128 + 63];
#pragma unroll
            for (int a = 0; a < NDT; ++a)
#pragma unroll
                for (int e = 0; e < NET; ++e) accC[a][e] = accC[a][e] * dec;
#pragma unroll
            for (int ks = 0; ks < 2; ++ks) { const f32x4 w0 = *(const LAS f32x4*)(scal + 256 + ks * 32 + 8 * fq), w1 = *(const LAS f32x4*)(scal + 256 + ks * 32 + 8 * fq + 4);
#pragma unroll
                for (int a = 0; a < NDT; ++a) { const u32x4 kw = __builtin_bit_cast(u32x4, kt[a][ks]); u32x4 o;
                    o.x = pk2(bflo(kw.x) * w0[0], bfhi(kw.x) * w0[1]); o.y = pk2(bflo(kw.y) * w0[2], bfhi(kw.y) * w0[3]); o.z = pk2(bflo(kw.z) * w1[0], bfhi(kw.z) * w1[1]); o.w = pk2(bflo(kw.w) * w1[2], bfhi(kw.w) * w1[3]);
                    kt[a][ks] = __builtin_bit_cast(bf16x8, o); } } }
#pragma unroll
        for (int ks = 0; ks < 2; ++ks)
#pragma unroll
            for (int e = 0; e < NET; ++e) { const bf16x8 bfr = *(const LAS bf16x8*)(lds + OFF_V + (16 * e + fr) * VS + ks * 64 + fq * 16);
#pragma unroll
                for (int a = 0; a < NDT; ++a) accC[a][e] = MFMA16(kt[a][ks], bfr, accC[a][e]); }
        if (!ML) {
#pragma unroll
            for (int a = 0; a < NDT; ++a) { const f32x4 ea = *(const LAS f32x4*)(scal + 16 * (NDT * w + a) + 4 * fq);
#pragma unroll
                for (int e = 0; e < NET; ++e) accC[a][e] = accC[a][e] * ea; } }
        LBAR();
#pragma unroll
        for (int a = 0; a < NDT; ++a)
#pragma unroll
            for (int e = 0; e < NET; ++e) { u32x2 wv; wv.x = pk2(accC[a][e][0], accC[a][e][1]); wv.y = pk2(accC[a][e][2], accC[a][e][3]);
                *(LAS u32x2*)(lds + OFF_C + (16 * e + fr) * QS + (16 * (NDT * w + a) + 4 * fq) * 2) = wv; }
        if (c + 1 < 32) STAGE_WRITE();
        LBAR();
    }
    if (ML) { float* Cp = p.out + O_CP + (size_t)(b * NH + h) * HD * HD; float* np = p.out + O_NP + (size_t)(b * NH + h) * HD;
#pragma unroll
        for (int a = 0; a < NDT; ++a) { const int d = 16 * (NDT * w + a) + 4 * fq;
#pragma unroll
            for (int e = 0; e < 4; ++e) *(f32x4*)(Cp + (size_t)(es * 64 + 16 * e + fr) * HD + d) = accC[a][e];
            if (es == 0 && fr == 0) *(f32x4*)(np + d) = accC[a][NET - 1]; }
    } else { float* Sp = p.out + O_SP + (size_t)(b * NH + h) * GDK * GDV;
#pragma unroll
        for (int a = 0; a < NDT; ++a)
#pragma unroll
            for (int e = 0; e < NET; ++e)
#pragma unroll
                for (int r = 0; r < 4; ++r) Sp[(size_t)(16 * (NDT * w + a) + 4 * fq + r) * GDV + es * 128 + 16 * e + fr] = accC[a][e][r]; }
#undef STAGE_LOAD
#undef STAGE_WRITE
    LBAR();
}
#define SBAR() __syncthreads()
__device__ __forceinline__ void sample_ml(const P& p, LAS unsigned char* lds, int seq, int h) {
    LAS float* qf = (LAS float*)lds; LAS float* kf = qf + 2048; LAS float* vf = kf + 2048; LAS float* n0s = vf + 2048; LAS float* sS = n0s + 256; LAS float* sc = sS + 64; LAS float* qn = sc + 40; LAS float* part = (LAS float*)(lds + 32768);
    int tid_ = threadIdx.x; asm volatile("" : "+v"(tid_));
    const int tid = tid_, w = __builtin_amdgcn_readfirstlane(tid >> 6), lane = tid & 63, fr = lane & 15, fq = lane >> 4;
    const size_t R0 = (size_t)T_P + (size_t)seq * 8, sh = (size_t)seq * NH + h;
    { const int t = tid >> 6, d4 = (tid & 63) * 4;
      const u32x2 qw = *(const u32x2*)(WSP(const bf16_t, A_Q) + (R0 + t) * D + h * 256 + d4), kw = *(const u32x2*)(WSP(const bf16_t, A_K) + (R0 + t) * D + h * 256 + d4);
      *(LAS f32x4*)(qf + t * 256 + d4) = (f32x4){bflo(qw.x), bfhi(qw.x), bflo(qw.y), bfhi(qw.y)}; *(LAS f32x4*)(kf + t * 256 + d4) = (f32x4){bflo(kw.x), bfhi(kw.x), bflo(kw.y), bfhi(kw.y)}; }
    if (tid < 256) { const u32x4 vw = *(const u32x4*)(WSP(const bf16_t, WS_VT) + (size_t)(h * 256 + tid) * T + R0);
        vf[0 * 256 + tid] = bflo(vw.x); vf[1 * 256 + tid] = bfhi(vw.x); vf[2 * 256 + tid] = bflo(vw.y); vf[3 * 256 + tid] = bfhi(vw.y); vf[4 * 256 + tid] = bflo(vw.z); vf[5 * 256 + tid] = bfhi(vw.z); vf[6 * 256 + tid] = bflo(vw.w); vf[7 * 256 + tid] = bfhi(vw.w);
        n0s[tid] = p.in[4][sh * HD + tid]; }
    if (tid < 40) sc[tid] = WSP(const float, M_SC)[(size_t)(tid >> 3) * SC_STRIDE + (size_t)h * T + R0 + (tid & 7)];
    SBAR();
    if (tid < 64) { const int t = tid >> 3, s = tid & 7; float dot = 0.f;
        for (int d = 0; d < 256; ++d) dot += qf[t * 256 + d] * kf[s * 256 + d];
        sS[tid] = (s <= t) ? dot * expf(sc[s] - sc[8 + t]) : 0.f; }
    else if (tid < 72) { const int t = tid - 64; float dot = 0.f; for (int d = 0; d < 256; ++d) dot += qf[t * 256 + d] * n0s[d]; qn[t] = dot; }
    SBAR();
    if (tid < 8) { float den = sc[16 + tid] * qn[tid]; for (int s = 0; s < 8; ++s) den += sS[tid * 8 + s]; WSP(float, M_DEN)[(R0 + tid) * 4 + h] = fmaxf(fabsf(den), sc[32 + tid]); }
    const int d0 = 32 * w + 8 * fq; const float dec = sc[16 + 7];
    float kr[8][8];
#pragma unroll
    for (int s = 0; s < 8; ++s) { const f32x4 k0 = *(const LAS f32x4*)(kf + s * 256 + d0), k1 = *(const LAS f32x4*)(kf + s * 256 + d0 + 4); const float ws_ = sc[24 + s];
        kr[s][0] = k0[0] * ws_; kr[s][1] = k0[1] * ws_; kr[s][2] = k0[2] * ws_; kr[s][3] = k0[3] * ws_; kr[s][4] = k1[0] * ws_; kr[s][5] = k1[1] * ws_; kr[s][6] = k1[2] * ws_; kr[s][7] = k1[3] * ws_; }
    bf16x8 qfrag; { u32x4 o = {0u, 0u, 0u, 0u}; if (fr < 8) { const f32x4 q0 = *(const LAS f32x4*)(qf + fr * 256 + d0), q1 = *(const LAS f32x4*)(qf + fr * 256 + d0 + 4);
        o.x = pk2(q0[0], q0[1]); o.y = pk2(q0[2], q0[3]); o.z = pk2(q1[0], q1[1]); o.w = pk2(q1[2], q1[3]); } qfrag = __builtin_bit_cast(bf16x8, o); }
    if (fr == 0) { float nn[8];
#pragma unroll
        for (int j = 0; j < 8; ++j) { float a = dec * n0s[d0 + j];
#pragma unroll
            for (int s = 0; s < 8; ++s) a += kr[s][j]; nn[j] = a; }
        float* no = p.out + O_NS + sh * HD + d0; *(f32x4*)no = (f32x4){nn[0], nn[1], nn[2], nn[3]}; *(f32x4*)(no + 4) = (f32x4){nn[4], nn[5], nn[6], nn[7]}; }
    const float* C0 = p.in[3] + sh * HD * HD; float* Cn = p.out + O_CS + sh * HD * HD;
#pragma unroll 4
    for (int strip = 0; strip < 16; ++strip) { const int e = 16 * strip + fr;
        const f32x4 c0 = *(const f32x4*)(C0 + (size_t)e * HD + d0), c1 = *(const f32x4*)(C0 + (size_t)e * HD + d0 + 4);
        float cn[8] = {c0[0] * dec, c0[1] * dec, c0[2] * dec, c0[3] * dec, c1[0] * dec, c1[1] * dec, c1[2] * dec, c1[3] * dec};
#pragma unroll
        for (int s = 0; s < 8; ++s) { const float vv = vf[s * 256 + e];
#pragma unroll
            for (int j = 0; j < 8; ++j) cn[j] += vv * kr[s][j]; }
        *(f32x4*)(Cn + (size_t)e * HD + d0) = (f32x4){cn[0], cn[1], cn[2], cn[3]}; *(f32x4*)(Cn + (size_t)e * HD + d0 + 4) = (f32x4){cn[4], cn[5], cn[6], cn[7]};
        u32x4 o; o.x = pk2(c0[0], c0[1]); o.y = pk2(c0[2], c0[3]); o.z = pk2(c1[0], c1[1]); o.w = pk2(c1[2], c1[3]);
        const f32x4 acc = MFMA16(__builtin_bit_cast(bf16x8, o), qfrag, ((f32x4){0.f, 0.f, 0.f, 0.f}));
        if (fr < 8) {
#pragma unroll
            for (int r = 0; r < 4; ++r) part[(size_t)(w * 256 + 16 * strip + 4 * fq + r) * 8 + fr] = acc[r]; } }
    SBAR();
    { const int t = tid >> 6, e4 = (tid & 63) * 4; float o4[4];
#pragma unroll
      for (int i = 0; i < 4; ++i) { float qc = 0.f;
#pragma unroll
          for (int ww = 0; ww < 8; ++ww) qc += part[(size_t)(ww * 256 + e4 + i) * 8 + t];
          float a = sc[16 + t] * qc;
#pragma unroll
          for (int s = 0; s < 8; ++s) a += sS[t * 8 + s] * vf[s * 256 + e4 + i];
          o4[i] = a; }
      u32x2 wv; wv.x = pk2(o4[0], o4[1]); wv.y = pk2(o4[2], o4[3]); *(u32x2*)(WSP(bf16_t, WS_HN) + (R0 + t) * D + h * 256 + e4) = wv; }
    SBAR();
}
__device__ __forceinline__ void sample_gla(const P& p, LAS unsigned char* lds, int seq, int h) {
    LAS float* qf = (LAS float*)lds; LAS float* kf = qf + 1024; LAS float* vf = kf + 1024; LAS float* eal = vf + 2048; LAS float* att = eal + 128; LAS float* part = (LAS float*)(lds + 32768);
    int tid_ = threadIdx.x; asm volatile("" : "+v"(tid_));
    const int tid = tid_, w = __builtin_amdgcn_readfirstlane(tid >> 6), lane = tid & 63;
    const size_t R0 = (size_t)T_P + (size_t)seq * 8, sh = (size_t)seq * NH + h;
    { const int t = tid >> 6, d2 = (tid & 63) * 2;
      const unsigned qw = *(const unsigned*)(WSP(const bf16_t, A_QT) + (R0 + t) * GKW + h * 128 + d2), kw = *(const unsigned*)(WSP(const bf16_t, G_KT) + (R0 + t) * GKW + h * 128 + d2);
      qf[t * 128 + d2] = bflo(qw); qf[t * 128 + d2 + 1] = bfhi(qw); kf[t * 128 + d2] = bflo(kw); kf[t * 128 + d2 + 1] = bfhi(kw); }
    if (tid < 256) { const u32x4 vw = *(const u32x4*)(WSP(const bf16_t, WS_VT) + (size_t)(1024 + h * 256 + tid) * T + R0);
        vf[0 * 256 + tid] = bflo(vw.x); vf[1 * 256 + tid] = bfhi(vw.x); vf[2 * 256 + tid] = bflo(vw.y); vf[3 * 256 + tid] = bfhi(vw.y); vf[4 * 256 + tid] = bflo(vw.z); vf[5 * 256 + tid] = bfhi(vw.z); vf[6 * 256 + tid] = bflo(vw.w); vf[7 * 256 + tid] = bfhi(vw.w); }
    else if (tid < 384) eal[tid - 256] = WSP(const float, M_EAL)[(size_t)(256 + seq) * GKW + h * 128 + (tid - 256)];
    SBAR();
    if (tid < 64) { const int t = tid >> 3, s = tid & 7; float dot = 0.f; for (int d = 0; d < 128; ++d) dot += qf[t * 128 + d] * kf[s * 128 + d]; att[tid] = (s <= t) ? dot : 0.f; }
    const int e4 = 4 * lane;
    f32x4 vr[8], ai[8];
#pragma unroll
    for (int s = 0; s < 8; ++s) { vr[s] = *(const LAS f32x4*)(vf + s * 256 + e4); ai[s] = (f32x4){0.f, 0.f, 0.f, 0.f}; }
    const float* S0 = p.in[6] + sh * GDK * GDV; float* Sn = p.out + O_SS + sh * GDK * GDV;
#pragma unroll 4
    for (int dd = 0; dd < 16; ++dd) { const int d = 16 * w + dd;
        const f32x4 s0 = *(const f32x4*)(S0 + (size_t)d * GDV + e4); f32x4 up = s0;
#pragma unroll
        for (int s = 0; s < 8; ++s) { up += vr[s] * kf[s * 128 + d]; ai[s] += s0 * qf[s * 128 + d]; }
        *(f32x4*)(Sn + (size_t)d * GDV + e4) = up * eal[d]; }
#pragma unroll
    for (int t = 0; t < 8; ++t) *(LAS f32x4*)(part + (size_t)(w * 8 + t) * 256 + e4) = ai[t];
    SBAR();
    { const int t = tid >> 6; f32x4 o = {0.f, 0.f, 0.f, 0.f};
#pragma unroll
      for (int ww = 0; ww < 8; ++ww) o += *(const LAS f32x4*)(part + (size_t)(ww * 8 + t) * 256 + e4);
#pragma unroll
      for (int s = 0; s < 8; ++s) o += *(const LAS f32x4*)(vf + s * 256 + e4) * att[t * 8 + s];
      u32x2 wv; wv.x = pk2(o[0], o[1]); wv.y = pk2(o[2], o[3]); *(u32x2*)(DOP(bf16_t, DO_OG) + (R0 + t) * D + h * 256 + e4) = wv; }
    SBAR();
}
#ifndef MK_SCAN_PARTS
#define MK_SCAN_PARTS 3
#endif
__device__ __forceinline__ void p5_scan(const P& p, LAS unsigned char* lds, int bid, int G, unsigned* counter, int parts) {
    if (parts & 1) for (int it = bid; it < 192; it += G) {
        if (it < 128) scan_prompt<true>(p, lds, it >> 4, (it >> 2) & 3, it & 3);
        else { const int i = it - 128; scan_prompt<false>(p, lds, i >> 3, (i >> 1) & 3, i & 1); }
    }
    LAS int* slot = (LAS int*)(lds + 140 * 1024);
    if (parts & 2) for (;;) {
        if (threadIdx.x == 0) *slot = (int)atomicAdd(counter, 1u);
        SBAR();
        const int it = *slot;
        SBAR();
        if (it >= 1024) break;
        if (it < 512) sample_ml(p, lds, it >> 2, it & 3); else sample_gla(p, lds, (it - 512) >> 2, it & 3);
    }
}
__device__ __forceinline__ void p5b_norm(const P& p, int gw, int NGW, int lane) {
    const bf16_t* HN = WSP(const bf16_t, WS_HN); const bf16_t* OG = DOP(const bf16_t, DO_OG); const bf16_t* SIGO = WSP(const bf16_t, S_SIGO); const bf16_t* SILUR = WSP(const bf16_t, S_SILUR);
    bf16_t* HMO = WSP(bf16_t, A_Q); const float* DEN = WSP(const float, M_DEN);
    const int h = lane >> 4, c0 = h * 256 + (lane & 15) * 16;
    float gm[16], gg[16];
#pragma unroll
    for (int i = 0; i < 16; ++i) { gm[i] = p.in[17][c0 + i]; gg[i] = p.in[20][c0 + i]; }
#pragma unroll 2
    for (int row = gw; row < T; row += NGW) {
#pragma unroll
        for (int br = 0; br < 2; ++br) {
            const bf16_t* src = (br == 0 ? HN : OG) + (size_t)row * D + c0; const bf16_t* gsrc = (br == 0 ? SIGO : SILUR) + (size_t)row * D + c0;
            const u32x4 a = *(const u32x4*)src, b = *(const u32x4*)(src + 8), ga = *(const u32x4*)gsrc, gb = *(const u32x4*)(gsrc + 8);
            float v[16] = {bflo(a.x), bfhi(a.x), bflo(a.y), bfhi(a.y), bflo(a.z), bfhi(a.z), bflo(a.w), bfhi(a.w), bflo(b.x), bfhi(b.x), bflo(b.y), bfhi(b.y), bflo(b.z), bfhi(b.z), bflo(b.w), bfhi(b.w)};
            float gt[16] = {bflo(ga.x), bfhi(ga.x), bflo(ga.y), bfhi(ga.y), bflo(ga.z), bfhi(ga.z), bflo(ga.w), bfhi(ga.w), bflo(gb.x), bfhi(gb.x), bflo(gb.y), bfhi(gb.y), bflo(gb.z), bfhi(gb.z), bflo(gb.w), bfhi(gb.w)};
            float ss = 0.f;
#pragma unroll
            for (int i = 0; i < 16; ++i) ss += v[i] * v[i];
            ss += __shfl_xor(ss, 1); ss += __shfl_xor(ss, 2); ss += __shfl_xor(ss, 4); ss += __shfl_xor(ss, 8);
            float extra = EPS; if (br == 0) { const float dn = DEN[(size_t)row * 4 + h]; extra = EPS * dn * dn; }
            const float sc = 1.f / sqrtf(ss * (1.f / 256.f) + extra);
            unsigned o[8];
#pragma unroll
            for (int i = 0; i < 8; ++i) { const float g0 = br == 0 ? gm[2 * i] : gg[2 * i], g1 = br == 0 ? gm[2 * i + 1] : gg[2 * i + 1]; o[i] = pk2(gt[2 * i] * g0 * v[2 * i] * sc, gt[2 * i + 1] * g1 * v[2 * i + 1] * sc); }
            bf16_t* dst = HMO + (size_t)row * (2 * D) + br * D + c0;
            *(u32x4*)dst = (u32x4){o[0], o[1], o[2], o[3]}; *(u32x4*)(dst + 8) = (u32x4){o[4], o[5], o[6], o[7]};
        }
    }
}
__device__ __forceinline__ void p10_final(const P& p, int gw, int NGW, int lane) {
    const f32x4* g4 = (const f32x4*)p.in[27] + lane; f32x4 g[4];
#pragma unroll
    for (int j = 0; j < 4; ++j) g[j] = g4[64 * j];
#pragma unroll 2
    for (int row = gw; row < T; row += NGW) {
        f32x4* xr = (f32x4*)(p.out + (size_t)row * D) + lane; f32x4 v[4]; float s = 0.f;
#pragma unroll
        for (int j = 0; j < 4; ++j) { v[j] = xr[64 * j]; s += (v[j].x * v[j].x + v[j].y * v[j].y) + (v[j].z * v[j].z + v[j].w * v[j].w); }
        const float rs = 1.f / sqrtf(wave_sum(s) * (1.f / D) + EPS);
#pragma unroll
        for (int j = 0; j < 4; ++j) xr[64 * j] = v[j] * rs * g[j];
    }
}
constexpr int LDS_BYTES = 147456;
constexpr int CW_CNT = 64;
constexpr int CW_BAR = 1024;
constexpr int CTL_ZERO_BYTES = 32768;
#ifndef MK_PH_LO
#define MK_PH_LO 0
#endif
#ifndef MK_PH_HI
#define MK_PH_HI 99
#endif
#ifndef MK_REP
#define MK_REP 0
#endif
__global__ void __launch_bounds__(NTHR, 2) mk_fwd(P p) {
    cg::grid_group grid = cg::this_grid();
    extern __shared__ __attribute__((aligned(16))) unsigned char lds_raw[];
    LAS unsigned char* lds = (LAS unsigned char*)lds_raw;
    const int bid = blockIdx.x, G = gridDim.x, NGW = G * NWAVES; const size_t gsz = (size_t)G * NTHR;
    if (threadIdx.x < 4) ((LAS unsigned*)(lds + 140 * 1024 + 16))[threadIdx.x] = 0u;
    __syncthreads();
    const XcdBarrier xbar = xcd_barrier_post((unsigned*)(p.ws + WS_CTL) + CW_BAR, (volatile LAS unsigned*)(lds + 140 * 1024 + 16));
#define GRID_BAR() xcd_barrier(xbar)
#define TIDX() int tid = threadIdx.x; asm volatile("" : "+v"(tid)); const int lane = tid & 63, wave = __builtin_amdgcn_readfirstlane(tid >> 6), gw = bid * NWAVES + wave; const size_t gtid = (size_t)bid * NTHR + tid; (void)lane; (void)gw; (void)gtid
    float* SSQ = WSP(float, M_SSQ); float* XRES = p.out;
    bf16_t* XBF = WSP(bf16_t, WS_XBF); bf16_t* ACT = WSP(bf16_t, WS_ACT);
    constexpr int NM = T / 256;
#define PH(k) (MK_PH_LO <= (k) && (k) <= MK_PH_HI)
#define PHASE_BEGIN(k) _Pragma("nounroll") for (int rep_ = 0; rep_ <= ((MK_REP >> (k)) & 1); ++rep_) { if (rep_) GRID_BAR(); if (PH(k)) {
#define PHASE_END } }
    PHASE_BEGIN(0) TIDX(); p0_prologue(p, lds, gw, NGW, wave, lane); PHASE_END
    grid.sync();
    PHASE_BEGIN(1) pg8::Gemm g{XBF, WSP(bf16_t, W_UP1), nullptr, nullptr, D, D, D, 0, 0}; pg8::Sched S; S.init(NM, 2 * FF / 256, 1, 0, 0, 0, G, bid);
        EpiUp E{SSQ, ACT}; pg8::gemm_phase(lds, g, S, E); PHASE_END
    GRID_BAR();
    PHASE_BEGIN(2) pg8::Gemm g{ACT, WSP(bf16_t, W_DN1), nullptr, nullptr, FF, FF, FF, 0, 0}; pg8::Sched S; S.init(NM, D / 256, 1, 0, 0, 0, G, bid);
        EpiRes<0> E{XBF, XRES, SSQ, 0.5f}; pg8::gemm_phase(lds, g, S, E); PHASE_END
    GRID_BAR();
    PHASE_BEGIN(3) const bf16_t* Wi = WSP(bf16_t, W_IN); pg8::Gemm g{XBF, Wi, Wi + (size_t)6400 * D, XBF, D, D, D, 0, 0}; pg8::Sched S; S.init(NM, 25, 1, 8, NM, 1, G, bid);
        EpiIn E{SSQ, DOP(bf16_t, DO_U), WSP(bf16_t, S_SIGO), DOP(bf16_t, DO_QG), DOP(bf16_t, DO_KG), WSP(bf16_t, S_SILUR), WSP(bf16_t, S_SIGA), WSP(bf16_t, S_SIGB), WSP(bf16_t, WS_VT), WSP(float, M_GATES)};
        pg8::gemm_phase(lds, g, S, E); PHASE_END
    GRID_BAR();
    PHASE_BEGIN(4) TIDX(); p4_gates(p, lds, bid, tid); p4_gla(p, bid, G, tid); { const int ncb = G > 32 ? G - 16 : G; if (bid < ncb) p4_conv(p, gtid, (size_t)ncb * NTHR); } PHASE_END
    GRID_BAR();
    PHASE_BEGIN(5) const bf16_t* Wqk = WSP(bf16_t, W_QK); const bf16_t* CH = DOP(bf16_t, DO_CH); pg8::Gemm g{CH, Wqk, Wqk + (size_t)256 * D, CH, D, D, 256, 256, 256}; pg8::Sched S; S.init(NM, 2, 4, 1, NM, 4, G, bid);
        EpiQK E{WSP(bf16_t, A_Q), WSP(bf16_t, A_K), WSP(bf16_t, WS_KT)}; pg8::gemm_phase(lds, g, S, E); PHASE_END
    GRID_BAR();
    PHASE_BEGIN(6) p5_scan(p, lds, bid, G, (unsigned*)(p.ws + WS_CTL) + CW_CNT + rep_, rep_ ? MK_SCAN_PARTS : 3); PHASE_END
    GRID_BAR();
    PHASE_BEGIN(7) TIDX(); p5b_norm(p, gw, NGW, lane); PHASE_END
    GRID_BAR();
    PHASE_BEGIN(8) pg8::Gemm g{WSP(bf16_t, A_Q), WSP(bf16_t, W_PA), nullptr, nullptr, 2 * D, 2 * D, 2 * D, 0, 0}; pg8::Sched S; S.init(NM, D / 256, 1, 0, 0, 0, G, bid);
        EpiMerge E{WSP(bf16_t, S_SIGA), WSP(bf16_t, S_SIGB), WSP(bf16_t, WS_KT)}; pg8::gemm_phase(lds, g, S, E); PHASE_END
    GRID_BAR();
    PHASE_BEGIN(9) pg8::Gemm g{WSP(bf16_t, WS_KT), WSP(bf16_t, W_O), nullptr, nullptr, D, D, D, 0, 0}; pg8::Sched S; S.init(NM, D / 256, 1, 0, 0, 0, G, bid);
        EpiRes<0> E{XBF, XRES, SSQ, 1.0f}; pg8::gemm_phase(lds, g, S, E); PHASE_END
    GRID_BAR();
    PHASE_BEGIN(10) pg8::Gemm g{XBF, WSP(bf16_t, W_UP2), nullptr, nullptr, D, D, D, 0, 0}; pg8::Sched S; S.init(NM, 2 * FF / 256, 1, 0, 0, 0, G, bid);
        EpiUp E{SSQ, ACT}; pg8::gemm_phase(lds, g, S, E); PHASE_END
    GRID_BAR();
    PHASE_BEGIN(11) pg8::Gemm g{ACT, WSP(bf16_t, W_DN2), nullptr, nullptr, FF, FF, FF, 0, 0}; pg8::Sched S; S.init(NM, D / 256, 1, 0, 0, 0, G, bid);
        EpiRes<1> E{XBF, XRES, SSQ, 0.5f}; pg8::gemm_phase(lds, g, S, E); PHASE_END
    GRID_BAR();
#ifdef MK_EXTRA_SYNCS
    for (int i_ = 0; i_ < MK_EXTRA_SYNCS; ++i_) GRID_BAR();
#endif
    PHASE_BEGIN(12) TIDX(); p10_final(p, gw, NGW, lane); PHASE_END
#undef PH
#undef TIDX
#undef PHASE_BEGIN
#undef PHASE_END
#undef GRID_BAR
}
}

static int mk_launch(void* const* d_in, const int* in_sizes, int n_in, void* d_out, int out_size, void* d_ws, size_t ws_size, hipStream_t stream) {
    static int grid = 0;
    if (grid == 0) {
        if (n_in != 28 || (size_t)out_size != mk::O_END || ws_size < mk::WS_END) { fprintf(stderr, "kernel_launch: built for 28 inputs, %zu outputs, >= %zu bytes of workspace; got n_in %d, out %d, ws %zu; nothing launched\n", (size_t)mk::O_END, (size_t)mk::WS_END, n_in, out_size, ws_size); grid = -1; return -1; }
        int dev = 0, cus = 0, per_cu = 0;
        if (hipGetDevice(&dev) != hipSuccess || hipDeviceGetAttribute(&cus, hipDeviceAttributeMultiprocessorCount, dev) != hipSuccess) { grid = -1; return -1; }
        if (hipFuncSetAttribute((const void*)mk::mk_fwd, hipFuncAttributeMaxDynamicSharedMemorySize, mk::LDS_BYTES) != hipSuccess) { fprintf(stderr, "kernel_launch: hipFuncSetAttribute failed\n"); grid = -1; return -1; }
        if (hipOccupancyMaxActiveBlocksPerMultiprocessor(&per_cu, (const void*)mk::mk_fwd, mk::NTHR, mk::LDS_BYTES) != hipSuccess || per_cu < 1) { fprintf(stderr, "kernel_launch: occupancy query reports %d blocks per CU\n", per_cu); grid = -1; (void)hipGetLastError(); return -1; }
        grid = cus;
    }
    if (grid < 0) return -1;
    if (hipMemsetAsync((char*)d_ws + mk::WS_CTL, 0, mk::CTL_ZERO_BYTES, stream) != hipSuccess) return -1;
    mk::P prm{}; for (int i = 0; i < 28; ++i) prm.in[i] = (const float*)d_in[i]; prm.out = (float*)d_out; prm.ws = (unsigned char*)d_ws;
    void* args[] = {&prm};
    const hipError_t e = hipLaunchCooperativeKernel((const void*)mk::mk_fwd, dim3(grid), dim3(mk::NTHR), args, mk::LDS_BYTES, stream);
    if (e != hipSuccess) { fprintf(stderr, "cooperative launch failed: %s (grid %d)\n", hipGetErrorString(e), grid); return -1; }
    return 0;
}
extern "C" void kernel_launch(void* const* d_in, const int* in_sizes, int n_in, void* d_out, int out_size, void* d_ws, size_t ws_size, hipStream_t stream) {
    (void)mk_launch(d_in, in_sizes, n_in, d_out, out_size, d_ws, ws_size, stream);
}
```

```cpp
#include <hip/hip_runtime.h>
#include <cstdio>
#include <cstdint>
#include <hip/hip_cooperative_groups.h>
namespace cg = cooperative_groups;
namespace mk {
#define LAS __attribute__((address_space(3)))
#define GAS __attribute__((address_space(1)))
typedef unsigned short bf16_t;
typedef short bf16x8 __attribute__((ext_vector_type(8)));
typedef float f32x4 __attribute__((ext_vector_type(4)));
typedef float f32x2 __attribute__((ext_vector_type(2)));
typedef unsigned u32x4 __attribute__((ext_vector_type(4)));
typedef unsigned u32x2 __attribute__((ext_vector_type(2)));

constexpr int D = 1024, FF = 2816, T_P = 16384, T_S = 1024, T = T_P + T_S, SEQ = 2048, NB = 8, DEC_B = 128, DEC_T = 8;
constexpr int NH = 4, HD = 256, GDK = 128, GDV = 256, GKW = 512, INW = 8216;
constexpr int NWAVES = 8, NTHR = 512;
constexpr float EPS = 1e-6f;
constexpr int NCH_P = T_P / 64;
constexpr int NGRP = T / 64;

__device__ __forceinline__ unsigned f2bf(float f) { unsigned u = __builtin_bit_cast(unsigned, f); return (u + 0x7fffu + ((u >> 16) & 1u)) >> 16; }
typedef __bf16 bf16x2n __attribute__((ext_vector_type(2)));
__device__ __forceinline__ unsigned pk2(float lo, float hi) { const f32x2 v = {lo, hi}; return __builtin_bit_cast(unsigned, __builtin_convertvector(v, bf16x2n)); }
__device__ __forceinline__ float bf2f(unsigned short b) { return __builtin_bit_cast(float, (unsigned)b << 16); }
__device__ __forceinline__ float bflo(unsigned w) { return __builtin_bit_cast(float, w << 16); }
__device__ __forceinline__ float bfhi(unsigned w) { return __builtin_bit_cast(float, w & 0xffff0000u); }
__device__ __forceinline__ float sigmoid_(float x) { return 1.f / (1.f + __expf(-x)); }
__device__ __forceinline__ float silu_(float x) { return x / (1.f + __expf(-x)); }
__device__ __forceinline__ float logsigmoid_(float x) { return fminf(x, 0.f) - log1pf(expf(-fabsf(x))); }
__device__ __forceinline__ float wave_sum(float v) {
#pragma unroll
    for (int o = 1; o < 64; o <<= 1) v += __shfl_xor(v, o);
    return v;
}

#define XB_TMO      128
#define XB_XCNT(j)  (256  + 64 * (j))
#define XB_XSUB(j)  (1280 + 64 * (j))
#define XB_XGEN(j)  (2304 + 64 * (j))
#define XB_TOP      3328
#define XB_TOPGEN   3392
#define XCD_BAR_WORDS 3456
#define XB_SPIN_CAP (1u << 18)
__device__ __forceinline__ unsigned xb_ld(unsigned* p)              { return __hip_atomic_load(p, __ATOMIC_RELAXED, __HIP_MEMORY_SCOPE_AGENT); }
__device__ __forceinline__ unsigned xb_add(unsigned* p, unsigned v) { return __hip_atomic_fetch_add(p, v, __ATOMIC_RELAXED, __HIP_MEMORY_SCOPE_AGENT); }
__device__ __forceinline__ unsigned xb_xcc_id() { return (unsigned)__builtin_amdgcn_s_getreg((3 << 11) | 20) & 0xFu; }
#define XB_SPIN(cond, bar) do { unsigned _sp = 0; while (cond) { __builtin_amdgcn_s_sleep(1); \
    if ((++_sp & 255u) == 0u) { if (xb_ld(&(bar)[XB_TMO])) break; if (_sp > XB_SPIN_CAP) { atomicAdd(&(bar)[XB_TMO], 1u); break; } } } } while (0)
struct XcdBarrier { unsigned* bar; unsigned x; volatile LAS unsigned* st; };
__device__ __forceinline__ XcdBarrier xcd_barrier_post(unsigned* bar, volatile LAS unsigned* st) {
    XcdBarrier b; b.bar = bar; b.x = xb_xcc_id(); b.st = st;
    if (threadIdx.x == 0) (void)xb_add(&bar[XB_XCNT(b.x)], 1u);
    return b;
}
__device__ __forceinline__ void xcd_barrier_complete(unsigned* bar, unsigned x, unsigned& nloc, unsigned& nx) {
    const unsigned G = gridDim.x * gridDim.y * gridDim.z;
    unsigned sum, cnt, mine, sp = 0u;
    for (;;) {
        sum = 0u; cnt = 0u; mine = 0u;
#pragma unroll
        for (unsigned j = 0; j < 16; ++j) { const unsigned c = xb_ld(&bar[XB_XCNT(j)]); sum += c; cnt += (c > 0u) ? 1u : 0u; mine = (j == x) ? c : mine; }
        if (sum == G) break;
        __builtin_amdgcn_s_sleep(1);
        if ((++sp & 255u) == 0u) { if (xb_ld(&bar[XB_TMO])) break; if (sp > XB_SPIN_CAP) { atomicAdd(&bar[XB_TMO], 1u); break; } }
    }
    nloc = mine > 0u ? mine : 1u; nx = cnt > 0u ? cnt : 1u;
}
__device__ __forceinline__ void xcd_barrier(const XcdBarrier& b) {
    asm volatile("s_waitcnt vmcnt(0)" ::: "memory");
    __syncthreads();
    if (threadIdx.x == 0) {
        unsigned* bar = b.bar;
        __builtin_amdgcn_s_waitcnt(0);
        unsigned nloc = b.st[0], nx = b.st[1];
        if (nloc == 0u) { xcd_barrier_complete(bar, b.x, nloc, nx); b.st[0] = nloc; b.st[1] = nx; }
        const unsigned old = xb_add(&bar[XB_XSUB(b.x)], 1u);
        const unsigned gen = old / nloc;
        if (old + 1u == (gen + 1u) * nloc) {
            __builtin_amdgcn_fence(__ATOMIC_RELEASE, "agent");
            asm volatile("s_waitcnt vmcnt(0)" ::: "memory");
            const unsigned og = xb_add(&bar[XB_TOP], 1u);
            const unsigned tg = og / nx;
            if (og + 1u == (tg + 1u) * nx) xb_add(&bar[XB_TOPGEN], 1u);
            else XB_SPIN(xb_ld(&bar[XB_TOPGEN]) == tg, bar);
            __builtin_amdgcn_fence(__ATOMIC_ACQUIRE, "agent");
            xb_add(&bar[XB_XGEN(b.x)], 1u);
            asm volatile("s_waitcnt vmcnt(0)" ::: "memory");
        } else {
            XB_SPIN(xb_ld(&bar[XB_XGEN(b.x)]) == gen, bar);
            __builtin_amdgcn_fence(__ATOMIC_ACQUIRE, "agent");
            asm volatile("s_waitcnt vmcnt(0)" ::: "memory");
        }
    }
    __syncthreads();
}

namespace pg8 {
constexpr int BM = 256, BK = 64, HALF = 128, HTB = HALF * BK * 2, STAGE_BYTES = 8 * HTB, NXCD = 8, WGM = 8;
__host__ __device__ __forceinline__ int lds_byte(int r, int c) { const int st = (r >> 4) * 2 + (c >> 5), rr = r & 15, cc = c & 31, ob = rr * 64 + cc * 2; return st * 1024 + (ob ^ (((ob >> 9) & 1) << 5)); }
__host__ __device__ __forceinline__ void stage_rc(int b, int& R, int& C) { const int st = b / 1024, sb = b % 1024, swz = sb ^ (((sb >> 9) & 1) << 5); R = (st >> 1) * 16 + swz / 64; C = (st & 1) * 32 + (swz % 64) / 2; }
__host__ __device__ __forceinline__ int perm32(int rho) { const int n = rho >> 4, i = rho & 15; return 8 * (i >> 2) + 4 * n + (i & 3); }

struct Unit { int pm, pn, seg, z; };
struct Gemm { const bf16_t* A0; const bf16_t* B0; const bf16_t* A1; const bf16_t* B1; int lda, ldb, K, zA, zB; };
struct Sched {
    int nM0, nN0, nM1, nN1, n0, ntot, G, c;
    __device__ void init(int nM0_, int nN0_, int nz0, int nM1_, int nN1_, int nz1, int G_, int c_) { nM0 = nM0_; nN0 = nN0_; nM1 = nM1_; nN1 = nN1_; n0 = nM0 * nN0 * nz0; ntot = n0 + nM1 * nN1 * nz1; G = G_; c = c_; }
    __device__ bool next(int i, Unit& u) const {
        int L = i * G + c; if (L >= ntot) return false;
        int nM = nM0, nN = nN0; u.seg = 0; if (L >= n0) { L -= n0; nM = nM1; nN = nN1; u.seg = 1; }
        const int nwg = nM * nN; u.z = L / nwg; int wgid = L - u.z * nwg;
        { const int q = nwg / NXCD, r = nwg % NXCD, xcd = wgid % NXCD, off = wgid / NXCD; wgid = (xcd < r ? xcd * (q + 1) : r * (q + 1) + (xcd - r) * q) + off; }
        const int nig = WGM * nN, gid = wgid / nig, fm = gid * WGM, gsz = (nM - fm) < WGM ? (nM - fm) : WGM;
        u.pm = fm + ((wgid % nig) % gsz); u.pn = (wgid % nig) / gsz; return true;
    }
};
template <class Epi>
__device__ __forceinline__ void gemm_phase(LAS unsigned char* lds, const Gemm g, const Sched& S, const Epi& E) {
    int tid_ = threadIdx.x; asm volatile("" : "+v"(tid_));
    const int tid = tid_, wid = __builtin_amdgcn_readfirstlane(tid >> 6), lane = tid & 63, wr = wid >> 2, wc = wid & 3, fr = lane & 15, fq = lane >> 4;
    int K_ = g.K; asm volatile("" : "+s"(K_));
    const int K = K_, nt = K / BK;
    unsigned voffA[2], voffB[2];
#pragma unroll
    for (int i = 0; i < 2; ++i) { int R, C; stage_rc(tid * 16 + i * 8192, R, C); const int Rb = (R & ~31) + perm32(R & 31);
        voffA[i] = (unsigned)(R * g.lda + C) * 2u; voffB[i] = (unsigned)(Rb * g.ldb + C) * 2u; }
    const size_t kstep = (size_t)(BK * 2);
    const size_t hstepA = (size_t)HALF * g.lda * 2, hstepB = (size_t)HALF * g.ldb * 2;
    const unsigned ldsw = (unsigned)wid * 1024u;
    const int aoff = lds_byte(wr * 64 + fr, fq * 8), boff = lds_byte(wc * 32 + fr, fq * 8);
#define PG8_SA(b, h) (((b) * 2 + (h)) * HTB)
#define PG8_SB(b, h) ((4 + (b) * 2 + (h)) * HTB)
#define PG8_STAGE(bufoff, gbase, voff) do { _Pragma("unroll") for (int _i = 0; _i < 2; ++_i) \
        __builtin_amdgcn_global_load_lds((const unsigned*)((const char*)(gbase) + (voff)[_i]), (LAS unsigned*)(lds + (bufoff) + ldsw + _i * 8192), 16, 0, 0); } while (0)
#define PG8_LDA(dst, b, h) do { _Pragma("unroll") for (int m = 0; m < 4; ++m) _Pragma("unroll") for (int k = 0; k < 2; ++k) dst[m][k] = *(const LAS bf16x8*)(lds + PG8_SA(b, h) + aoff + m * 2048 + k * 1024); } while (0)
#define PG8_LDB(dst, b, h) do { _Pragma("unroll") for (int n = 0; n < 2; ++n) _Pragma("unroll") for (int k = 0; k < 2; ++k) dst[n][k] = *(const LAS bf16x8*)(lds + PG8_SB(b, h) + boff + n * 2048 + k * 1024); } while (0)
#define PG8_MMA(ai, bj, At, Bt) do { __builtin_amdgcn_s_setprio(1); _Pragma("unroll") for (int m = 0; m < 4; ++m) _Pragma("unroll") for (int n = 0; n < 2; ++n) _Pragma("unroll") for (int k = 0; k < 2; ++k) \
        acc[ai][bj][m][n] = __builtin_amdgcn_mfma_f32_16x16x32_bf16(Bt[n][k], At[m][k], acc[ai][bj][m][n], 0, 0, 0); __builtin_amdgcn_s_setprio(0); } while (0)
#define PG8_WAIT_V(n) asm volatile("s_waitcnt vmcnt(" #n ")" ::: "memory")
#define PG8_WAIT_L(n) asm volatile("s_waitcnt lgkmcnt(" #n ")" ::: "memory")
#define PG8_BAR __builtin_amdgcn_s_barrier()
#define PG8_SCHED __builtin_amdgcn_sched_barrier(0)
#define PG8_ABASE(u) ((const char*)((u).seg ? g.A1 : g.A0) + ((size_t)(u).z * g.zA) * 2 + (size_t)(u).pm * 2 * hstepA)
#define PG8_BBASE(u) ((const char*)((u).seg ? g.B1 : g.B0) + ((size_t)(u).z * g.zB) * 2 + (size_t)(u).pn * 2 * hstepB)
    Unit cur, nxt; int ui = 0;
    if (!S.next(0, cur)) return;
    f32x4 acc[2][2][4][2];
#pragma unroll
    for (int a = 0; a < 2; ++a)
#pragma unroll
        for (int b = 0; b < 2; ++b)
#pragma unroll
            for (int m = 0; m < 4; ++m)
#pragma unroll
                for (int n = 0; n < 2; ++n) acc[a][b][m][n] = (f32x4){0.f, 0.f, 0.f, 0.f};
    bf16x8 At[4][2], B0[2][2], B1[2][2];
    const char* cA = PG8_ABASE(cur); const char* cB = PG8_BBASE(cur);
    PG8_STAGE(PG8_SB(0, 0), cB, voffB); PG8_STAGE(PG8_SB(0, 1), cB + hstepB, voffB); PG8_STAGE(PG8_SA(0, 0), cA, voffA); PG8_STAGE(PG8_SA(0, 1), cA + hstepA, voffA);
    if (wr == 1) PG8_BAR;
    PG8_WAIT_V(2); PG8_BAR;
    PG8_STAGE(PG8_SB(1, 0), cB + kstep, voffB); PG8_STAGE(PG8_SA(1, 0), cA + kstep, voffA); PG8_STAGE(PG8_SB(1, 1), cB + hstepB + kstep, voffB);
    PG8_WAIT_V(6); PG8_BAR;
    for (;;) {
        const bool has_next = S.next(ui + 1, nxt);
        const char* nA = has_next ? PG8_ABASE(nxt) : cA; const char* nB = has_next ? PG8_BBASE(nxt) : cB;
#ifndef MK_KLOOP_PASSES
#define MK_KLOOP_PASSES 1
#endif
        _Pragma("nounroll") for (int pass_ = 0; pass_ < MK_KLOOP_PASSES; ++pass_) {
        const bool lastpass_ = pass_ == MK_KLOOP_PASSES - 1;
        for (int t = 0; t < nt; t += 2) {
            if constexpr (Epi::MID_HOOK) { if (t == (nt >> 1)) E.mid(acc, cur, wr, wc, fr, fq); }
            const bool last = (t == nt - 2);
            const char* a1 = cA + (size_t)(t + 1) * kstep;
            const char* a2 = last ? (lastpass_ ? nA : cA) : cA + (size_t)(t + 2) * kstep; const char* b2 = last ? (lastpass_ ? nB : cB) : cB + (size_t)(t + 2) * kstep;
            const char* a3 = a2 + kstep; const char* b3 = b2 + kstep;
            PG8_LDB(B0, 0, 0); PG8_LDB(B1, 0, 1); PG8_SCHED; PG8_LDA(At, 0, 0); PG8_STAGE(PG8_SA(1, 1), a1 + hstepA, voffA);
            PG8_WAIT_V(8); PG8_WAIT_L(0); PG8_BAR; PG8_MMA(0, 0, At, B0); PG8_MMA(0, 1, At, B1); PG8_BAR; PG8_SCHED;
            PG8_LDA(At, 0, 1); PG8_STAGE(PG8_SB(0, 0), b2, voffB); PG8_STAGE(PG8_SB(0, 1), b2 + hstepB, voffB); PG8_STAGE(PG8_SA(0, 0), a2, voffA);
            PG8_WAIT_V(8); PG8_WAIT_L(0); PG8_BAR; PG8_MMA(1, 0, At, B0); PG8_MMA(1, 1, At, B1); PG8_BAR; PG8_SCHED;
            PG8_LDB(B0, 1, 0); PG8_LDB(B1, 1, 1); PG8_SCHED; PG8_LDA(At, 1, 0); PG8_STAGE(PG8_SA(0, 1), a2 + hstepA, voffA);
            PG8_WAIT_V(8); PG8_WAIT_L(0); PG8_BAR; PG8_MMA(0, 0, At, B0); PG8_MMA(0, 1, At, B1); PG8_BAR; PG8_SCHED;
            PG8_LDA(At, 1, 1); PG8_STAGE(PG8_SB(1, 0), b3, voffB); PG8_STAGE(PG8_SB(1, 1), b3 + hstepB, voffB); PG8_STAGE(PG8_SA(1, 0), a3, voffA);
            PG8_WAIT_V(8); PG8_WAIT_L(0); PG8_BAR; PG8_MMA(1, 0, At, B0); PG8_MMA(1, 1, At, B1); PG8_BAR; PG8_SCHED;
        }
        if (!lastpass_) {
#pragma unroll
            for (int a = 0; a < 2; ++a)
#pragma unroll
                for (int b = 0; b < 2; ++b)
#pragma unroll
                    for (int m = 0; m < 4; ++m)
#pragma unroll
                        for (int n = 0; n < 2; ++n) acc[a][b][m][n] = (f32x4){0.f, 0.f, 0.f, 0.f}; }
        }
        if (wr == 0) PG8_BAR;
        if constexpr (Epi::NEEDS_RS) {
            if (tid < 256) { const float* q_ = E.SSQ + (size_t)((cur.seg ? cur.pn : cur.pm) * 256 + tid) * 16; const f32x4 a_ = *(const f32x4*)q_, b_ = *(const f32x4*)(q_ + 4), c_ = *(const f32x4*)(q_ + 8), d_ = *(const f32x4*)(q_ + 12);
                const float s_ = ((a_.x + a_.y) + (a_.z + a_.w)) + ((b_.x + b_.y) + (b_.z + b_.w)) + ((c_.x + c_.y) + (c_.z + c_.w)) + ((d_.x + d_.y) + (d_.z + d_.w));
                ((LAS float*)(lds + STAGE_BYTES))[tid] = 1.f / sqrtf(s_ * (1.f / 1024.f) + 1e-6f); }
            PG8_WAIT_L(0); PG8_BAR; asm volatile("" ::: "memory");
        }
        E(acc, cur, wr, wc, fr, fq, (const LAS float*)(lds + STAGE_BYTES));
        if (!has_next) break;
#pragma unroll
        for (int a = 0; a < 2; ++a)
#pragma unroll
            for (int b = 0; b < 2; ++b)
#pragma unroll
                for (int m = 0; m < 4; ++m)
#pragma unroll
                    for (int n = 0; n < 2; ++n) acc[a][b][m][n] = (f32x4){0.f, 0.f, 0.f, 0.f};
        cur = nxt; cA = nA; cB = nB; ++ui;
        if (wr == 1) PG8_BAR;
    }
    PG8_WAIT_V(0);
    PG8_BAR;
#undef PG8_SA
#undef PG8_SB
#undef PG8_STAGE
#undef PG8_LDA
#undef PG8_LDB
#undef PG8_MMA
#undef PG8_WAIT_V
#undef PG8_WAIT_L
#undef PG8_BAR
#undef PG8_SCHED
#undef PG8_ABASE
#undef PG8_BBASE
}
}
constexpr size_t MiB = 1u << 20;
constexpr size_t SZ_TD2 = (size_t)T * D * 2;
constexpr size_t WS_CTL = 0;
constexpr size_t WS_W = 1 * MiB;
constexpr size_t W_UP1 = WS_W, W_DN1 = W_UP1 + (size_t)2 * FF * D * 2, W_IN = W_DN1 + (size_t)D * FF * 2;
constexpr int NIN = 8448;
constexpr size_t W_QK = W_IN + (size_t)NIN * D * 2, W_PA = W_QK + (size_t)512 * D * 2, W_PB = W_PA + (size_t)D * D * 2, W_O = W_PB + (size_t)D * D * 2;
constexpr size_t W_UP2 = W_O + (size_t)D * D * 2, W_DN2 = W_UP2 + (size_t)2 * FF * D * 2, W_END = W_DN2 + (size_t)D * FF * 2;
static_assert(W_END <= 61 * MiB, "weights");
constexpr size_t WS_XBF = 61 * MiB;
constexpr size_t WS_MISC = WS_XBF + SZ_TD2;
constexpr size_t M_SSQ = WS_MISC;
constexpr size_t M_GATES = M_SSQ + (size_t)T * 16 * 4;
constexpr size_t M_SC = M_GATES + (size_t)T * 32 * 4;
constexpr size_t M_EAL = M_SC + (size_t)5 * NH * T * 4;
constexpr size_t M_DEN = M_EAL + (size_t)384 * GKW * 4;
constexpr size_t M_END = M_DEN + (size_t)T * 4 * 4;
static_assert(M_END <= WS_MISC + 6 * MiB, "misc");
constexpr size_t WS_ACT = WS_MISC + 6 * MiB;
constexpr size_t A_Q = WS_ACT, A_K = A_Q + SZ_TD2, A_QT = A_K + SZ_TD2;
constexpr size_t WS_SIG = WS_ACT + 94 * MiB;
constexpr size_t S_SIGO = WS_SIG, S_SILUR = S_SIGO + SZ_TD2, S_SIGA = S_SILUR + SZ_TD2, S_SIGB = S_SIGA + SZ_TD2;
constexpr size_t WS_VT = WS_SIG + 4 * SZ_TD2;
constexpr size_t WS_KT = WS_VT + 2 * SZ_TD2;
constexpr size_t WS_G = WS_KT + SZ_TD2;
constexpr size_t G_KT = WS_G, G_KTT = WS_G + SZ_TD2 / 2;
constexpr size_t WS_HN = WS_G + SZ_TD2;
constexpr size_t WS_END = WS_HN + SZ_TD2;
static_assert(A_QT + SZ_TD2 / 2 <= WS_SIG && WS_END <= 502 * MiB, "ws map");
constexpr size_t O_YP = 0, O_YS = 16777216, O_CONVP = 17825792, O_CP = 17850368, O_NP = 19947520, O_MP = 19955712, O_SP = 19955744, O_CONVS = 21004320, O_CS = 21397536, O_NS = 54951968, O_MS = 55083040, O_SS = 55083552, O_END = 71860768;
constexpr size_t DO_OG = 0;
constexpr size_t DO_U = O_CS * 4, DO_QG = DO_U + SZ_TD2, DO_KG = DO_QG + SZ_TD2 / 2, DO_CH = DO_KG + SZ_TD2 / 2;
static_assert(DO_CH + SZ_TD2 <= O_NS * 4, "d_out temporaries");

struct P {
    const float* in[28]; float* out; unsigned char* ws;
};
#define WSP(T_, off) ((T_*)(p.ws + (off)))
#define DOP(T_, off) ((T_*)((unsigned char*)p.out + (off)))

__device__ __forceinline__ int win_src(int n) {
    if (n < 1024) return n;
    if (n < 2048) return 2048 + (n - 1024);
    if (n < 2560) return 3080 + (n - 2048);
    if (n < 3072) return 3592 + (n - 2560);
    if (n < 4096) return 5128 + (n - 3072);
    if (n < 5120) return 6168 + (n - 4096);
    if (n < 6144) return 7192 + (n - 5120);
    if (n < 6400) { const int j = n - 6144; return j < 8 ? 3072 + j : (j < 24 ? 6152 + (j - 8) : -1); }
    if (n < 7424) return 1024 + (n - 6400);
    return 4104 + (n - 7424);
}
__device__ __forceinline__ int up_src(int n) { const int t = n >> 8, r = n & 255; return (r >> 7) * FF + t * 128 + (r & 127); }
template <int MAP>
__device__ __forceinline__ void p0_item(const float* W, int K, int N, const float* gk, float scale, bf16_t* WT, int dst_row0, int ndst, LAS float* scr, int item, int lane, int ldw = 0, int kd0 = 0) {
    if (ldw == 0) ldw = K;
    const int nblk = ndst / 32, kb = item / nblk, nb = item % nblk, k0 = 64 * kb, n0 = 32 * nb;
    const int nn = n0 + (lane & 31); const int src = MAP == 0 ? nn : (MAP == 1 ? up_src(nn) : win_src(nn));
    float v[32];
#pragma unroll
    for (int i = 0; i < 32; ++i) { const int kk = 2 * i + (lane >> 5); v[i] = src >= 0 ? W[(size_t)(k0 + kk) * N + src] : 0.f; }
#pragma unroll
    for (int i = 0; i < 32; ++i) scr[(2 * i + (lane >> 5)) * 33 + (lane & 31)] = v[i];
    asm volatile("s_waitcnt lgkmcnt(0)" ::: "memory");
    const int c = lane & 7;
    f32x4 g0 = {scale, scale, scale, scale}, g1 = g0;
    if (gk) { g0 = *(const f32x4*)(gk + k0 + 8 * c) * scale; g1 = *(const f32x4*)(gk + k0 + 8 * c + 4) * scale; }
#pragma unroll
    for (int j = 0; j < 4; ++j) { const int n = (lane >> 3) + 8 * j; const LAS float* s = scr + (8 * c) * 33 + n;
        u32x4 o; o.x = pk2(s[0 * 33] * g0[0], s[1 * 33] * g0[1]); o.y = pk2(s[2 * 33] * g0[2], s[3 * 33] * g0[3]); o.z = pk2(s[4 * 33] * g1[0], s[5 * 33] * g1[1]); o.w = pk2(s[6 * 33] * g1[2], s[7 * 33] * g1[3]);
        *(u32x4*)(WT + (size_t)(dst_row0 + n0 + n) * ldw + kd0 + k0 + 8 * c) = o; }
    asm volatile("s_waitcnt lgkmcnt(0)" ::: "memory");
}
__device__ __forceinline__ void p0_prologue(const P& p, LAS unsigned char* lds, int gw, int NGW, int wave, int lane) {
    LAS float* scr = (LAS float*)(lds + wave * 16384);
    constexpr int I_UP = (D / 64) * (2 * FF / 32), I_DN = (FF / 64) * (D / 32), I_IN = (D / 64) * (NIN / 32), I_QK = (D / 64) * (256 / 32), I_SQ = (D / 64) * (D / 32);
    constexpr int NITEMS = 2 * I_UP + 2 * I_DN + I_IN + 2 * I_QK + 3 * I_SQ;
    for (int it = gw; it < NITEMS; it += NGW) {
        int r = it;
        if (r < I_IN) { p0_item<2>(p.in[11], D, INW, p.in[10], 1.f, WSP(bf16_t, W_IN), 0, NIN, scr, r, lane); continue; } r -= I_IN;
        if (r < I_UP) { p0_item<1>(p.in[8], D, 2 * FF, p.in[7], 1.f, WSP(bf16_t, W_UP1), 0, 2 * FF, scr, r, lane); continue; } r -= I_UP;
        if (r < I_UP) { p0_item<1>(p.in[25], D, 2 * FF, p.in[24], 1.f, WSP(bf16_t, W_UP2), 0, 2 * FF, scr, r, lane); continue; } r -= I_UP;
        if (r < I_DN) { p0_item<0>(p.in[9], FF, D, nullptr, 1.f, WSP(bf16_t, W_DN1), 0, D, scr, r, lane); continue; } r -= I_DN;
        if (r < I_DN) { p0_item<0>(p.in[26], FF, D, nullptr, 1.f, WSP(bf16_t, W_DN2), 0, D, scr, r, lane); continue; } r -= I_DN;
        if (r < I_QK) { p0_item<0>(p.in[14], D, 256, nullptr, 1.f, WSP(bf16_t, W_QK), 0, 256, scr, r, lane); continue; } r -= I_QK;
        if (r < I_QK) { p0_item<0>(p.in[15], D, 256, nullptr, 0.0625f, WSP(bf16_t, W_QK), 256, 256, scr, r, lane); continue; } r -= I_QK;
        if (r < I_SQ) { p0_item<0>(p.in[21], D, D, nullptr, 1.f, WSP(bf16_t, W_PA), 0, D, scr, r, lane, 2 * D, 0); continue; } r -= I_SQ;
        if (r < I_SQ) { p0_item<0>(p.in[22], D, D, nullptr, 1.f, WSP(bf16_t, W_PA), 0, D, scr, r, lane, 2 * D, D); continue; } r -= I_SQ;
        p0_item<0>(p.in[23], D, D, nullptr, 1.f, WSP(bf16_t, W_O), 0, D, scr, r, lane);
    }
    bf16_t* XB = WSP(bf16_t, WS_XBF); float* SSQ = WSP(float, M_SSQ);
    for (int m0 = 2 * gw; m0 < T; m0 += 2 * NGW) {
        f32x4 v[2][4];
#pragma unroll
        for (int r = 0; r < 2; ++r) { const int m = m0 + r; const float* xrow = m < T_P ? p.in[0] + (size_t)m * D : p.in[1] + (size_t)(m - T_P) * D; const f32x4* xr = (const f32x4*)xrow + lane;
#pragma unroll
            for (int j = 0; j < 4; ++j) v[r][j] = xr[64 * j]; }
#pragma unroll
        for (int r = 0; r < 2; ++r) { const int m = m0 + r; float s = 0.f;
#pragma unroll
            for (int j = 0; j < 4; ++j) s += (v[r][j].x * v[r][j].x + v[r][j].y * v[r][j].y) + (v[r][j].z * v[r][j].z + v[r][j].w * v[r][j].w);
            s = wave_sum(s);
            u32x2* o8 = (u32x2*)(XB + (size_t)m * D) + lane;
#pragma unroll
            for (int j = 0; j < 4; ++j) { u32x2 w; w.x = pk2(v[r][j].x, v[r][j].y); w.y = pk2(v[r][j].z, v[r][j].w); o8[64 * j] = w; }
            if (lane < 16) SSQ[(size_t)m * 16 + lane] = lane == 0 ? s : 0.f; }
    }
}
__device__ __forceinline__ float row_rs(const float* SSQ, int row) {
    const f32x4* q = (const f32x4*)(SSQ + (size_t)row * 16); const f32x4 a = q[0], b = q[1], c = q[2], d = q[3];
    const float s = ((a.x + a.y) + (a.z + a.w)) + ((b.x + b.y) + (b.z + b.w)) + ((c.x + c.y) + (c.z + c.w)) + ((d.x + d.y) + (d.z + d.w));
    return 1.f / sqrtf(s * (1.f / D) + EPS);
}

typedef pg8::Unit Unit;
#define EPI_ARGS const f32x4 (&acc)[2][2][4][2], const Unit& u, int wr, int wc, int fr, int fq, const LAS float* rst
struct EpiUp { static constexpr bool NEEDS_RS = true; static constexpr bool MID_HOOK = false; const float* SSQ; bf16_t* ACT;
    __device__ __forceinline__ void operator()(EPI_ARGS) const {
        const int row0 = u.pm * 256 + wr * 64 + fr, col0 = u.pn * 128 + wc * 32 + 8 * fq;
#pragma unroll
        for (int ai = 0; ai < 2; ++ai)
#pragma unroll
            for (int m = 0; m < 4; ++m) { const int row = row0 + ai * 128 + m * 16; const float rs = rst[wr * 64 + fr + ai * 128 + m * 16]; u32x4 w; unsigned* wp = (unsigned*)&w;
#pragma unroll
                for (int n = 0; n < 2; ++n) { const f32x4 a = acc[ai][0][m][n] * rs, g = acc[ai][1][m][n] * rs;
                    wp[2 * n] = pk2(silu_(g[0]) * a[0], silu_(g[1]) * a[1]); wp[2 * n + 1] = pk2(silu_(g[2]) * a[2], silu_(g[3]) * a[3]); }
                *(u32x4*)(ACT + (size_t)row * FF + col0) = w; }
    }
};
template <int MODE> struct EpiRes { static constexpr bool NEEDS_RS = false; static constexpr bool MID_HOOK = false; bf16_t* XB; float* XO; float* SSQ; float alpha;
    __device__ __forceinline__ void operator()(EPI_ARGS) const {
        const int row0 = u.pm * 256 + wr * 64 + fr;
#pragma unroll
        for (int ai = 0; ai < 2; ++ai)
#pragma unroll
            for (int m = 0; m < 4; ++m) { const int row = row0 + ai * 128 + m * 16; float ss = 0.f;
#pragma unroll
                for (int bj = 0; bj < 2; ++bj) { const int col = u.pn * 256 + bj * 128 + wc * 32 + 8 * fq; const size_t off = (size_t)row * D + col;
                    const u32x4 xw = *(const u32x4*)(XB + off);
                    const f32x4 x0 = {bflo(xw.x), bfhi(xw.x), bflo(xw.y), bfhi(xw.y)}, x1 = {bflo(xw.z), bfhi(xw.z), bflo(xw.w), bfhi(xw.w)};
                    const f32x4 y0 = x0 + acc[ai][bj][m][0] * alpha, y1 = x1 + acc[ai][bj][m][1] * alpha;
                    if (MODE == 0) { ss += (y0[0] * y0[0] + y0[1] * y0[1]) + (y0[2] * y0[2] + y0[3] * y0[3]) + (y1[0] * y1[0] + y1[1] * y1[1]) + (y1[2] * y1[2] + y1[3] * y1[3]);
                        u32x4 w; w.x = pk2(y0[0], y0[1]); w.y = pk2(y0[2], y0[3]); w.z = pk2(y1[0], y1[1]); w.w = pk2(y1[2], y1[3]); *(u32x4*)(XB + off) = w; }
                    else { *(f32x4*)(XO + off) = y0; *(f32x4*)(XO + off + 4) = y1; } }
                if (MODE == 0) { ss += __shfl_xor(ss, 16); ss += __shfl_xor(ss, 32); if (fq == 0) SSQ[(size_t)row * 16 + u.pn * 4 + wc] = ss; } }
    }
};
struct EpiIn { static constexpr bool NEEDS_RS = true; static constexpr bool MID_HOOK = false; const float* SSQ; bf16_t *U, *SIGO, *QG, *KG, *SILUR, *SIGA, *SIGB, *VT; float* GATES;
    __device__ __forceinline__ void operator()(EPI_ARGS) const {
        if (u.seg == 0) {
            const int row0 = u.pm * 256 + wr * 64 + fr; const int pn = u.pn;
            bf16_t* dst; int ld, cb, act;
            if (pn < 4) { dst = U; ld = D; cb = pn * 256; act = 0; } else if (pn < 8) { dst = SIGO; ld = D; cb = (pn - 4) * 256; act = 1; }
            else if (pn < 10) { dst = QG; ld = GKW; cb = (pn - 8) * 256; act = 0; } else if (pn < 12) { dst = KG; ld = GKW; cb = (pn - 10) * 256; act = 0; }
            else if (pn < 16) { dst = SILUR; ld = D; cb = (pn - 12) * 256; act = 2; } else if (pn < 20) { dst = SIGA; ld = D; cb = (pn - 16) * 256; act = 1; }
            else { dst = SIGB; ld = D; cb = (pn - 20) * 256; act = 1; }
#pragma unroll
            for (int ai = 0; ai < 2; ++ai)
#pragma unroll
                for (int m = 0; m < 4; ++m) { const int row = row0 + ai * 128 + m * 16; const float rs = rst[wr * 64 + fr + ai * 128 + m * 16];
                    if (pn == 24) { if (wc == 0) { *(f32x4*)(GATES + (size_t)row * 32 + 8 * fq) = acc[ai][0][m][0] * rs; *(f32x4*)(GATES + (size_t)row * 32 + 8 * fq + 4) = acc[ai][0][m][1] * rs; } continue; }
#pragma unroll
                    for (int bj = 0; bj < 2; ++bj) { f32x4 v0 = acc[ai][bj][m][0] * rs, v1 = acc[ai][bj][m][1] * rs;
                        if (act == 1) { for (int i = 0; i < 4; ++i) { v0[i] = sigmoid_(v0[i]); v1[i] = sigmoid_(v1[i]); } }
                        else if (act == 2) { for (int i = 0; i < 4; ++i) { v0[i] = silu_(v0[i]); v1[i] = silu_(v1[i]); } }
                        u32x4 w; w.x = pk2(v0[0], v0[1]); w.y = pk2(v0[2], v0[3]); w.z = pk2(v1[0], v1[1]); w.w = pk2(v1[2], v1[3]);
                        *(u32x4*)(dst + (size_t)row * ld + cb + bj * 128 + wc * 32 + 8 * fq) = w; } }
        } else {
            const int vrow0 = u.pm * 256 + wr * 64 + fr;
            float rs[2][8];
#pragma unroll
            for (int bj = 0; bj < 2; ++bj)
#pragma unroll
                for (int j = 0; j < 8; ++j) rs[bj][j] = rst[bj * 128 + wc * 32 + 8 * fq + j];
#pragma unroll
            for (int ai = 0; ai < 2; ++ai)
#pragma unroll
                for (int m = 0; m < 4; ++m) { const int vr = vrow0 + ai * 128 + m * 16;
#pragma unroll
                    for (int bj = 0; bj < 2; ++bj) { const f32x4 a0 = acc[ai][bj][m][0], a1 = acc[ai][bj][m][1]; u32x4 w;
                        w.x = pk2(a0[0] * rs[bj][0], a0[1] * rs[bj][1]); w.y = pk2(a0[2] * rs[bj][2], a0[3] * rs[bj][3]); w.z = pk2(a1[0] * rs[bj][4], a1[1] * rs[bj][5]); w.w = pk2(a1[2] * rs[bj][6], a1[3] * rs[bj][7]);
                        *(u32x4*)(VT + (size_t)vr * T + u.pn * 256 + bj * 128 + wc * 32 + 8 * fq) = w; } }
        }
    }
};
struct EpiQK { static constexpr bool NEEDS_RS = false; static constexpr bool MID_HOOK = false; bf16_t *Q, *K, *KT;
    __device__ __forceinline__ void operator()(EPI_ARGS) const {
        const int row0 = u.pm * 256 + wr * 64 + fr;
#pragma unroll
        for (int ai = 0; ai < 2; ++ai)
#pragma unroll
            for (int m = 0; m < 4; ++m) { const int row = row0 + ai * 128 + m * 16;
#pragma unroll
                for (int bj = 0; bj < 2; ++bj) { const f32x4 v0 = acc[ai][bj][m][0], v1 = acc[ai][bj][m][1]; const int cc = bj * 128 + wc * 32 + 8 * fq;
                    u32x4 w; w.x = pk2(v0[0], v0[1]); w.y = pk2(v0[2], v0[3]); w.z = pk2(v1[0], v1[1]); w.w = pk2(v1[2], v1[3]);
                    if (u.seg == 0) *(u32x4*)((u.pn == 0 ? Q : K) + (size_t)row * D + u.z * 256 + cc) = w;
                    else *(u32x4*)(KT + (size_t)(u.z * 256 + row) * T + u.pn * 256 + cc) = w; } }
    }
};
struct EpiMerge { static constexpr bool NEEDS_RS = false; static constexpr bool MID_HOOK = true; const bf16_t* GA; const bf16_t* GB; bf16_t* Y;
    __device__ __forceinline__ void mid(f32x4 (&acc)[2][2][4][2], const Unit& u, int wr, int wc, int fr, int fq) const {
        int row0 = u.pm * 256 + wr * 64 + fr; asm volatile("" : "+v"(row0));
#pragma unroll
        for (int ai = 0; ai < 2; ++ai)
#pragma unroll
            for (int m = 0; m < 4; ++m) { const int row = row0 + ai * 128 + m * 16;
#pragma unroll
                for (int bj = 0; bj < 2; ++bj) { const size_t off = (size_t)row * D + u.pn * 256 + bj * 128 + wc * 32 + 8 * fq;
                    const u32x4 a = *(const u32x4*)(GA + off), b = *(const u32x4*)(GB + off);
#define RAT(x, y) ((x) * __builtin_amdgcn_rcpf(fmaxf((y), 1e-30f)))
                    const f32x4 r0 = {RAT(bflo(a.x), bflo(b.x)), RAT(bfhi(a.x), bfhi(b.x)), RAT(bflo(a.y), bflo(b.y)), RAT(bfhi(a.y), bfhi(b.y))};
                    const f32x4 r1 = {RAT(bflo(a.z), bflo(b.z)), RAT(bfhi(a.z), bfhi(b.z)), RAT(bflo(a.w), bflo(b.w)), RAT(bfhi(a.w), bfhi(b.w))};
#undef RAT
                    acc[ai][bj][m][0] = acc[ai][bj][m][0] * r0; acc[ai][bj][m][1] = acc[ai][bj][m][1] * r1; }
                asm volatile("" ::: "memory"); }
    }
    __device__ __forceinline__ void operator()(EPI_ARGS) const {
        const int row0 = u.pm * 256 + wr * 64 + fr;
#pragma unroll
        for (int ai = 0; ai < 2; ++ai)
#pragma unroll
            for (int m = 0; m < 4; ++m) { const int row = row0 + ai * 128 + m * 16;
#pragma unroll
                for (int bj = 0; bj < 2; ++bj) { const size_t off = (size_t)row * D + u.pn * 256 + bj * 128 + wc * 32 + 8 * fq;
                    const u32x4 b = *(const u32x4*)(GB + off);
                    const f32x4 y0 = acc[ai][bj][m][0] * (f32x4){fmaxf(bflo(b.x), 1e-30f), fmaxf(bfhi(b.x), 1e-30f), fmaxf(bflo(b.y), 1e-30f), fmaxf(bfhi(b.y), 1e-30f)};
                    const f32x4 y1 = acc[ai][bj][m][1] * (f32x4){fmaxf(bflo(b.z), 1e-30f), fmaxf(bfhi(b.z), 1e-30f), fmaxf(bflo(b.w), 1e-30f), fmaxf(bfhi(b.w), 1e-30f)};
                    u32x4 w; w.x = pk2(y0[0], y0[1]); w.y = pk2(y0[2], y0[3]); w.z = pk2(y1[0], y1[1]); w.w = pk2(y1[2], y1[3]); *(u32x4*)(Y + off) = w; } }
    }
};
constexpr size_t SC_STRIDE = (size_t)NH * T;
__device__ __forceinline__ void p4_conv(const P& p, size_t gtid, size_t gsz) {
    const bf16_t* __restrict__ U = DOP(const bf16_t, DO_U); bf16_t* __restrict__ CH = DOP(bf16_t, DO_CH);
    const float* __restrict__ cw = p.in[12]; const float* __restrict__ cb = p.in[13]; const float* __restrict__ stc = p.in[2];
    const int c8 = (int)(gtid & 127) * 8; const int bstep = (int)(gsz >> 7);
    float wt[4][8], bs[8];
#pragma unroll
    for (int j = 0; j < 4; ++j) { const f32x4 w0 = *(const f32x4*)(cw + j * D + c8), w1 = *(const f32x4*)(cw + j * D + c8 + 4); wt[j][0] = w0[0]; wt[j][1] = w0[1]; wt[j][2] = w0[2]; wt[j][3] = w0[3]; wt[j][4] = w1[0]; wt[j][5] = w1[1]; wt[j][6] = w1[2]; wt[j][7] = w1[3]; }
    { const f32x4 b0 = *(const f32x4*)(cb + c8), b1 = *(const f32x4*)(cb + c8 + 4); bs[0] = b0[0]; bs[1] = b0[1]; bs[2] = b0[2]; bs[3] = b0[3]; bs[4] = b1[0]; bs[5] = b1[1]; bs[6] = b1[2]; bs[7] = b1[3]; }
    for (int rb = (int)(gtid >> 7); rb < T / 8; rb += bstep) {
        const int row0 = rb * 8; int t0, Tl, seq; if (row0 < T_P) { t0 = row0 & (SEQ - 1); Tl = SEQ; seq = row0 >> 11; } else { t0 = 0; Tl = DEC_T; seq = (row0 - T_P) >> 3; }
        u32x4 ur[11];
#pragma unroll
        for (int i = 0; i < 11; ++i) { if (i >= 3 || t0 > 0) ur[i] = *(const u32x4*)(U + (size_t)(row0 - 3 + i) * D + c8); else ur[i] = (u32x4){0u, 0u, 0u, 0u}; }
        float h[3][8];
        const bool st_halo = (t0 == 0) && (row0 >= T_P);
#pragma unroll
        for (int i = 0; i < 3; ++i) { if (st_halo) { const float* s_ = stc + ((size_t)seq * 3 + i) * D + c8; const f32x4 s0 = *(const f32x4*)s_, s1 = *(const f32x4*)(s_ + 4); h[i][0] = s0[0]; h[i][1] = s0[1]; h[i][2] = s0[2]; h[i][3] = s0[3]; h[i][4] = s1[0]; h[i][5] = s1[1]; h[i][6] = s1[2]; h[i][7] = s1[3]; }
            else { h[i][0] = bflo(ur[i].x); h[i][1] = bfhi(ur[i].x); h[i][2] = bflo(ur[i].y); h[i][3] = bfhi(ur[i].y); h[i][4] = bflo(ur[i].z); h[i][5] = bfhi(ur[i].z); h[i][6] = bflo(ur[i].w); h[i][7] = bfhi(ur[i].w); } }
        float win[4][8];
#pragma unroll
        for (int i = 0; i < 3; ++i)
#pragma unroll
            for (int k = 0; k < 8; ++k) win[i][k] = h[i][k];
#pragma unroll
        for (int r = 0; r < 8; ++r) { const u32x4 w = ur[3 + r];
            win[3][0] = bflo(w.x); win[3][1] = bfhi(w.x); win[3][2] = bflo(w.y); win[3][3] = bfhi(w.y); win[3][4] = bflo(w.z); win[3][5] = bfhi(w.z); win[3][6] = bflo(w.w); win[3][7] = bfhi(w.w);
            float a[8];
#pragma unroll
            for (int k = 0; k < 8; ++k) a[k] = bs[k] + win[0][k] * wt[0][k] + win[1][k] * wt[1][k] + win[2][k] * wt[2][k] + win[3][k] * wt[3][k];
            u32x4 o; o.x = pk2(silu_(a[0]), silu_(a[1])); o.y = pk2(silu_(a[2]), silu_(a[3])); o.z = pk2(silu_(a[4]), silu_(a[5])); o.w = pk2(silu_(a[6]), silu_(a[7]));
            *(u32x4*)(CH + (size_t)(row0 + r) * D + c8) = o;
            const int t = t0 + r;
            if (t >= Tl - 3) { float* co = (row0 < T_P ? p.out + O_CONVP : p.out + O_CONVS) + ((size_t)seq * 3 + (t - (Tl - 3))) * D + c8;
                *(f32x4*)co = (f32x4){win[3][0], win[3][1], win[3][2], win[3][3]}; *(f32x4*)(co + 4) = (f32x4){win[3][4], win[3][5], win[3][6], win[3][7]}; }
#pragma unroll
            for (int k = 0; k < 8; ++k) { win[0][k] = win[1][k]; win[1][k] = win[2][k]; win[2][k] = win[3][k]; } }
    }
}
__device__ __forceinline__ void p4_gates(const P& p, LAS unsigned char* lds, int bid, int tid) {
    const float* GATES = WSP(const float, M_GATES); float* SC = WSP(float, M_SC); const float* bif = p.in[16];
    const int lane = tid & 63, w = __builtin_amdgcn_readfirstlane(tid >> 6);
    if (bid < 32) {
        const int b = bid >> 2, h = bid & 3; LAS float* sum = (LAS float*)lds; LAS float* mp = sum + 64;
        const float bi = bif[h], bfg = bif[NH + h]; float a[4], bb[4], cm[4];
#pragma unroll
        for (int j = 0; j < 4; ++j) { const int c = 4 * w + j, row = b * SEQ + c * 64 + lane;
            const float gi = GATES[(size_t)row * 32 + h] + bi, gf = GATES[(size_t)row * 32 + NH + h] + bfg;
            float x = logsigmoid_(gf);
#pragma unroll
            for (int o = 1; o < 64; o <<= 1) { const float y = __shfl_up(x, o, 64); if (lane >= o) x += y; }
            float m = gi - x; a[j] = m;
#pragma unroll
            for (int o = 1; o < 64; o <<= 1) { const float y = __shfl_up(m, o, 64); if (lane >= o) m = fmaxf(m, y); }
            bb[j] = x; cm[j] = m; if (lane == 63) { sum[2 * c] = x; sum[2 * c + 1] = m; } }
        __syncthreads();
        if (tid == 0) { float m = 0.f; for (int c = 0; c < 32; ++c) { mp[c] = m; m = sum[2 * c] + fmaxf(m, sum[2 * c + 1]); } p.out[O_MP + (size_t)b * NH + h] = m; }
        __syncthreads();
#pragma unroll
        for (int j = 0; j < 4; ++j) { const int c = 4 * w + j, row = b * SEQ + c * 64 + lane; const float mprev = mp[c];
            const float Mt = fmaxf(mprev, cm[j]), mt = bb[j] + Mt, ML = __shfl(Mt, 63, 64); const size_t o = (size_t)h * T + row;
            SC[o] = a[j]; SC[SC_STRIDE + o] = Mt; SC[2 * SC_STRIDE + o] = expf(mprev - Mt); SC[3 * SC_STRIDE + o] = expf(a[j] - ML); SC[4 * SC_STRIDE + o] = expf(-mt); }
        __syncthreads();
    } else if (bid < 40) {
        const int job = (bid - 32) * 8 + w, h = job & 3, li = lane & 7, seq = (job >> 2) * 8 + (lane >> 3), row = T_P + seq * 8 + li;
        const float mprev = p.in[5][seq * NH + h];
        const float gi = GATES[(size_t)row * 32 + h] + bif[h], gf = GATES[(size_t)row * 32 + NH + h] + bif[NH + h];
        float b = logsigmoid_(gf);
#pragma unroll
        for (int o = 1; o < 8; o <<= 1) { const float x = __shfl_up(b, o, 8); if (li >= o) b += x; }
        const float a = gi - b; float cm = a;
#pragma unroll
        for (int o = 1; o < 8; o <<= 1) { const float x = __shfl_up(cm, o, 8); if (li >= o) cm = fmaxf(cm, x); }
        const float Mt = fmaxf(mprev, cm), mt = b + Mt, ML = __shfl(Mt, 7, 8), bL = __shfl(b, 7, 8); const size_t o = (size_t)h * T + row;
        SC[o] = a; SC[SC_STRIDE + o] = Mt; SC[2 * SC_STRIDE + o] = expf(mprev - Mt); SC[3 * SC_STRIDE + o] = expf(a - ML); SC[4 * SC_STRIDE + o] = expf(-mt);
        if (li == 7) p.out[O_MS + (size_t)seq * NH + h] = bL + ML;
    }
}
__device__ __forceinline__ void p4_gla(const P& p, LAS unsigned char* lds, int bid, int G, int tid) {
    const float* __restrict__ GATES = WSP(const float, M_GATES); const bf16_t* __restrict__ QG = DOP(const bf16_t, DO_QG); const bf16_t* __restrict__ KG = DOP(const bf16_t, DO_KG);
    bf16_t* __restrict__ QT = WSP(bf16_t, A_QT); bf16_t* __restrict__ KTn = WSP(bf16_t, G_KT); bf16_t* __restrict__ KTT = WSP(bf16_t, G_KTT); float* __restrict__ EAL = WSP(float, M_EAL);
    LAS float* As = (LAS float*)lds;
    LAS bf16_t* Kt = (LAS bf16_t*)(lds + 131072);
    const int c = tid;
    float w2[16];
#pragma unroll
    for (int r = 0; r < 16; ++r) w2[r] = p.in[18][r * GKW + c];
    const float ba = p.in[19][c];
    for (int g = G - 1 - bid; g < NGRP; g += G) {
        const bool smp = g >= NCH_P; float A = 0.f;
#pragma unroll 8
        for (int t = 0; t < 64; ++t) {
            const int row = g * 64 + t;
            if (smp && (t & 7) == 0) A = 0.f;
            const f32x4* ag = (const f32x4*)(GATES + (size_t)row * 32 + 8); float s_ = ba;
#pragma unroll
            for (int r4 = 0; r4 < 4; ++r4) { const f32x4 a4 = ag[r4]; s_ += a4[0] * w2[4 * r4] + a4[1] * w2[4 * r4 + 1] + a4[2] * w2[4 * r4 + 2] + a4[3] * w2[4 * r4 + 3]; }
            A += (fminf(s_, 0.f) - __logf(1.f + __expf(-fabsf(s_)))) * 0.0625f;
            As[t * 512 + c] = A;
            if (smp) { if ((t & 7) == 7) EAL[(size_t)(256 + (g - NCH_P) * 8 + (t >> 3)) * GKW + c] = __expf(A); } else if (t == 63) EAL[(size_t)g * GKW + c] = __expf(A);
        }
        __syncthreads();
        { const int cc = (tid & 63) * 8;
#pragma unroll 4
          for (int j = 0; j < 8; ++j) { const int t = (tid >> 6) + 8 * j; const size_t off = (size_t)(g * 64 + t) * GKW + cc;
              const u32x4 qw = *(const u32x4*)(QG + off), kw = *(const u32x4*)(KG + off);
              const f32x4 a0 = *(const LAS f32x4*)(As + t * 512 + cc), a1 = *(const LAS f32x4*)(As + t * 512 + cc + 4);
              float e[8] = {__expf(a0[0]), __expf(a0[1]), __expf(a0[2]), __expf(a0[3]), __expf(a1[0]), __expf(a1[1]), __expf(a1[2]), __expf(a1[3])};
              float qv[8] = {bflo(qw.x), bfhi(qw.x), bflo(qw.y), bfhi(qw.y), bflo(qw.z), bfhi(qw.z), bflo(qw.w), bfhi(qw.w)};
              float kv[8] = {bflo(kw.x), bfhi(kw.x), bflo(kw.y), bfhi(kw.y), bflo(kw.z), bfhi(kw.z), bflo(kw.w), bfhi(kw.w)};
#pragma unroll
              for (int i = 0; i < 8; ++i) { qv[i] = qv[i] * 0.08838834764831845f * e[i]; kv[i] = kv[i] * __builtin_amdgcn_rcpf(e[i]); }
              u32x4 qo, ko; qo.x = pk2(qv[0], qv[1]); qo.y = pk2(qv[2], qv[3]); qo.z = pk2(qv[4], qv[5]); qo.w = pk2(qv[6], qv[7]); ko.x = pk2(kv[0], kv[1]); ko.y = pk2(kv[2], kv[3]); ko.z = pk2(kv[4], kv[5]); ko.w = pk2(kv[6], kv[7]);
              *(u32x4*)(QT + off) = qo; *(u32x4*)(KTn + off) = ko; } }
        for (int strip = 0; strip < 8; ++strip) {
            __syncthreads();
            { const int t = tid >> 3, cc = (tid & 7) * 8, ch = strip * 64 + cc; const size_t off = (size_t)(g * 64 + t) * GKW + ch;
              const u32x4 kw = *(const u32x4*)(KG + off);
              const f32x4 a0 = *(const LAS f32x4*)(As + t * 512 + ch), a1 = *(const LAS f32x4*)(As + t * 512 + ch + 4);
              float kv[8] = {bflo(kw.x), bfhi(kw.x), bflo(kw.y), bfhi(kw.y), bflo(kw.z), bfhi(kw.z), bflo(kw.w), bfhi(kw.w)};
              const float e[8] = {__expf(-a0[0]), __expf(-a0[1]), __expf(-a0[2]), __expf(-a0[3]), __expf(-a1[0]), __expf(-a1[1]), __expf(-a1[2]), __expf(-a1[3])};
#pragma unroll
              for (int i = 0; i < 8; ++i) Kt[(cc + i) * 72 + t] = (bf16_t)(pk2(kv[i] * e[i], 0.f) & 0xffffu); }
            __syncthreads();
            { const int cr = tid >> 3, t8 = (tid & 7) * 8; const u32x4 w = *(const LAS u32x4*)(Kt + cr * 72 + t8);
              *(u32x4*)(KTT + (size_t)(strip * 64 + cr) * T + g * 64 + t8) = w; }
        }
        __syncthreads();
    }
}

#define MFMA16(a, b, c) __builtin_amdgcn_mfma_f32_16x16x32_bf16(a, b, c, 0, 0, 0)
#define LBAR() do { asm volatile("s_waitcnt lgkmcnt(0)" ::: "memory"); __builtin_amdgcn_s_barrier(); asm volatile("" ::: "memory"); } while (0)
template <bool ML>
__device__ __forceinline__ void scan_prompt(const P& p, LAS unsigned char* lds, int b, int h, int es) {
    constexpr int DK = ML ? 256 : 128, ES = ML ? 64 : 128, NE = ML ? 80 : 128, NET = NE / 16, NDT = DK / 128  , KS = DK / 32;
    constexpr int QS = DK * 2 + 32, VS = 160;
    constexpr int OFF_Q = 0, OFF_K = OFF_Q + 64 * QS, OFF_V = OFF_K + 64 * QS, OFF_S = OFF_V + NE * VS, OFF_C = OFF_S + 64 * VS, OFF_SC = OFF_C + NE * QS;
    static_assert(OFF_SC + 1280 <= 140 * 1024, "scan LDS");
    constexpr int TPW = ML ? 3 : 4;
    constexpr int QPT = 64 * (DK / 8) / NTHR, VPT = ES * 8 / NTHR;
    int tid_ = threadIdx.x; asm volatile("" : "+v"(tid_));
    const int tid = tid_, w = __builtin_amdgcn_readfirstlane(tid >> 6), lane = tid & 63, fr = lane & 15, fq = lane >> 4;
    const size_t row0 = (size_t)b * SEQ;
    const bf16_t* Qg = ML ? WSP(const bf16_t, A_Q) + row0 * D + h * 256 : WSP(const bf16_t, A_QT) + row0 * GKW + h * 128;
    const bf16_t* Kg = ML ? WSP(const bf16_t, A_K) + row0 * D + h * 256 : WSP(const bf16_t, G_KT) + row0 * GKW + h * 128;
    constexpr int LDQ = ML ? D : GKW;
    const bf16_t* VTg = WSP(const bf16_t, WS_VT) + (size_t)((ML ? 0 : 1024) + h * 256 + es * ES) * T + row0;
    const bf16_t* KTg = (ML ? WSP(const bf16_t, WS_KT) + (size_t)(h * 256) * T : WSP(const bf16_t, G_KTT) + (size_t)(h * 128) * T) + row0;
    const float* SC = WSP(const float, M_SC) + (size_t)h * T + row0;
    const float* EALg = WSP(const float, M_EAL) + (size_t)(b * 32) * GKW + h * 128;
    bf16_t* OUT = ML ? WSP(bf16_t, WS_HN) : DOP(bf16_t, DO_OG);
    LAS float* scal = (LAS float*)(lds + OFF_SC);
    for (int i = tid; i < NE * QS / 4; i += NTHR) ((LAS unsigned*)(lds + OFF_C))[i] = 0u;
    for (int i = tid; i < 64 * VS / 4; i += NTHR) ((LAS unsigned*)(lds + OFF_S))[i] = 0u;
    if (ML) for (int i = tid; i < 16 * VS / 4; i += NTHR) ((LAS unsigned*)(lds + OFF_V + ES * VS))[i] = (i < VS / 4) ? 0x3f803f80u : 0u;
    f32x4 accC[NDT][NET];
#pragma unroll
    for (int a = 0; a < NDT; ++a)
#pragma unroll
        for (int e = 0; e < NET; ++e) accC[a][e] = (f32x4){0.f, 0.f, 0.f, 0.f};
    u32x4 sq[QPT], sk[QPT], sv[VPT]; float ssc = 0.f;
#define STAGE_LOAD(c_) do { const size_t r0_ = (size_t)(c_) * 64; \
        _Pragma("unroll") for (int j = 0; j < QPT; ++j) { const int i = tid + NTHR * j, rr = i / (DK / 8), cc = i % (DK / 8); sq[j] = *(const u32x4*)(Qg + (r0_ + rr) * LDQ + cc * 8); sk[j] = *(const u32x4*)(Kg + (r0_ + rr) * LDQ + cc * 8); } \
        _Pragma("unroll") for (int j = 0; j < VPT; ++j) { const int i = tid + NTHR * j, rr = i >> 3, cc = i & 7; sv[j] = *(const u32x4*)(VTg + (size_t)rr * T + r0_ + cc * 8); } \
        if (ML) { if (tid < 320) ssc = SC[(size_t)((tid >> 6) == 3 ? 4 : ((tid >> 6) == 4 ? 3 : (tid >> 6))) * SC_STRIDE + r0_ + (tid & 63)]; } else if (tid < 128) ssc = EALg[(size_t)(c_) * GKW + tid]; } while (0)
#define STAGE_WRITE() do { \
        _Pragma("unroll") for (int j = 0; j < QPT; ++j) { const int i = tid + NTHR * j, rr = i / (DK / 8), cc = i % (DK / 8); *(LAS u32x4*)(lds + OFF_Q + rr * QS + cc * 16) = sq[j]; *(LAS u32x4*)(lds + OFF_K + rr * QS + cc * 16) = sk[j]; } \
        _Pragma("unroll") for (int j = 0; j < VPT; ++j) { const int i = tid + NTHR * j, rr = i >> 3, cc = i & 7; *(LAS u32x4*)(lds + OFF_V + rr * VS + cc * 16) = sv[j]; } \
        if (tid < (ML ? 320 : 128)) scal[tid] = ssc; } while (0)
    STAGE_LOAD(0); STAGE_WRITE(); LBAR();
    for (int c = 0; c < 32; ++c) {
        const size_t r0 = (size_t)c * 64;
        if (c + 1 < 32) STAGE_LOAD(c + 1);
        bf16x8 kt[NDT][2];
#pragma unroll
        for (int a = 0; a < NDT; ++a)
#pragma unroll
            for (int ks = 0; ks < 2; ++ks) kt[a][ks] = *(const bf16x8*)(KTg + (size_t)(16 * (NDT * w + a) + fr) * T + r0 + ks * 32 + 8 * fq);
        if (w < 6) {
            const int st = w < 2 ? 0 : (w == 2 ? 1 : (w == 3 ? 2 : (w == 4 ? 1 : 3))), tt0 = w == 0 ? 0 : (w == 2 ? 1 : (w >= 4 ? 3 : 2)); const int ntl = w < 4 ? 2 : 1;
            f32x4 accS[2] = {(f32x4){0.f, 0.f, 0.f, 0.f}, (f32x4){0.f, 0.f, 0.f, 0.f}};
#pragma unroll
            for (int ks = 0; ks < KS; ++ks) { const bf16x8 af = *(const LAS bf16x8*)(lds + OFF_K + (16 * st + fr) * QS + ks * 64 + fq * 16);
                { const bf16x8 bfr = *(const LAS bf16x8*)(lds + OFF_Q + (16 * tt0 + fr) * QS + ks * 64 + fq * 16); accS[0] = MFMA16(af, bfr, accS[0]); }
                if (ntl == 2) { const bf16x8 bfr = *(const LAS bf16x8*)(lds + OFF_Q + (16 * (tt0 + 1) + fr) * QS + ks * 64 + fq * 16); accS[1] = MFMA16(af, bfr, accS[1]); } }
#pragma unroll
            for (int j = 0; j < 2; ++j) if (j < ntl) { const int t = 16 * (tt0 + j) + fr, s0 = 16 * st + 4 * fq; float v[4];
#pragma unroll
                for (int r = 0; r < 4; ++r) { const int s = s0 + r; float x = accS[j][r]; if (ML) x *= __expf(scal[s] - scal[64 + t]); v[r] = (s <= t) ? x : 0.f; }
                u32x2 wv; wv.x = pk2(v[0], v[1]); wv.y = pk2(v[2], v[3]); *(LAS u32x2*)(lds + OFF_S + t * VS + s0 * 2) = wv; }
        }
        const int ttq = ML ? (w & 3) : (w & 3), et0 = ML ? (w < 4 ? 3 : 0) : 4 * (w >> 2), ntq = ML ? (w < 4 ? 2 : 3) : 4;
        f32x4 accO[TPW];
#pragma unroll
        for (int j = 0; j < TPW; ++j) accO[j] = (f32x4){0.f, 0.f, 0.f, 0.f};
#pragma unroll
        for (int ks = 0; ks < KS; ++ks) { const bf16x8 bfr = *(const LAS bf16x8*)(lds + OFF_Q + (16 * ttq + fr) * QS + ks * 64 + fq * 16);
#pragma unroll
            for (int j = 0; j < TPW; ++j) if (j < ntq) { const bf16x8 af = *(const LAS bf16x8*)(lds + OFF_C + (16 * (et0 + j) + fr) * QS + ks * 64 + fq * 16); accO[j] = MFMA16(af, bfr, accO[j]); } }
        LBAR();
        { const int t = 16 * ttq + fr; const size_t grow = row0 + r0 + t; const int nks = ttq < 2 ? 1 : 2;
#pragma unroll
          for (int j = 0; j < TPW; ++j) if (j < ntq) { const int et = et0 + j;
                if (ML) accO[j] = accO[j] * scal[128 + t];
#pragma unroll
                for (int ks = 0; ks < 2; ++ks) if (ks < nks) { const bf16x8 af = *(const LAS bf16x8*)(lds + OFF_V + (16 * et + fr) * VS + ks * 64 + fq * 16), bfr = *(const LAS bf16x8*)(lds + OFF_S + t * VS + ks * 64 + fq * 16);
                    accO[j] = MFMA16(af, bfr, accO[j]); }
                if (!ML || et < 4) { u32x2 wv; wv.x = pk2(accO[j][0], accO[j][1]); wv.y = pk2(accO[j][2], accO[j][3]); *(u32x2*)(OUT + grow * D + h * 256 + es * ES + 16 * et + 4 * fq) = wv; }
                else if (es == 0 && fq == 0) WSP(float, M_DEN)[grow * 4 + h] = fmaxf(fabsf(accO[j][0]), scal[192 + t]); } }
        if (ML) { const float dec = scal[128 + 63];
#pragma unroll
            for (int a = 0; a < NDT; ++a)
#pragma unroll
                for (int e = 0; e < NET; ++e) accC[a][e] = accC[a][e] * dec;
#pragma unroll
            for (int ks = 0; ks < 2; ++ks) { const f32x4 w0 = *(const LAS f32x4*)(scal + 256 + ks * 32 + 8 * fq), w1 = *(const LAS f32x4*)(scal + 256 + ks * 32 + 8 * fq + 4);
#pragma unroll
                for (int a = 0; a < NDT; ++a) { const u32x4 kw = __builtin_bit_cast(u32x4, kt[a][ks]); u32x4 o;
                    o.x = pk2(bflo(kw.x) * w0[0], bfhi(kw.x) * w0[1]); o.y = pk2(bflo(kw.y) * w0[2], bfhi(kw.y) * w0[3]); o.z = pk2(bflo(kw.z) * w1[0], bfhi(kw.z) * w1[1]); o.w = pk2(bflo(kw.w) * w1[2], bfhi(kw.w) * w1[3]);
                    kt[a][ks] = __builtin_bit_cast(bf16x8, o); } } }
#pragma unroll
        for (int ks = 0; ks < 2; ++ks)
#pragma unroll
            for (int e = 0; e < NET; ++e) { const bf16x8 bfr = *(const LAS bf16x8*)(lds + OFF_V + (16 * e + fr) * VS + ks * 64 + fq * 16);
#pragma unroll
                for (int a = 0; a < NDT; ++a) accC[a][e] = MFMA16(kt[a][ks], bfr, accC[a][e]); }
        if (!ML) {
#pragma unroll
            for (int a = 0; a < NDT; ++a) { const f32x4 ea = *(const LAS f32x4*)(scal + 16 * (NDT * w + a) + 4 * fq);
#pragma unroll
                for (int e = 0; e < NET; ++e) accC[a][e] = accC[a][e] * ea; } }
        LBAR();
#pragma unroll
        for (int a = 0; a < NDT; ++a)
#pragma unroll
            for (int e = 0; e < NET; ++e) { u32x2 wv; wv.x = pk2(accC[a][e][0], accC[a][e][1]); wv.y = pk2(accC[a][e][2], accC[a][e][3]);
                *(LAS u32x2*)(lds + OFF_C + (16 * e + fr) * QS + (16 * (NDT * w + a) + 4 * fq) * 2) = wv; }
        if (c + 1 < 32) STAGE_WRITE();
        LBAR();
    }
    if (ML) { float* Cp = p.out + O_CP + (size_t)(b * NH + h) * HD * HD; float* np = p.out + O_NP + (size_t)(b * NH + h) * HD;
#pragma unroll
        for (int a = 0; a < NDT; ++a) { const int d = 16 * (NDT * w + a) + 4 * fq;
#pragma unroll
            for (int e = 0; e < 4; ++e) *(f32x4*)(Cp + (size_t)(es * 64 + 16 * e + fr) * HD + d) = accC[a][e];
            if (es == 0 && fr == 0) *(f32x4*)(np + d) = accC[a][NET - 1]; }
    } else { float* Sp = p.out + O_SP + (size_t)(b * NH + h) * GDK * GDV;
#pragma unroll
        for (int a = 0; a < NDT; ++a)
#pragma unroll
            for (int e = 0; e < NET; ++e)
#pragma unroll
                for (int r = 0; r < 4; ++r) Sp[(size_t)(16 * (NDT * w + a) + 4 * fq + r) * GDV + es * 128 + 16 * e + fr] = accC[a][e][r]; }
#undef STAGE_LOAD
#undef STAGE_WRITE
    LBAR();
}
#define SBAR() __syncthreads()
__device__ __forceinline__ void sample_ml(const P& p, LAS unsigned char* lds, int seq, int h) {
    LAS float* qf = (LAS float*)lds; LAS float* kf = qf + 2048; LAS float* vf = kf + 2048; LAS float* n0s = vf + 2048; LAS float* sS = n0s + 256; LAS float* sc = sS + 64; LAS float* qn = sc + 40; LAS float* part = (LAS float*)(lds + 32768);
    int tid_ = threadIdx.x; asm volatile("" : "+v"(tid_));
    const int tid = tid_, w = __builtin_amdgcn_readfirstlane(tid >> 6), lane = tid & 63, fr = lane & 15, fq = lane >> 4;
    const size_t R0 = (size_t)T_P + (size_t)seq * 8, sh = (size_t)seq * NH + h;
    { const int t = tid >> 6, d4 = (tid & 63) * 4;
      const u32x2 qw = *(const u32x2*)(WSP(const bf16_t, A_Q) + (R0 + t) * D + h * 256 + d4), kw = *(const u32x2*)(WSP(const bf16_t, A_K) + (R0 + t) * D + h * 256 + d4);
      *(LAS f32x4*)(qf + t * 256 + d4) = (f32x4){bflo(qw.x), bfhi(qw.x), bflo(qw.y), bfhi(qw.y)}; *(LAS f32x4*)(kf + t * 256 + d4) = (f32x4){bflo(kw.x), bfhi(kw.x), bflo(kw.y), bfhi(kw.y)}; }
    if (tid < 256) { const u32x4 vw = *(const u32x4*)(WSP(const bf16_t, WS_VT) + (size_t)(h * 256 + tid) * T + R0);
        vf[0 * 256 + tid] = bflo(vw.x); vf[1 * 256 + tid] = bfhi(vw.x); vf[2 * 256 + tid] = bflo(vw.y); vf[3 * 256 + tid] = bfhi(vw.y); vf[4 * 256 + tid] = bflo(vw.z); vf[5 * 256 + tid] = bfhi(vw.z); vf[6 * 256 + tid] = bflo(vw.w); vf[7 * 256 + tid] = bfhi(vw.w);
        n0s[tid] = p.in[4][sh * HD + tid]; }
    if (tid < 40) sc[tid] = WSP(const float, M_SC)[(size_t)(tid >> 3) * SC_STRIDE + (size_t)h * T + R0 + (tid & 7)];
    SBAR();
    if (tid < 64) { const int t = tid >> 3, s = tid & 7; float dot = 0.f;
        for (int d = 0; d < 256; ++d) dot += qf[t * 256 + d] * kf[s * 256 + d];
        sS[tid] = (s <= t) ? dot * expf(sc[s] - sc[8 + t]) : 0.f; }
    else if (tid < 72) { const int t = tid - 64; float dot = 0.f; for (int d = 0; d < 256; ++d) dot += qf[t * 256 + d] * n0s[d]; qn[t] = dot; }
    SBAR();
    if (tid < 8) { float den = sc[16 + tid] * qn[tid]; for (int s = 0; s < 8; ++s) den += sS[tid * 8 + s]; WSP(float, M_DEN)[(R0 + tid) * 4 + h] = fmaxf(fabsf(den), sc[32 + tid]); }
    const int d0 = 32 * w + 8 * fq; const float dec = sc[16 + 7];
    float kr[8][8];
#pragma unroll
    for (int s = 0; s < 8; ++s) { const f32x4 k0 = *(const LAS f32x4*)(kf + s * 256 + d0), k1 = *(const LAS f32x4*)(kf + s * 256 + d0 + 4); const float ws_ = sc[24 + s];
        kr[s][0] = k0[0] * ws_; kr[s][1] = k0[1] * ws_; kr[s][2] = k0[2] * ws_; kr[s][3] = k0[3] * ws_; kr[s][4] = k1[0] * ws_; kr[s][5] = k1[1] * ws_; kr[s][6] = k1[2] * ws_; kr[s][7] = k1[3] * ws_; }
    bf16x8 qfrag; { u32x4 o = {0u, 0u, 0u, 0u}; if (fr < 8) { const f32x4 q0 = *(const LAS f32x4*)(qf + fr * 256 + d0), q1 = *(const LAS f32x4*)(qf + fr * 256 + d0 + 4);
        o.x = pk2(q0[0], q0[1]); o.y = pk2(q0[2], q0[3]); o.z = pk2(q1[0], q1[1]); o.w = pk2(q1[2], q1[3]); } qfrag = __builtin_bit_cast(bf16x8, o); }
    if (fr == 0) { float nn[8];
#pragma unroll
        for (int j = 0; j < 8; ++j) { float a = dec * n0s[d0 + j];
#pragma unroll
            for (int s = 0; s < 8; ++s) a += kr[s][j]; nn[j] = a; }
        float* no = p.out + O_NS + sh * HD + d0; *(f32x4*)no = (f32x4){nn[0], nn[1], nn[2], nn[3]}; *(f32x4*)(no + 4) = (f32x4){nn[4], nn[5], nn[6], nn[7]}; }
    const float* C0 = p.in[3] + sh * HD * HD; float* Cn = p.out + O_CS + sh * HD * HD;
#pragma unroll 4
    for (int strip = 0; strip < 16; ++strip) { const int e = 16 * strip + fr;
        const f32x4 c0 = *(const f32x4*)(C0 + (size_t)e * HD + d0), c1 = *(const f32x4*)(C0 + (size_t)e * HD + d0 + 4);
        float cn[8] = {c0[0] * dec, c0[1] * dec, c0[2] * dec, c0[3] * dec, c1[0] * dec, c1[1] * dec, c1[2] * dec, c1[3] * dec};
#pragma unroll
        for (int s = 0; s < 8; ++s) { const float vv = vf[s * 256 + e];
#pragma unroll
            for (int j = 0; j < 8; ++j) cn[j] += vv * kr[s][j]; }
        *(f32x4*)(Cn + (size_t)e * HD + d0) = (f32x4){cn[0], cn[1], cn[2], cn[3]}; *(f32x4*)(Cn + (size_t)e * HD + d0 + 4) = (f32x4){cn[4], cn[5], cn[6], cn[7]};
        u32x4 o; o.x = pk2(c0[0], c0[1]); o.y = pk2(c0[2], c0[3]); o.z = pk2(c1[0], c1[1]); o.w = pk2(c1[2], c1[3]);
        const f32x4 acc = MFMA16(__builtin_bit_cast(bf16x8, o), qfrag, ((f32x4){0.f, 0.f, 0.f, 0.f}));
        if (fr < 8) {
#pragma unroll
            for (int r = 0; r < 4; ++r) part[(size_t)(w * 256 + 16 * strip + 4 * fq + r) * 8 + fr] = acc[r]; } }
    SBAR();
    { const int t = tid >> 6, e4 = (tid & 63) * 4; float o4[4];
#pragma unroll
      for (int i = 0; i < 4; ++i) { float qc = 0.f;
#pragma unroll
          for (int ww = 0; ww < 8; ++ww) qc += part[(size_t)(ww * 256 + e4 + i) * 8 + t];
          float a = sc[16 + t] * qc;
#pragma unroll
          for (int s = 0; s < 8; ++s) a += sS[t * 8 + s] * vf[s * 256 + e4 + i];
          o4[i] = a; }
      u32x2 wv; wv.x = pk2(o4[0], o4[1]); wv.y = pk2(o4[2], o4[3]); *(u32x2*)(WSP(bf16_t, WS_HN) + (R0 + t) * D + h * 256 + e4) = wv; }
    SBAR();
}
__device__ __forceinline__ void sample_gla(const P& p, LAS unsigned char* lds, int seq, int h) {
    LAS float* qf = (LAS float*)lds; LAS float* kf = qf + 1024; LAS float* vf = kf + 1024; LAS float* eal = vf + 2048; LAS float* att = eal + 128; LAS float* part = (LAS float*)(lds + 32768);
    int tid_ = threadIdx.x; asm volatile("" : "+v"(tid_));
    const int tid = tid_, w = __builtin_amdgcn_readfirstlane(tid >> 6), lane = tid & 63;
    const size_t R0 = (size_t)T_P + (size_t)seq * 8, sh = (size_t)seq * NH + h;
    { const int t = tid >> 6, d2 = (tid & 63) * 2;
      const unsigned qw = *(const unsigned*)(WSP(const bf16_t, A_QT) + (R0 + t) * GKW + h * 128 + d2), kw = *(const unsigned*)(WSP(const bf16_t, G_KT) + (R0 + t) * GKW + h * 128 + d2);
      qf[t * 128 + d2] = bflo(qw); qf[t * 128 + d2 + 1] = bfhi(qw); kf[t * 128 + d2] = bflo(kw); kf[t * 128 + d2 + 1] = bfhi(kw); }
    if (tid < 256) { const u32x4 vw = *(const u32x4*)(WSP(const bf16_t, WS_VT) + (size_t)(1024 + h * 256 + tid) * T + R0);
        vf[0 * 256 + tid] = bflo(vw.x); vf[1 * 256 + tid] = bfhi(vw.x); vf[2 * 256 + tid] = bflo(vw.y); vf[3 * 256 + tid] = bfhi(vw.y); vf[4 * 256 + tid] = bflo(vw.z); vf[5 * 256 + tid] = bfhi(vw.z); vf[6 * 256 + tid] = bflo(vw.w); vf[7 * 256 + tid] = bfhi(vw.w); }
    else if (tid < 384) eal[tid - 256] = WSP(const float, M_EAL)[(size_t)(256 + seq) * GKW + h * 128 + (tid - 256)];
    SBAR();
    if (tid < 64) { const int t = tid >> 3, s = tid & 7; float dot = 0.f; for (int d = 0; d < 128; ++d) dot += qf[t * 128 + d] * kf[s * 128 + d]; att[tid] = (s <= t) ? dot : 0.f; }
    const int e4 = 4 * lane;
    f32x4 vr[8], ai[8];
#pragma unroll
    for (int s = 0; s < 8; ++s) { vr[s] = *(const LAS f32x4*)(vf + s * 256 + e4); ai[s] = (f32x4){0.f, 0.f, 0.f, 0.f}; }
    const float* S0 = p.in[6] + sh * GDK * GDV; float* Sn = p.out + O_SS + sh * GDK * GDV;
#pragma unroll 4
    for (int dd = 0; dd < 16; ++dd) { const int d = 16 * w + dd;
        const f32x4 s0 = *(const f32x4*)(S0 + (size_t)d * GDV + e4); f32x4 up = s0;
#pragma unroll
        for (int s = 0; s < 8; ++s) { up += vr[s] * kf[s * 128 + d]; ai[s] += s0 * qf[s * 128 + d]; }
        *(f32x4*)(Sn + (size_t)d * GDV + e4) = up * eal[d]; }
#pragma unroll
    for (int t = 0; t < 8; ++t) *(LAS f32x4*)(part + (size_t)(w * 8 + t) * 256 + e4) = ai[t];
    SBAR();
    { const int t = tid >> 6; f32x4 o = {0.f, 0.f, 0.f, 0.f};
#pragma unroll
      for (int ww = 0; ww < 8; ++ww) o += *(const LAS f32x4*)(part + (size_t)(ww * 8 + t) * 256 + e4);
#pragma unroll
      for (int s = 0; s < 8; ++s) o += *(const LAS f32x4*)(vf + s * 256 + e4) * att[t * 8 + s];
      u32x2 wv; wv.x = pk2(o[0], o[1]); wv.y = pk2(o[2], o[3]); *(u32x2*)(DOP(bf16_t, DO_OG) + (R0 + t) * D + h * 256 + e4) = wv; }
    SBAR();
}
#ifndef MK_SCAN_PARTS
#define MK_SCAN_PARTS 3
#endif
__device__ __forceinline__ void p5_scan(const P& p, LAS unsigned char* lds, int bid, int G, unsigned* counter, int parts) {
    if (parts & 1) for (int it = bid; it < 192; it += G) {
        if (it < 128) scan_prompt<true>(p, lds, it >> 4, (it >> 2) & 3, it & 3);
        else { const int i = it - 128; scan_prompt<false>(p, lds, i >> 3, (i >> 1) & 3, i & 1); }
    }
    LAS int* slot = (LAS int*)(lds + 140 * 1024);
    if (parts & 2) for (;;) {
        if (threadIdx.x == 0) *slot = (int)atomicAdd(counter, 1u);
        SBAR();
        const int it = *slot;
        SBAR();
        if (it >= 1024) break;
        if (it < 512) sample_ml(p, lds, it >> 2, it & 3); else sample_gla(p, lds, (it - 512) >> 2, it & 3);
    }
}
__device__ __forceinline__ void p5b_norm(const P& p, int gw, int NGW, int lane) {
    const bf16_t* HN = WSP(const bf16_t, WS_HN); const bf16_t* OG = DOP(const bf16_t, DO_OG); const bf16_t* SIGO = WSP(const bf16_t, S_SIGO); const bf16_t* SILUR = WSP(const bf16_t, S_SILUR);
    bf16_t* HMO = WSP(bf16_t, A_Q); const float* DEN = WSP(const float, M_DEN);
    const int h = lane >> 4, c0 = h * 256 + (lane & 15) * 16;
    float gm[16], gg[16];
#pragma unroll
    for (int i = 0; i < 16; ++i) { gm[i] = p.in[17][c0 + i]; gg[i] = p.in[20][c0 + i]; }
#pragma unroll 2
    for (int row = gw; row < T; row += NGW) {
#pragma unroll
        for (int br = 0; br < 2; ++br) {
            const bf16_t* src = (br == 0 ? HN : OG) + (size_t)row * D + c0; const bf16_t* gsrc = (br == 0 ? SIGO : SILUR) + (size_t)row * D + c0;
            const u32x4 a = *(const u32x4*)src, b = *(const u32x4*)(src + 8), ga = *(const u32x4*)gsrc, gb = *(const u32x4*)(gsrc + 8);
            float v[16] = {bflo(a.x), bfhi(a.x), bflo(a.y), bfhi(a.y), bflo(a.z), bfhi(a.z), bflo(a.w), bfhi(a.w), bflo(b.x), bfhi(b.x), bflo(b.y), bfhi(b.y), bflo(b.z), bfhi(b.z), bflo(b.w), bfhi(b.w)};
            float gt[16] = {bflo(ga.x), bfhi(ga.x), bflo(ga.y), bfhi(ga.y), bflo(ga.z), bfhi(ga.z), bflo(ga.w), bfhi(ga.w), bflo(gb.x), bfhi(gb.x), bflo(gb.y), bfhi(gb.y), bflo(gb.z), bfhi(gb.z), bflo(gb.w), bfhi(gb.w)};
            float ss = 0.f;
#pragma unroll
            for (int i = 0; i < 16; ++i) ss += v[i] * v[i];
            ss += __shfl_xor(ss, 1); ss += __shfl_xor(ss, 2); ss += __shfl_xor(ss, 4); ss += __shfl_xor(ss, 8);
            float extra = EPS; if (br == 0) { const float dn = DEN[(size_t)row * 4 + h]; extra = EPS * dn * dn; }
            const float sc = 1.f / sqrtf(ss * (1.f / 256.f) + extra);
            unsigned o[8];
#pragma unroll
            for (int i = 0; i < 8; ++i) { const float g0 = br == 0 ? gm[2 * i] : gg[2 * i], g1 = br == 0 ? gm[2 * i + 1] : gg[2 * i + 1]; o[i] = pk2(gt[2 * i] * g0 * v[2 * i] * sc, gt[2 * i + 1] * g1 * v[2 * i + 1] * sc); }
            bf16_t* dst = HMO + (size_t)row * (2 * D) + br * D + c0;
            *(u32x4*)dst = (u32x4){o[0], o[1], o[2], o[3]}; *(u32x4*)(dst + 8) = (u32x4){o[4], o[5], o[6], o[7]};
        }
    }
}
__device__ __forceinline__ void p10_final(const P& p, int gw, int NGW, int lane) {
    const f32x4* g4 = (const f32x4*)p.in[27] + lane; f32x4 g[4];
#pragma unroll
    for (int j = 0; j < 4; ++j) g[j] = g4[64 * j];
#pragma unroll 2
    for (int row = gw; row < T; row += NGW) {
        f32x4* xr = (f32x4*)(p.out + (size_t)row * D) + lane; f32x4 v[4]; float s = 0.f;
#pragma unroll
        for (int j = 0; j < 4; ++j) { v[j] = xr[64 * j]; s += (v[j].x * v[j].x + v[j].y * v[j].y) + (v[j].z * v[j].z + v[j].w * v[j].w); }
        const float rs = 1.f / sqrtf(wave_sum(s) * (1.f / D) + EPS);
#pragma unroll
        for (int j = 0; j < 4; ++j) xr[64 * j] = v[j] * rs * g[j];
    }
}
constexpr int LDS_BYTES = 147456;
constexpr int CW_CNT = 64;
constexpr int CW_BAR = 1024;
constexpr int CTL_ZERO_BYTES = 32768;
#ifndef MK_PH_LO
#define MK_PH_LO 0
#endif
#ifndef MK_PH_HI
#define MK_PH_HI 99
#endif
#ifndef MK_REP
#define MK_REP 0
#endif
__global__ void __launch_bounds__(NTHR, 2) mk_fwd(P p) {
    cg::grid_group grid = cg::this_grid();
    extern __shared__ __attribute__((aligned(16))) unsigned char lds_raw[];
    LAS unsigned char* lds = (LAS unsigned char*)lds_raw;
    const int bid = blockIdx.x, G = gridDim.x, NGW = G * NWAVES; const size_t gsz = (size_t)G * NTHR;
    if (threadIdx.x < 4) ((LAS unsigned*)(lds + 140 * 1024 + 16))[threadIdx.x] = 0u;
    __syncthreads();
    const XcdBarrier xbar = xcd_barrier_post((unsigned*)(p.ws + WS_CTL) + CW_BAR, (volatile LAS unsigned*)(lds + 140 * 1024 + 16));
#define GRID_BAR() xcd_barrier(xbar)
#define TIDX() int tid = threadIdx.x; asm volatile("" : "+v"(tid)); const int lane = tid & 63, wave = __builtin_amdgcn_readfirstlane(tid >> 6), gw = bid * NWAVES + wave; const size_t gtid = (size_t)bid * NTHR + tid; (void)lane; (void)gw; (void)gtid
    float* SSQ = WSP(float, M_SSQ); float* XRES = p.out;
    bf16_t* XBF = WSP(bf16_t, WS_XBF); bf16_t* ACT = WSP(bf16_t, WS_ACT);
    constexpr int NM = T / 256;
#define PH(k) (MK_PH_LO <= (k) && (k) <= MK_PH_HI)
#define PHASE_BEGIN(k) _Pragma("nounroll") for (int rep_ = 0; rep_ <= ((MK_REP >> (k)) & 1); ++rep_) { if (rep_) GRID_BAR(); if (PH(k)) {
#define PHASE_END } }
    PHASE_BEGIN(0) TIDX(); p0_prologue(p, lds, gw, NGW, wave, lane); PHASE_END
    grid.sync();
    PHASE_BEGIN(1) pg8::Gemm g{XBF, WSP(bf16_t, W_UP1), nullptr, nullptr, D, D, D, 0, 0}; pg8::Sched S; S.init(NM, 2 * FF / 256, 1, 0, 0, 0, G, bid);
        EpiUp E{SSQ, ACT}; pg8::gemm_phase(lds, g, S, E); PHASE_END
    GRID_BAR();
    PHASE_BEGIN(2) pg8::Gemm g{ACT, WSP(bf16_t, W_DN1), nullptr, nullptr, FF, FF, FF, 0, 0}; pg8::Sched S; S.init(NM, D / 256, 1, 0, 0, 0, G, bid);
        EpiRes<0> E{XBF, XRES, SSQ, 0.5f}; pg8::gemm_phase(lds, g, S, E); PHASE_END
    GRID_BAR();
    PHASE_BEGIN(3) const bf16_t* Wi = WSP(bf16_t, W_IN); pg8::Gemm g{XBF, Wi, Wi + (size_t)6400 * D, XBF, D, D, D, 0, 0}; pg8::Sched S; S.init(NM, 25, 1, 8, NM, 1, G, bid);
        EpiIn E{SSQ, DOP(bf16_t, DO_U), WSP(bf16_t, S_SIGO), DOP(bf16_t, DO_QG), DOP(bf16_t, DO_KG), WSP(bf16_t, S_SILUR), WSP(bf16_t, S_SIGA), WSP(bf16_t, S_SIGB), WSP(bf16_t, WS_VT), WSP(float, M_GATES)};
        pg8::gemm_phase(lds, g, S, E); PHASE_END
    GRID_BAR();
    #ifndef MK_P4_PARTS
#define MK_P4_PARTS 7
#endif
    PHASE_BEGIN(4) TIDX(); const int pp_ = rep_ ? MK_P4_PARTS : 7; if (pp_ & 1) p4_gates(p, lds, bid, tid); if (pp_ & 2) p4_gla(p, lds, bid, G, tid); if (pp_ & 4) { const int ncb = G > 32 ? G - 16 : G; if (bid < ncb) p4_conv(p, gtid, (size_t)ncb * NTHR); } PHASE_END
    GRID_BAR();
    PHASE_BEGIN(5) const bf16_t* Wqk = WSP(bf16_t, W_QK); const bf16_t* CH = DOP(bf16_t, DO_CH); pg8::Gemm g{CH, Wqk, Wqk + (size_t)256 * D, CH, D, D, 256, 256, 256}; pg8::Sched S; S.init(NM, 2, 4, 1, NM, 4, G, bid);
        EpiQK E{WSP(bf16_t, A_Q), WSP(bf16_t, A_K), WSP(bf16_t, WS_KT)}; pg8::gemm_phase(lds, g, S, E); PHASE_END
    GRID_BAR();
    PHASE_BEGIN(6) p5_scan(p, lds, bid, G, (unsigned*)(p.ws + WS_CTL) + CW_CNT + rep_, rep_ ? MK_SCAN_PARTS : 3); PHASE_END
    GRID_BAR();
    PHASE_BEGIN(7) TIDX(); p5b_norm(p, gw, NGW, lane); PHASE_END
    GRID_BAR();
    PHASE_BEGIN(8) pg8::Gemm g{WSP(bf16_t, A_Q), WSP(bf16_t, W_PA), nullptr, nullptr, 2 * D, 2 * D, 2 * D, 0, 0}; pg8::Sched S; S.init(NM, D / 256, 1, 0, 0, 0, G, bid);
        EpiMerge E{WSP(bf16_t, S_SIGA), WSP(bf16_t, S_SIGB), WSP(bf16_t, WS_KT)}; pg8::gemm_phase(lds, g, S, E); PHASE_END
    GRID_BAR();
    PHASE_BEGIN(9) pg8::Gemm g{WSP(bf16_t, WS_KT), WSP(bf16_t, W_O), nullptr, nullptr, D, D, D, 0, 0}; pg8::Sched S; S.init(NM, D / 256, 1, 0, 0, 0, G, bid);
        EpiRes<0> E{XBF, XRES, SSQ, 1.0f}; pg8::gemm_phase(lds, g, S, E); PHASE_END
    GRID_BAR();
    PHASE_BEGIN(10) pg8::Gemm g{XBF, WSP(bf16_t, W_UP2), nullptr, nullptr, D, D, D, 0, 0}; pg8::Sched S; S.init(NM, 2 * FF / 256, 1, 0, 0, 0, G, bid);
        EpiUp E{SSQ, ACT}; pg8::gemm_phase(lds, g, S, E); PHASE_END
    GRID_BAR();
    PHASE_BEGIN(11) pg8::Gemm g{ACT, WSP(bf16_t, W_DN2), nullptr, nullptr, FF, FF, FF, 0, 0}; pg8::Sched S; S.init(NM, D / 256, 1, 0, 0, 0, G, bid);
        EpiRes<1> E{XBF, XRES, SSQ, 0.5f}; pg8::gemm_phase(lds, g, S, E); PHASE_END
    GRID_BAR();
#ifdef MK_EXTRA_SYNCS
    for (int i_ = 0; i_ < MK_EXTRA_SYNCS; ++i_) GRID_BAR();
#endif
    PHASE_BEGIN(12) TIDX(); p10_final(p, gw, NGW, lane); PHASE_END
#undef PH
#undef TIDX
#undef PHASE_BEGIN
#undef PHASE_END
#undef GRID_BAR
}
}

static int mk_launch(void* const* d_in, const int* in_sizes, int n_in, void* d_out, int out_size, void* d_ws, size_t ws_size, hipStream_t stream) {
    static int grid = 0;
    if (grid == 0) {
        if (n_in != 28 || (size_t)out_size != mk::O_END || ws_size < mk::WS_END) { fprintf(stderr, "kernel_launch: built for 28 inputs, %zu outputs, >= %zu bytes of workspace; got n_in %d, out %d, ws %zu; nothing launched\n", (size_t)mk::O_END, (size_t)mk::WS_END, n_in, out_size, ws_size); grid = -1; return -1; }
        int dev = 0, cus = 0, per_cu = 0;
        if (hipGetDevice(&dev) != hipSuccess || hipDeviceGetAttribute(&cus, hipDeviceAttributeMultiprocessorCount, dev) != hipSuccess) { grid = -1; return -1; }
        if (hipFuncSetAttribute((const void*)mk::mk_fwd, hipFuncAttributeMaxDynamicSharedMemorySize, mk::LDS_BYTES) != hipSuccess) { fprintf(stderr, "kernel_launch: hipFuncSetAttribute failed\n"); grid = -1; return -1; }
        if (hipOccupancyMaxActiveBlocksPerMultiprocessor(&per_cu, (const void*)mk::mk_fwd, mk::NTHR, mk::LDS_BYTES) != hipSuccess || per_cu < 1) { fprintf(stderr, "kernel_launch: occupancy query reports %d blocks per CU\n", per_cu); grid = -1; (void)hipGetLastError(); return -1; }
        grid = cus;
    }
    if (grid < 0) return -1;
    if (hipMemsetAsync((char*)d_ws + mk::WS_CTL, 0, mk::CTL_ZERO_BYTES, stream) != hipSuccess) return -1;
    mk::P prm{}; for (int i = 0; i < 28; ++i) prm.in[i] = (const float*)d_in[i]; prm.out = (float*)d_out; prm.ws = (unsigned char*)d_ws;
    void* args[] = {&prm};
    const hipError_t e = hipLaunchCooperativeKernel((const void*)mk::mk_fwd, dim3(grid), dim3(mk::NTHR), args, mk::LDS_BYTES, stream);
    if (e != hipSuccess) { fprintf(stderr, "cooperative launch failed: %s (grid %d)\n", hipGetErrorString(e), grid); return -1; }
    return 0;
}
extern "C" void kernel_launch(void* const* d_in, const int* in_sizes, int n_in, void* d_out, int out_size, void* d_ws, size_t ws_size, hipStream_t stream) {
    (void)mk_launch(d_in, in_sizes, n_in, d_out, out_size, d_ws, ws_size, stream);
}
```
